# Optimizing an MI355X kernel written in HIP

```python
import jax, jax.numpy as jnp
from jax import lax
import numpy as np

D_MODEL = 1024
BATCH = 16
SEQ = 2048
DEPTH = 1

D_MIX = D_MODEL
D_MLSTM = D_MIX // 2
D_RWKV = D_MIX - D_MLSTM
MLSTM_HEADS = 4
MLSTM_HEAD_DIM = D_MLSTM // MLSTM_HEADS
MLSTM_CHUNK = 128
CONV_WIDTH = 4
RWKV_HEAD_DIM = 64
RWKV_HEADS = D_RWKV // RWKV_HEAD_DIM
DECAY_LORA = 64
ICLR_LORA = 64
GATE_LORA = 128
D_IN_MLSTM = 4 * D_MLSTM + 2 * MLSTM_HEADS
D_IN_RWKV = 3 * D_RWKV + DECAY_LORA + ICLR_LORA + GATE_LORA
D_IN = D_IN_MLSTM + D_IN_RWKV
D_FF = -(-8 * D_MODEL // (3 * 256)) * 256
MEM_TOKENS = 256
XATTN_HEADS = 4
XATTN_HEAD_DIM = D_MODEL // XATTN_HEADS
EPS = 1e-6
RWKV_LN_EPS = 64e-5

kernel_name = 'hybrid_mlstm_rwkv7_memxattn_block'


def rms_norm(x, g):
    xf = x.astype(jnp.float32)
    y = xf * lax.rsqrt(jnp.mean(xf * xf, -1, keepdims=True) + EPS)
    return (y * g.astype(jnp.float32)).astype(x.dtype)


def split_cols(z, sizes):
    outs, start = [], 0
    for s in sizes:
        outs.append(z[..., start:start + s])
        start += s
    return outs


def token_shift(z):
    return jnp.pad(z, ((0, 0), (1, 0), (0, 0)))[:, :-1]


def causal_conv(z, w):
    T = z.shape[1]
    zp = jnp.pad(z, ((0, 0), (CONV_WIDTH - 1, 0), (0, 0)))
    out = zp[:, 0:T] * w[0]
    for j in range(1, CONV_WIDTH):
        out = out + zp[:, j:j + T] * w[j]
    return out


def mlstm_chunkwise(q, k, v, i_pre, f_pre):
    B, T, H, DH = q.shape
    L = MLSTM_CHUNK
    NC = T // L
    f32 = jnp.float32
    to_chunks = lambda t: t.astype(f32).reshape(B, NC, L, H, DH).transpose(0, 3, 1, 2, 4)
    q = to_chunks(q)
    k = to_chunks(k) * (DH ** -0.5)
    v = to_chunks(v)
    ig = i_pre.astype(f32).reshape(B, NC, L, H).transpose(0, 3, 1, 2)
    lf = jax.nn.log_sigmoid(f_pre.astype(f32)).reshape(B, NC, L, H).transpose(0, 3, 1, 2)
    b = jnp.cumsum(lf, axis=-1)
    g = b[..., -1]

    a = g[..., None] - b + ig
    m_loc = jnp.max(a, -1)
    wgt = jnp.exp(a - m_loc[..., None])
    dC = jnp.einsum('bhcld,bhcle->bhcde', v * wgt[..., None], k)
    dn = jnp.einsum('bhcl,bhcle->bhce', wgt, k)

    def step(carry, inp):
        C, n, m = carry
        g_c, mloc_c, dC_c, dn_c = inp
        m_new = jnp.maximum(g_c + m, mloc_c)
        s_old = jnp.exp(g_c + m - m_new)
        s_new = jnp.exp(mloc_c - m_new)
        C_new = s_old[..., None, None] * C + s_new[..., None, None] * dC_c
        n_new = s_old[..., None] * n + s_new[..., None] * dn_c
        return (C_new, n_new, m_new), (C, n, m)

    init = (jnp.zeros((B, H, DH, DH), f32), jnp.zeros((B, H, DH), f32), jnp.zeros((B, H), f32))
    xs = (jnp.moveaxis(g, 2, 0), jnp.moveaxis(m_loc, 2, 0), jnp.moveaxis(dC, 2, 0), jnp.moveaxis(dn, 2, 0))
    _, (C_prev, n_prev, m_prev) = lax.scan(step, init, xs)
    C_prev = jnp.moveaxis(C_prev, 0, 2)
    n_prev = jnp.moveaxis(n_prev, 0, 2)
    m_prev = jnp.moveaxis(m_prev, 0, 2)

    causal = jnp.tril(jnp.ones((L, L), dtype=bool))
    Dm = b[..., :, None] - b[..., None, :] + ig[..., None, :]
    Dm = jnp.where(causal, Dm, -jnp.inf)
    m_intra = jnp.max(Dm, -1)
    m_inter = b + m_prev[..., None]
    m_t = jnp.maximum(m_inter, m_intra)
    S = jnp.einsum('bhcld,bhcsd->bhcls', q, k) * jnp.exp(Dm - m_t[..., None])
    s_inter = jnp.exp(m_inter - m_t)
    num = jnp.einsum('bhcls,bhcsd->bhcld', S, v) + s_inter[..., None] * jnp.einsum('bhcde,bhcle->bhcld', C_prev, q)
    den = jnp.sum(S, -1) + s_inter * jnp.einsum('bhce,bhcle->bhcl', n_prev, q)
    h = num / jnp.maximum(jnp.abs(den), jnp.exp(-m_t))[..., None]
    return h.transpose(0, 2, 3, 1, 4).reshape(B, T, H, DH)


def mlstm_group(z, conv_w, i_bias, f_bias, norm_w):
    B, T, _ = z.shape
    qk, v, o, ig, fg = split_cols(z, (2 * D_MLSTM, D_MLSTM, D_MLSTM, MLSTM_HEADS, MLSTM_HEADS))
    qk = jax.nn.silu(causal_conv(qk, conv_w))
    q, k = qk[..., :D_MLSTM], qk[..., D_MLSTM:]
    shp = (B, T, MLSTM_HEADS, MLSTM_HEAD_DIM)
    h = mlstm_chunkwise(q.reshape(shp), k.reshape(shp), v.reshape(shp), ig + i_bias, fg + f_bias)
    h = h * lax.rsqrt(jnp.mean(h * h, -1, keepdims=True) + EPS)
    h = h * norm_w.astype(jnp.float32).reshape(MLSTM_HEADS, MLSTM_HEAD_DIM)
    return (h.reshape(B, T, D_MLSTM) * jax.nn.sigmoid(o.astype(jnp.float32))).astype(z.dtype)


def rwkv7_scan(r, w, k, v, a, b):
    B, T, H, N = r.shape

    def step(S, inp):
        r_t, w_t, k_t, v_t, a_t, b_t = inp
        sa = jnp.einsum('bhij,bhj->bhi', S, a_t)
        S = S * w_t[:, :, None, :] + sa[..., None] * b_t[:, :, None, :] + v_t[..., None] * k_t[:, :, None, :]
        return S, jnp.einsum('bhij,bhj->bhi', S, r_t)

    xs = tuple(jnp.moveaxis(t, 1, 0) for t in (r, w, k, v, a, b))
    _, y = lax.scan(step, jnp.zeros((B, H, N, N), jnp.float32), xs)
    return jnp.moveaxis(y, 0, 1)


def rwkv7_group(z, mu, w0, w_up, a0, a_up, g_up, k_k, k_a, r_k, ln_w, ln_b):
    B, T, _ = z.shape
    f32 = jnp.float32
    z = z + (token_shift(z) - z) * mu
    r, k, v, xw, xa, xg = split_cols(z, (D_RWKV, D_RWKV, D_RWKV, DECAY_LORA, ICLR_LORA, GATE_LORA))
    w = -jax.nn.softplus(-(w0 + jnp.tanh(xw) @ w_up).astype(f32)) - 0.5
    decay = jnp.exp(-jnp.exp(w))
    a = jax.nn.sigmoid((a0 + xa @ a_up).astype(f32))
    g = jax.nn.sigmoid(xg) @ g_up
    hs = lambda t: t.astype(f32).reshape(B, T, RWKV_HEADS, RWKV_HEAD_DIM)
    hp = lambda t: t.astype(f32).reshape(RWKV_HEADS, RWKV_HEAD_DIM)
    kk = hs(k * k_k)
    kk = kk / jnp.maximum(jnp.sqrt(jnp.sum(kk * kk, -1, keepdims=True)), 1e-12)
    a = hs(a)
    k = hs(k) * (1.0 + (a - 1.0) * hp(k_a))
    r, v = hs(r), hs(v)
    y = rwkv7_scan(r, hs(decay), k, v, -kk, kk * a)
    mean = jnp.mean(y, -1, keepdims=True)
    var = jnp.mean(jnp.square(y - mean), -1, keepdims=True)
    y = (y - mean) * lax.rsqrt(var + RWKV_LN_EPS)
    y = y * hp(ln_w) + hp(ln_b)
    y = y + jnp.sum(r * k * r_k.astype(f32), -1, keepdims=True) * v
    return (y.reshape(B, T, D_RWKV) * g.astype(f32)).astype(z.dtype)


def memory_cross_attention(u, m, wq, wkv, wo):
    B, T, D = u.shape
    M = m.shape[1]
    q = (u @ wq).reshape(B, T, XATTN_HEADS, XATTN_HEAD_DIM)
    kv = m @ wkv
    k = kv[..., :D].reshape(B, M, XATTN_HEADS, XATTN_HEAD_DIM)
    v = kv[..., D:].reshape(B, M, XATTN_HEADS, XATTN_HEAD_DIM)
    s = jnp.einsum('bthd,bmhd->bhtm', q, k).astype(jnp.float32) * (XATTN_HEAD_DIM ** -0.5)
    p = jax.nn.softmax(s, -1).astype(v.dtype)
    o = jnp.einsum('bhtm,bmhd->bthd', p, v).reshape(B, T, D)
    return o @ wo


def setup_inputs(seed: int = 0) -> dict:
    key = jax.random.key(seed)
    ks = jax.random.split(key, 32)
    f32 = jnp.float32
    nrm = lambda k, shape, s: jax.random.normal(k, shape, f32) * s
    L_ = DEPTH
    ramp_w0 = jnp.linspace(-6.0, -1.0, D_RWKV, dtype=f32)
    ramp_fb = jnp.linspace(3.0, 6.0, MLSTM_HEADS, dtype=f32)
    return {
        'x': nrm(ks[0], (BATCH, SEQ, D_MODEL), 1.0),
        'mem': nrm(ks[1], (BATCH, MEM_TOKENS, D_MODEL), 1.0),
        'norm_mix': 1.0 + nrm(ks[2], (L_, D_MODEL), 0.02),
        'w_in': nrm(ks[3], (L_, D_MODEL, D_IN), D_MODEL ** -0.5),
        'mlstm_conv': nrm(ks[4], (L_, CONV_WIDTH, 2 * D_MLSTM), CONV_WIDTH ** -0.5),
        'mlstm_i_bias': nrm(ks[5], (L_, MLSTM_HEADS), 0.1),
        'mlstm_f_bias': ramp_fb + nrm(ks[6], (L_, MLSTM_HEADS), 0.1),
        'mlstm_norm': 1.0 + nrm(ks[7], (L_, D_MLSTM), 0.02),
        'rwkv_mu': jax.random.uniform(ks[8], (L_, D_IN_RWKV), f32),
        'rwkv_w0': ramp_w0 + nrm(ks[9], (L_, D_RWKV), 0.1),
        'rwkv_w_up': nrm(ks[10], (L_, DECAY_LORA, D_RWKV), 0.3 * DECAY_LORA ** -0.5),
        'rwkv_a0': nrm(ks[11], (L_, D_RWKV), 0.1),
        'rwkv_a_up': nrm(ks[12], (L_, ICLR_LORA, D_RWKV), ICLR_LORA ** -0.5),
        'rwkv_g_up': nrm(ks[13], (L_, GATE_LORA, D_RWKV), GATE_LORA ** -0.5),
        'rwkv_k_k': 0.85 + nrm(ks[14], (L_, D_RWKV), 0.05),
        'rwkv_k_a': 1.0 + nrm(ks[15], (L_, D_RWKV), 0.05),
        'rwkv_r_k': nrm(ks[16], (L_, RWKV_HEADS, RWKV_HEAD_DIM), 0.1),
        'rwkv_ln_w': 1.0 + nrm(ks[17], (L_, D_RWKV), 0.02),
        'rwkv_ln_b': nrm(ks[18], (L_, D_RWKV), 0.02),
        'w_mix_out': nrm(ks[19], (L_, D_MIX, D_MODEL), D_MIX ** -0.5),
        'norm_xattn': 1.0 + nrm(ks[20], (L_, D_MODEL), 0.02),
        'norm_mem': 1.0 + nrm(ks[21], (L_, D_MODEL), 0.02),
        'xattn_wq': nrm(ks[22], (L_, D_MODEL, D_MODEL), D_MODEL ** -0.5),
        'xattn_wkv': nrm(ks[23], (L_, D_MODEL, 2 * D_MODEL), D_MODEL ** -0.5),
        'xattn_wo': nrm(ks[24], (L_, D_MODEL, D_MODEL), D_MODEL ** -0.5),
        'norm_ffn': 1.0 + nrm(ks[25], (L_, D_MODEL), 0.02),
        'ffn_w_gate': nrm(ks[26], (L_, D_MODEL, D_FF), D_MODEL ** -0.5),
        'ffn_w_up': nrm(ks[27], (L_, D_MODEL, D_FF), D_MODEL ** -0.5),
        'ffn_w_down': nrm(ks[28], (L_, D_FF, D_MODEL), D_FF ** -0.5),
        'norm_final': 1.0 + nrm(ks[29], (D_MODEL,), 0.02),
    }


def reference(x, mem, norm_mix, w_in, mlstm_conv, mlstm_i_bias, mlstm_f_bias, mlstm_norm, rwkv_mu, rwkv_w0, rwkv_w_up, rwkv_a0, rwkv_a_up, rwkv_g_up, rwkv_k_k, rwkv_k_a, rwkv_r_k, rwkv_ln_w, rwkv_ln_b, w_mix_out, norm_xattn, norm_mem, xattn_wq, xattn_wkv, xattn_wo, norm_ffn, ffn_w_gate, ffn_w_up, ffn_w_down, norm_final):
    h = x
    for l in range(DEPTH):
        u = rms_norm(h, norm_mix[l])
        z = u @ w_in[l]
        y_m = mlstm_group(z[..., :D_IN_MLSTM], mlstm_conv[l], mlstm_i_bias[l], mlstm_f_bias[l], mlstm_norm[l])
        y_r = rwkv7_group(z[..., D_IN_MLSTM:], rwkv_mu[l], rwkv_w0[l], rwkv_w_up[l], rwkv_a0[l], rwkv_a_up[l],
                          rwkv_g_up[l], rwkv_k_k[l], rwkv_k_a[l], rwkv_r_k[l], rwkv_ln_w[l], rwkv_ln_b[l])
        h = h + jnp.concatenate([y_m, y_r], axis=-1) @ w_mix_out[l]
        h = h + memory_cross_attention(rms_norm(h, norm_xattn[l]), rms_norm(mem, norm_mem[l]),
                                       xattn_wq[l], xattn_wkv[l], xattn_wo[l])
        u = rms_norm(h, norm_ffn[l])
        h = h + (jax.nn.silu(u @ ffn_w_gate[l]) * (u @ ffn_w_up[l])) @ ffn_w_down[l]
    return rms_norm(h, norm_final)
```

```cpp
#include <hip/hip_runtime.h>
#include <hip/hip_bf16.h>
#include <cstdio>
#include <cstdint>
namespace pg8 {
#define PG8_LAS __attribute__((address_space(3)))
typedef unsigned short bf16_t;
typedef short bf16x8 __attribute__((ext_vector_type(8)));
typedef float f32x4 __attribute__((ext_vector_type(4)));
typedef unsigned u32x4 __attribute__((ext_vector_type(4)));
constexpr int BM = 256, BK = 64, HALF = 128, HTB = HALF * BK * 2  , STAGE_BYTES = 8 * HTB, NXCD = 8, WGM = 8;

__host__ __device__ __forceinline__ int lds_byte(int r, int c) { const int st = (r >> 4) * 2 + (c >> 5), rr = r & 15, cc = c & 31, ob = rr * 64 + cc * 2; return st * 1024 + (ob ^ (((ob >> 9) & 1) << 5)); }
__host__ __device__ __forceinline__ void stage_rc(int b, int& R, int& C) { const int st = b / 1024, sb = b % 1024, swz = sb ^ (((sb >> 9) & 1) << 5); R = (st >> 1) * 16 + swz / 64; C = (st & 1) * 32 + (swz % 64) / 2; }
__host__ __device__ __forceinline__ int perm32(int rho) { const int n = rho >> 4, i = rho & 15; return 8 * (i >> 2) + 4 * n + (i & 3); }

struct Unit { int pm, pn; };
struct Gemm { const bf16_t* A; const bf16_t* Bt; int M, N, K; };

struct StaticOrder {
    int nM, nN, nwg, G, c;
    __host__ __device__ void init(int M, int N, int G_, int c_) { nM = M / BM; nN = N / BM; nwg = nM * nN; G = G_; c = c_; }
    __host__ __device__ bool next(int i, Unit& u) const {
        const long L = (long)i * G + c; if (L >= nwg) return false;
        int wgid = (int)L; { const int q = nwg / NXCD, r = nwg % NXCD, xcd = wgid % NXCD, off = wgid / NXCD; wgid = (xcd < r ? xcd * (q + 1) : r * (q + 1) + (xcd - r) * q) + off; }
        const int nig = WGM * nN, gid = wgid / nig, fm = gid * WGM, gsz = (nM - fm) < WGM ? (nM - fm) : WGM;
        u.pm = fm + ((wgid % nig) % gsz); u.pn = (wgid % nig) / gsz; return true;
    }
    __device__ __forceinline__ void a_ready(const Unit&) const {}
    __device__ __forceinline__ void done(const Unit&) const {}
};

__device__ __forceinline__ unsigned cvt_pk_bf16(float lo, float hi) { unsigned r; asm volatile("v_cvt_pk_bf16_f32 %0, %1, %2" : "=v"(r) : "v"(lo), "v"(hi)); return r; }
typedef float f32x2 __attribute__((ext_vector_type(2)));

struct Order2 {
    StaticOrder so; int G, c;
    __device__ void init(int G_, int c_) { so.init(32768, 3840, G_, c_); G = G_; c = c_; }
    __device__ bool next(int i, Unit& u) const {
        const long L = (long)i * G + c;
        if (L < 1920) return so.next(i, u);
        const int Lp = (int)(L - 1920); if (Lp >= 128) return false;
        const int xcd = Lp & 7, off = Lp >> 3;
        u.pm = 128 + xcd * 2 + (off & 1); u.pn = 15 + (off >> 1); return true;
    }
    __device__ __forceinline__ void a_ready(const Unit&) const {}
    __device__ __forceinline__ void done(const Unit&) const {}
};


struct EpiZ {
    static constexpr bool PERM = true, AFTER_DRAIN = false;
    bf16_t* zm; bf16_t* zr; bf16_t* kv;
    __device__ __forceinline__ void operator()(const f32x4 (&acc)[2][2][4][2], const Unit& u, int wr, int wc, int fr, int fq) const {
        bf16_t* base; int ldc; int row0 = u.pm * BM + wr * 64 + fr; int colt;
        if (u.pm < 128) { if (u.pn < 8) { base = zm; ldc = 2048; colt = u.pn * BM; } else { base = zr; ldc = 1792; colt = (u.pn - 8) * BM; } }
        else { base = kv; ldc = 2048; colt = (u.pn - 15) * BM; row0 -= 32768; }
        const int col0 = colt + wc * 32 + 8 * fq;
#pragma unroll
        for (int ai = 0; ai < 2; ++ai)
#pragma unroll
            for (int m = 0; m < 4; ++m) { bf16_t* rowp = base + (size_t)(row0 + ai * HALF + m * 16) * ldc + col0;
#pragma unroll
                for (int bj = 0; bj < 2; ++bj) { const f32x4 v0 = acc[ai][bj][m][0], v1 = acc[ai][bj][m][1];
                    u32x4 w; w.x = cvt_pk_bf16(v0[0], v0[1]); w.y = cvt_pk_bf16(v0[2], v0[3]); w.z = cvt_pk_bf16(v1[0], v1[1]); w.w = cvt_pk_bf16(v1[2], v1[3]);
                    *(u32x4*)(rowp + bj * HALF) = w; } }
    }
};

__device__ __forceinline__ float row_rstd16(const float* ssq, int row, float eps) {
    const f32x4* p = (const f32x4*)(ssq + (size_t)row * 16);
    const f32x4 a = p[0], b = p[1], c = p[2], d = p[3];
    const float s = ((a[0] + a[1]) + (a[2] + a[3])) + ((b[0] + b[1]) + (b[2] + b[3])) + ((c[0] + c[1]) + (c[2] + c[3])) + ((d[0] + d[1]) + (d[2] + d[3]));
    return 1.0f / sqrtf(s * (1.0f / 1024.0f) + eps);
}

template <bool HAS_HB> struct EpiRes {
    static constexpr bool PERM = true, AFTER_DRAIN = false;
    const float* base; float* out; bf16_t* hb; float* ssq;
    __device__ __forceinline__ void operator()(const f32x4 (&acc)[2][2][4][2], const Unit& u, int wr, int wc, int fr, int fq) const {
        const int row0 = u.pm * BM + wr * 64 + fr, col0 = u.pn * BM + wc * 32 + 8 * fq;
#pragma unroll
        for (int ai = 0; ai < 2; ++ai)
#pragma unroll
            for (int m = 0; m < 4; ++m) { const int row = row0 + ai * HALF + m * 16; const size_t off = (size_t)row * 1024 + col0; float ss = 0.f;
#pragma unroll
                for (int bj = 0; bj < 2; ++bj) {
                    const f32x4 b0 = *(const f32x4*)(base + off + bj * HALF), b1 = *(const f32x4*)(base + off + bj * HALF + 4);
                    const f32x4 v0 = acc[ai][bj][m][0] + b0, v1 = acc[ai][bj][m][1] + b1;
                    *(f32x4*)(out + off + bj * HALF) = v0; *(f32x4*)(out + off + bj * HALF + 4) = v1;
                    ss += (v0[0] * v0[0] + v0[1] * v0[1]) + (v0[2] * v0[2] + v0[3] * v0[3]) + (v1[0] * v1[0] + v1[1] * v1[1]) + (v1[2] * v1[2] + v1[3] * v1[3]);
                    if (HAS_HB) { u32x4 w; w.x = cvt_pk_bf16(v0[0], v0[1]); w.y = cvt_pk_bf16(v0[2], v0[3]); w.z = cvt_pk_bf16(v1[0], v1[1]); w.w = cvt_pk_bf16(v1[2], v1[3]);
                        *(u32x4*)(hb + off + bj * HALF) = w; } }
                ss += __shfl_xor(ss, 16); ss += __shfl_xor(ss, 32);
                if (fq == 0) ssq[(size_t)row * 16 + u.pn * 4 + wc] = ss; }
    }
};

struct EpiQ {
    static constexpr bool PERM = true, AFTER_DRAIN = false;
    bf16_t* q; const float* ssq; float eps, scale;
    __device__ __forceinline__ void operator()(const f32x4 (&acc)[2][2][4][2], const Unit& u, int wr, int wc, int fr, int fq) const {
        const int row0 = u.pm * BM + wr * 64 + fr, col0 = u.pn * BM + wc * 32 + 8 * fq;
#pragma unroll
        for (int ai = 0; ai < 2; ++ai)
#pragma unroll
            for (int m = 0; m < 4; ++m) { const int row = row0 + ai * HALF + m * 16; const float rs = row_rstd16(ssq, row, eps) * scale; bf16_t* rowp = q + (size_t)row * 1024 + col0;
#pragma unroll
                for (int bj = 0; bj < 2; ++bj) { const f32x4 v0 = acc[ai][bj][m][0] * rs, v1 = acc[ai][bj][m][1] * rs;
                    u32x4 w; w.x = cvt_pk_bf16(v0[0], v0[1]); w.y = cvt_pk_bf16(v0[2], v0[3]); w.z = cvt_pk_bf16(v1[0], v1[1]); w.w = cvt_pk_bf16(v1[2], v1[3]);
                    *(u32x4*)(rowp + bj * HALF) = w; } }
    }
};

struct EpiGlu {
    static constexpr bool PERM = true, AFTER_DRAIN = false;
    bf16_t* act; const float* ssq; float eps;
    __device__ __forceinline__ void operator()(const f32x4 (&acc)[2][2][4][2], const Unit& u, int wr, int wc, int fr, int fq) const {
        const int row0 = u.pm * BM + wr * 64 + fr, col0 = u.pn * HALF + wc * 32 + 8 * fq;
#pragma unroll
        for (int ai = 0; ai < 2; ++ai)
#pragma unroll
            for (int m = 0; m < 4; ++m) { const int row = row0 + ai * HALF + m * 16; const float rs = row_rstd16(ssq, row, eps);
                float o[8];
#pragma unroll
                for (int n = 0; n < 2; ++n)
#pragma unroll
                    for (int e = 0; e < 4; ++e) { const float g = acc[ai][0][m][n][e] * rs, up = acc[ai][1][m][n][e] * rs;
                        const float sg = g * __builtin_amdgcn_rcpf(1.0f + __builtin_amdgcn_exp2f(-1.4426950408889634f * g)); o[n * 4 + e] = sg * up; }
                u32x4 w; w.x = cvt_pk_bf16(o[0], o[1]); w.y = cvt_pk_bf16(o[2], o[3]); w.z = cvt_pk_bf16(o[4], o[5]); w.w = cvt_pk_bf16(o[6], o[7]);
                *(u32x4*)(act + (size_t)row * 2816 + col0) = w; }
    }
};
template <class Epi, class Sched, bool ALIGN_EPI = false, bool SP2 = false>
__device__ __forceinline__ void gemm_phase(PG8_LAS unsigned char* lds, const Gemm g, const Sched& S, const Epi& E) {
    const int tid = threadIdx.x, wid = __builtin_amdgcn_readfirstlane(tid >> 6), lane = tid & 63, wr = wid >> 2, wc = wid & 3, fr = lane & 15, fq = lane >> 4;
    const int K = g.K, nt = K / BK;
    unsigned voffA[2], voffB[2];
#pragma unroll
    for (int i = 0; i < 2; ++i) { int R, C; stage_rc(tid * 16 + i * 8192, R, C); const int Rb = Epi::PERM ? ((R & ~31) + perm32(R & 31)) : R;
        voffA[i] = (unsigned)(R * K + C) * 2u; voffB[i] = (unsigned)(Rb * K + C) * 2u; }
    const size_t kstep = (size_t)(BK * 2);
    const size_t hstep = (size_t)HALF * K * 2;
    const size_t tstep = 2 * hstep;
    const unsigned ldsw = (unsigned)wid * 1024u;
    const int aoff = lds_byte(wr * 64 + fr, fq * 8), boff = lds_byte(wc * 32 + fr, fq * 8);
#define PG8_SA(b, h) (((b) * 2 + (h)) * HTB)
#define PG8_SB(b, h) ((4 + (b) * 2 + (h)) * HTB)
#define PG8_STAGE(bufoff, gbase, voff) do { _Pragma("unroll") for (int _i = 0; _i < 2; ++_i) \
        __builtin_amdgcn_global_load_lds((const unsigned*)((const char*)(gbase) + (voff)[_i]), (PG8_LAS unsigned*)(lds + (bufoff) + ldsw + _i * 8192), 16, 0, 0); } while (0)
#define PG8_LDA(dst, b, h) do { _Pragma("unroll") for (int m = 0; m < 4; ++m) _Pragma("unroll") for (int k = 0; k < 2; ++k) dst[m][k] = *(const PG8_LAS bf16x8*)(lds + PG8_SA(b, h) + aoff + m * 2048 + k * 1024); } while (0)
#define PG8_LDB(dst, b, h) do { _Pragma("unroll") for (int n = 0; n < 2; ++n) _Pragma("unroll") for (int k = 0; k < 2; ++k) dst[n][k] = *(const PG8_LAS bf16x8*)(lds + PG8_SB(b, h) + boff + n * 2048 + k * 1024); } while (0)
#define PG8_MMA(ai, bj, At, Bt) do { __builtin_amdgcn_s_setprio(1); _Pragma("unroll") for (int m = 0; m < 4; ++m) _Pragma("unroll") for (int n = 0; n < 2; ++n) _Pragma("unroll") for (int k = 0; k < 2; ++k) \
        acc[ai][bj][m][n] = __builtin_amdgcn_mfma_f32_16x16x32_bf16(Bt[n][k], At[m][k], acc[ai][bj][m][n], 0, 0, 0); __builtin_amdgcn_s_setprio(0); } while (0)
#define PG8_WAIT_V(n) asm volatile("s_waitcnt vmcnt(" #n ")" ::: "memory")
#define PG8_WAIT_L(n) asm volatile("s_waitcnt lgkmcnt(" #n ")" ::: "memory")
#define PG8_BAR __builtin_amdgcn_s_barrier()
#define PG8_SCHED __builtin_amdgcn_sched_barrier(0)
    Unit cur, nxt; int ui = 0;
    if (!S.next(0, cur)) return;
    f32x4 acc[2][2][4][2];
#pragma unroll
    for (int a = 0; a < 2; ++a)
#pragma unroll
        for (int b = 0; b < 2; ++b)
#pragma unroll
            for (int m = 0; m < 4; ++m)
#pragma unroll
                for (int n = 0; n < 2; ++n) acc[a][b][m][n] = (f32x4){0.f, 0.f, 0.f, 0.f};
    bf16x8 At[4][2], B0[2][2], B1[2][2];
    const char* cA = (const char*)g.A + (size_t)cur.pm * tstep; const char* cB = (const char*)g.Bt + (size_t)cur.pn * tstep;
    S.a_ready(cur);
    if constexpr (SP2) {
        PG8_STAGE(PG8_SB(0, 0), cB, voffB); PG8_STAGE(PG8_SB(0, 1), cB + hstep, voffB); PG8_STAGE(PG8_SA(0, 0), cA, voffA); PG8_STAGE(PG8_SA(0, 1), cA + hstep, voffA);
        if (wr == 1) PG8_BAR;
        PG8_WAIT_V(2); PG8_BAR;
        PG8_STAGE(PG8_SB(1, 0), cB + kstep, voffB); PG8_STAGE(PG8_SA(1, 0), cA + kstep, voffA); PG8_STAGE(PG8_SB(1, 1), cB + hstep + kstep, voffB);
        PG8_WAIT_V(6); PG8_BAR;
    } else {
        PG8_STAGE(PG8_SB(0, 0), cB, voffB); PG8_STAGE(PG8_SA(0, 0), cA, voffA); PG8_STAGE(PG8_SB(0, 1), cB + hstep, voffB); PG8_STAGE(PG8_SA(0, 1), cA + hstep, voffA);
        if (wr == 1) PG8_BAR;
        PG8_WAIT_V(4); PG8_BAR;
        PG8_STAGE(PG8_SB(1, 0), cB + kstep, voffB); PG8_STAGE(PG8_SA(1, 0), cA + kstep, voffA); PG8_STAGE(PG8_SB(1, 1), cB + hstep + kstep, voffB);
        PG8_WAIT_V(6); PG8_BAR;
    }
    for (;;) {
        const bool has_next = S.next(ui + 1, nxt);
        const char* nA = has_next ? (const char*)g.A + (size_t)nxt.pm * tstep : cA; const char* nB = has_next ? (const char*)g.Bt + (size_t)nxt.pn * tstep : cB;
        for (int t = 0; t < nt; t += 2) {
            const bool last = (t == nt - 2);
            const char* a1 = cA + (size_t)(t + 1) * kstep;
            const char* a2 = last ? nA : cA + (size_t)(t + 2) * kstep; const char* b2 = last ? nB : cB + (size_t)(t + 2) * kstep;
            const char* a3 = a2 + kstep; const char* b3 = b2 + kstep;
            if (last && has_next) S.a_ready(nxt);
            if constexpr (SP2) {
            PG8_LDB(B0, 0, 0); PG8_LDB(B1, 0, 1); PG8_SCHED; PG8_LDA(At, 0, 0); PG8_STAGE(PG8_SA(1, 1), a1 + hstep, voffA);
            PG8_WAIT_V(8); PG8_WAIT_L(0); PG8_BAR; PG8_MMA(0, 0, At, B0); PG8_MMA(0, 1, At, B1); PG8_BAR; PG8_SCHED;
            PG8_LDA(At, 0, 1); PG8_STAGE(PG8_SB(0, 0), b2, voffB); PG8_STAGE(PG8_SB(0, 1), b2 + hstep, voffB); PG8_STAGE(PG8_SA(0, 0), a2, voffA);
            PG8_WAIT_V(8); PG8_WAIT_L(0); PG8_BAR; PG8_MMA(1, 0, At, B0); PG8_MMA(1, 1, At, B1); PG8_BAR; PG8_SCHED;
            PG8_LDB(B0, 1, 0); PG8_LDB(B1, 1, 1); PG8_SCHED; PG8_LDA(At, 1, 0); PG8_STAGE(PG8_SA(0, 1), a2 + hstep, voffA);
            PG8_WAIT_V(8); PG8_WAIT_L(0); PG8_BAR; PG8_MMA(0, 0, At, B0); PG8_MMA(0, 1, At, B1); PG8_BAR; PG8_SCHED;
            PG8_LDA(At, 1, 1); PG8_STAGE(PG8_SB(1, 0), b3, voffB); PG8_STAGE(PG8_SB(1, 1), b3 + hstep, voffB); PG8_STAGE(PG8_SA(1, 0), a3, voffA);
            PG8_WAIT_V(8); PG8_WAIT_L(0); PG8_BAR; PG8_MMA(1, 0, At, B0); PG8_MMA(1, 1, At, B1); PG8_BAR; PG8_SCHED;
            } else {
            PG8_LDB(B0, 0, 0); PG8_SCHED; PG8_LDA(At, 0, 0); PG8_STAGE(PG8_SA(1, 1), a1 + hstep, voffA);
            PG8_WAIT_L(8); PG8_BAR; PG8_WAIT_L(0); PG8_MMA(0, 0, At, B0); PG8_BAR; PG8_SCHED;
            PG8_LDB(B1, 0, 1); PG8_STAGE(PG8_SB(0, 0), b2, voffB);
            PG8_BAR; PG8_WAIT_L(0); PG8_MMA(0, 1, At, B1); PG8_BAR;
            PG8_LDA(At, 0, 1); PG8_STAGE(PG8_SA(0, 0), a2, voffA);
            PG8_BAR; PG8_WAIT_L(0); PG8_MMA(1, 0, At, B0); PG8_BAR; PG8_SCHED;
            PG8_STAGE(PG8_SB(0, 1), b2 + hstep, voffB);
            PG8_WAIT_V(6); PG8_BAR; PG8_MMA(1, 1, At, B1); PG8_BAR;
            PG8_LDB(B0, 1, 0); PG8_SCHED; PG8_LDA(At, 1, 0); PG8_STAGE(PG8_SA(0, 1), a2 + hstep, voffA);
            PG8_WAIT_L(8); PG8_BAR; PG8_WAIT_L(0); PG8_MMA(0, 0, At, B0); PG8_BAR; PG8_SCHED;
            PG8_LDB(B1, 1, 1); PG8_STAGE(PG8_SB(1, 0), b3, voffB);
            PG8_BAR; PG8_WAIT_L(0); PG8_MMA(0, 1, At, B1); PG8_BAR;
            PG8_LDA(At, 1, 1); PG8_STAGE(PG8_SA(1, 0), a3, voffA);
            PG8_BAR; PG8_WAIT_L(0); PG8_MMA(1, 0, At, B0); PG8_BAR; PG8_SCHED;
            PG8_STAGE(PG8_SB(1, 1), b3 + hstep, voffB);
            PG8_WAIT_V(6); PG8_BAR; PG8_MMA(1, 1, At, B1); PG8_BAR;
            }
        }
        if constexpr (ALIGN_EPI) { if (wr == 0) PG8_BAR; }
        if constexpr (!Epi::AFTER_DRAIN) { E(acc, cur, wr, wc, fr, fq); S.done(cur); }
        if (!has_next) break;
#pragma unroll
        for (int a = 0; a < 2; ++a)
#pragma unroll
            for (int b = 0; b < 2; ++b)
#pragma unroll
                for (int m = 0; m < 4; ++m)
#pragma unroll
                    for (int n = 0; n < 2; ++n) acc[a][b][m][n] = (f32x4){0.f, 0.f, 0.f, 0.f};
        cur = nxt; cA = nA; cB = nB; ++ui;
        if constexpr (ALIGN_EPI) { if (wr == 1) PG8_BAR; }
    }
    PG8_WAIT_V(0);
    if constexpr (!ALIGN_EPI) { if (wr == 0) PG8_BAR; }
    PG8_BAR;
    if constexpr (Epi::AFTER_DRAIN) { E.fused(acc, cur, wr, wc, fr, fq, lds, wid, lane); S.done(cur); }
#undef PG8_SA
#undef PG8_SB
#undef PG8_STAGE
#undef PG8_LDA
#undef PG8_LDB
#undef PG8_MMA
#undef PG8_WAIT_V
#undef PG8_WAIT_L
#undef PG8_BAR
#undef PG8_SCHED
}
}
#define GAS __attribute__((address_space(1)))
#define LAS __attribute__((address_space(3)))
typedef unsigned short bf16;
typedef unsigned v4u __attribute__((ext_vector_type(4)));
typedef float f32x4 __attribute__((ext_vector_type(4)));
typedef short bf16x8 __attribute__((ext_vector_type(8)));
typedef GAS unsigned gu32;
typedef GAS unsigned long long gu64;
#define RLX_AGENT __ATOMIC_RELAXED, __HIP_MEMORY_SCOPE_AGENT
#define LDS_WAIT() asm volatile("s_waitcnt lgkmcnt(0)" ::: "memory")
#define VM_WAIT() asm volatile("s_waitcnt vmcnt(0)" ::: "memory")
__device__ __forceinline__ unsigned long long rt() { return __builtin_amdgcn_s_memrealtime(); }
__device__ __forceinline__ unsigned f2bf(float f) { unsigned u = __builtin_bit_cast(unsigned, f); return (u + 0x7fffu + ((u >> 16) & 1u)) >> 16; }
__device__ __forceinline__ unsigned pk2(float lo, float hi) { return f2bf(lo) | (f2bf(hi) << 16); }

#define XB_TMO      128
#define XB_XCNT(j)  (256  + 64 * (j))
#define XB_XSUB(j)  (1280 + 64 * (j))
#define XB_XGEN(j)  (2304 + 64 * (j))
#define XB_TOP      3328
#define XB_TOPGEN   3392
#define XCD_BAR_WORDS 3456
#define XB_SPIN_CAP (1u << 18)

__device__ __forceinline__ unsigned xb_ld(unsigned* p)              { return __hip_atomic_load(p, __ATOMIC_RELAXED, __HIP_MEMORY_SCOPE_AGENT); }
__device__ __forceinline__ unsigned xb_add(unsigned* p, unsigned v) { return __hip_atomic_fetch_add(p, v, __ATOMIC_RELAXED, __HIP_MEMORY_SCOPE_AGENT); }
__device__ __forceinline__ unsigned xb_xcc_id() { return (unsigned)__builtin_amdgcn_s_getreg((3 << 11) | 20) & 0xFu; }
#define XB_SPIN(cond, bar) do { unsigned _sp = 0; while (cond) { __builtin_amdgcn_s_sleep(1); \
    if ((++_sp & 255u) == 0u) { if (xb_ld(&(bar)[XB_TMO])) break; if (_sp > XB_SPIN_CAP) { atomicAdd(&(bar)[XB_TMO], 1u); break; } } } } while (0)

struct XcdBarrier {
    unsigned* bar; unsigned x;
    volatile LAS unsigned* st;
};

__device__ __forceinline__ XcdBarrier xcd_barrier_post(unsigned* bar, volatile LAS unsigned* st) {
    XcdBarrier b; b.bar = bar; b.x = xb_xcc_id(); b.st = st;
    if (threadIdx.x == 0) (void)xb_add(&bar[XB_XCNT(b.x)], 1u);
    return b;
}
__device__ __forceinline__ void xcd_barrier_complete(unsigned* bar, unsigned x, unsigned& nloc, unsigned& nx) {
    const unsigned G = gridDim.x * gridDim.y * gridDim.z;
    unsigned sum, cnt, mine, sp = 0u;
    for (;;) {
        sum = 0u; cnt = 0u; mine = 0u;
#pragma unroll
        for (unsigned j = 0; j < 16; ++j) { const unsigned c = xb_ld(&bar[XB_XCNT(j)]); sum += c; cnt += (c > 0u) ? 1u : 0u; mine = (j == x) ? c : mine; }
        if (sum == G) break;
        __builtin_amdgcn_s_sleep(1);
        if ((++sp & 255u) == 0u) { if (xb_ld(&bar[XB_TMO])) break; if (sp > XB_SPIN_CAP) { atomicAdd(&bar[XB_TMO], 1u); break; } }
    }
    nloc = mine > 0u ? mine : 1u; nx = cnt > 0u ? cnt : 1u;
}

__device__ __forceinline__ void xcd_barrier(const XcdBarrier& b) {
    asm volatile("s_waitcnt vmcnt(0)" ::: "memory");
    __syncthreads();
    if (threadIdx.x == 0) {
        unsigned* bar = b.bar;
        __builtin_amdgcn_s_waitcnt(0);
        unsigned nloc = b.st[0], nx = b.st[1];
        if (nloc == 0u) { xcd_barrier_complete(bar, b.x, nloc, nx); b.st[0] = nloc; b.st[1] = nx; }
        const unsigned old = xb_add(&bar[XB_XSUB(b.x)], 1u);
        const unsigned gen = old / nloc;
        if (old + 1u == (gen + 1u) * nloc) {
            __builtin_amdgcn_fence(__ATOMIC_RELEASE, "agent");
            asm volatile("s_waitcnt vmcnt(0)" ::: "memory");
            const unsigned og = xb_add(&bar[XB_TOP], 1u);
            const unsigned tg = og / nx;
            if (og + 1u == (tg + 1u) * nx) xb_add(&bar[XB_TOPGEN], 1u);
            else XB_SPIN(xb_ld(&bar[XB_TOPGEN]) == tg, bar);
            __builtin_amdgcn_fence(__ATOMIC_ACQUIRE, "agent");
            xb_add(&bar[XB_XGEN(b.x)], 1u);
            asm volatile("s_waitcnt vmcnt(0)" ::: "memory");
        } else {
            XB_SPIN(xb_ld(&bar[XB_XGEN(b.x)]) == gen, bar);
            __builtin_amdgcn_fence(__ATOMIC_ACQUIRE, "agent");
            asm volatile("s_waitcnt vmcnt(0)" ::: "memory");
        }
    }
    __syncthreads();
}

typedef float f32x2 __attribute__((ext_vector_type(2)));
constexpr int NWAVES = 8;
constexpr int BATCH = 16, SEQ = 2048, DM = 1024, M = BATCH * SEQ;
constexpr int MEMT = 256, MM = BATCH * MEMT;
constexpr int DIN = 3848, NZM = 2048, NZR = 1792, NZ = NZM + NZR;
constexpr int DFF = 2816;
constexpr float EPS = 1e-6f, RWKV_LN_EPS = 64e-5f;
constexpr float LOG2E = 1.4426950408889634f;

constexpr size_t MiB = 1u << 20;
constexpr size_t WS_CTL = 0, CTL_ZERO_BYTES = 64 * 1024;
constexpr size_t WS_ZG = 1 * MiB;
constexpr size_t WS_SSQ1 = 2 * MiB, WS_SSQ2 = 4 * MiB, WS_SSQ3 = 6 * MiB;
constexpr size_t WS_WIN = 8 * MiB;
constexpr size_t WS_WKV = WS_WIN + (size_t)NZ * DM * 2;
constexpr size_t WS_WMIX = 20 * MiB, WS_WQ = 22 * MiB, WS_WO = 24 * MiB, WS_WGU = 26 * MiB  , WS_WD = 37 * MiB  ;
constexpr size_t WS_LORA = 43 * MiB;
constexpr size_t WS_KV = 44 * MiB;
constexpr size_t WS_XN = 60 * MiB;
constexpr size_t WS_MN = WS_XN + (size_t)M * DM * 2;
constexpr size_t WS_Y = WS_XN;
constexpr size_t WS_ZM = 132 * MiB;
constexpr size_t WS_ZR = 260 * MiB;
constexpr size_t WS_H1B = WS_ZM, WS_QO = WS_ZM + 64 * MiB;
constexpr size_t WS_H2B = WS_ZR;
constexpr size_t WS_ACT = WS_ZR + 64 * MiB;
constexpr size_t WS_END = 500 * MiB;
static_assert(WS_WKV + (size_t)2048 * DM * 2 <= WS_WMIX && WS_WD + (size_t)DM * DFF * 2 <= WS_LORA && WS_MN + (size_t)MM * DM * 2 <= WS_ZM && WS_ZR + (size_t)M * NZR * 2 <= WS_END && WS_ACT + (size_t)M * DFF * 2 <= WS_END, "d_ws map");
constexpr int CW_BAR = 1024;

constexpr int LDS_BYTES = 163840;
constexpr int MISC_OFF = LDS_BYTES - 256;

__device__ __forceinline__ float bf2f(unsigned short h) { return __builtin_bit_cast(float, (unsigned)h << 16); }
__device__ __forceinline__ float bflo(unsigned w) { return __builtin_bit_cast(float, w << 16); }
__device__ __forceinline__ float bfhi(unsigned w) { return __builtin_bit_cast(float, w & 0xffff0000u); }
__device__ __forceinline__ float sigmoidf_(float x) { return __builtin_amdgcn_rcpf(1.0f + __builtin_amdgcn_exp2f(-LOG2E * x)); }
__device__ __forceinline__ float expf_(float x) { return __builtin_amdgcn_exp2f(LOG2E * x); }
__device__ __forceinline__ float wave_sum(float v) {
#pragma unroll
    for (int o = 1; o < 64; o <<= 1) v += __shfl_xor(v, o);
    return v;
}
template <int CTRL> __device__ __forceinline__ float dpp_f(float v) { return __builtin_bit_cast(float, __builtin_amdgcn_update_dpp(0, __builtin_bit_cast(int, v), CTRL, 0xF, 0xF, false)); }
__device__ __forceinline__ float row16_sum(float v) { v += dpp_f<0xB1>(v); v += dpp_f<0x4E>(v); v += dpp_f<0x141>(v); v += dpp_f<0x140>(v); return v; }
__device__ __forceinline__ float row8_sum(float v) { v += dpp_f<0xB1>(v); v += dpp_f<0x4E>(v); v += dpp_f<0x141>(v); return v; }

struct Frame {
    LAS unsigned char* lds;
    int tid, lane, wave, vcu, G;
    const float* in[30]; float* out; unsigned char* ws;
};

__device__ __forceinline__ void transpose_item(const float* W, int ldw, int src_col0, bf16* WT, int K, int dst_row0, const float* kscale, int k0, LAS float* scr, int lane) {
#pragma unroll 8
    for (int i = 0; i < 32; ++i) { const int kk = 2 * i + (lane >> 5); float v = W[(size_t)(k0 + kk) * ldw + src_col0 + (lane & 31)]; if (kscale) v *= kscale[k0 + kk]; scr[kk * 33 + (lane & 31)] = v; }
    LDS_WAIT(); asm volatile("" ::: "memory");
    const int c = lane & 7;
#pragma unroll
    for (int j = 0; j < 4; ++j) { const int n = (lane >> 3) + 8 * j; const LAS float* s = scr + (8 * c) * 33 + n;
        v4u o; o.x = pk2(s[0 * 33], s[1 * 33]); o.y = pk2(s[2 * 33], s[3 * 33]); o.z = pk2(s[4 * 33], s[5 * 33]); o.w = pk2(s[6 * 33], s[7 * 33]);
        *(GAS v4u*)(WT + (size_t)(dst_row0 + n) * K + k0 + 8 * c) = o; }
    LDS_WAIT(); asm volatile("" ::: "memory");
}

__device__ __forceinline__ void p0_prologue(Frame& F) {
    LAS float* scr = (LAS float*)(F.lds + F.wave * 8704);
    LAS float* GW = (LAS float*)(F.lds + 98304);
    const float* w_in = F.in[3];
    for (int idx = F.tid; idx < 8 * 1024; idx += NWAVES * 64) { const int q = idx >> 10, k = idx & 1023; GW[idx] = F.in[2][k] * w_in[(size_t)k * DIN + 2048 + q]; }
    __syncthreads();
    const int gw = F.vcu * NWAVES + F.wave, NGW = F.G * NWAVES;
    unsigned char* ws = F.ws;
    constexpr int I_WIN = 120 * 16, I_WKV = 64 * 16, I_SQ = 32 * 16, I_WGU = 176 * 16, I_WD = 32 * 44, I_L64 = 16, I_L128 = 32;
    constexpr int NITEMS = I_WIN + I_WKV + 3 * I_SQ + I_WGU + I_WD + 2 * I_L64 + I_L128;
    for (int it = gw; it < NITEMS; it += NGW) {
        int r = it;
        if (r < I_WIN) { const int seg = r >> 4, kb = r & 15, n0 = seg * 32; transpose_item(w_in, DIN, n0 < 2048 ? n0 : n0 + 8, (bf16*)(ws + WS_WIN), 1024, n0, F.in[2], kb * 64, scr, F.lane); continue; } r -= I_WIN;
        if (r < I_WKV) { const int seg = r >> 4, kb = r & 15; transpose_item(F.in[23], 2048, seg * 32, (bf16*)(ws + WS_WKV), 1024, seg * 32, F.in[21], kb * 64, scr, F.lane); continue; } r -= I_WKV;
        if (r < I_SQ) { const int seg = r >> 4, kb = r & 15; transpose_item(F.in[19], 1024, seg * 32, (bf16*)(ws + WS_WMIX), 1024, seg * 32, nullptr, kb * 64, scr, F.lane); continue; } r -= I_SQ;
        if (r < I_SQ) { const int seg = r >> 4, kb = r & 15; transpose_item(F.in[22], 1024, seg * 32, (bf16*)(ws + WS_WQ), 1024, seg * 32, F.in[20], kb * 64, scr, F.lane); continue; } r -= I_SQ;
        if (r < I_SQ) { const int seg = r >> 4, kb = r & 15; transpose_item(F.in[24], 1024, seg * 32, (bf16*)(ws + WS_WO), 1024, seg * 32, nullptr, kb * 64, scr, F.lane); continue; } r -= I_SQ;
        if (r < I_WGU) { const int seg = r >> 4, kb = r & 15, r0 = seg * 32, blk = r0 >> 8, within = r0 & 255;
            transpose_item(within < 128 ? F.in[26] : F.in[27], DFF, blk * 128 + (within & 127), (bf16*)(ws + WS_WGU), 1024, r0, F.in[25], kb * 64, scr, F.lane); continue; } r -= I_WGU;
        if (r < I_WD) { const int seg = r / 44, kb = r % 44; transpose_item(F.in[28], 1024, seg * 32, (bf16*)(ws + WS_WD), DFF, seg * 32, nullptr, kb * 64, scr, F.lane); continue; } r -= I_WD;
        if (r < I_L64) { transpose_item(F.in[10], 512, r * 32, (bf16*)(ws + WS_LORA), 64, r * 32, nullptr, 0, scr, F.lane); continue; } r -= I_L64;
        if (r < I_L64) { transpose_item(F.in[12], 512, r * 32, (bf16*)(ws + WS_LORA) + 512 * 64, 64, r * 32, nullptr, 0, scr, F.lane); continue; } r -= I_L64;
        { const int seg = r >> 1, kb = r & 1; transpose_item(F.in[13], 512, seg * 32, (bf16*)(ws + WS_LORA) + 2 * 512 * 64, 128, seg * 32, nullptr, kb * 64, scr, F.lane); }
    }
    for (int m = gw; m < M + MM; m += NGW) {
        const bool is_x = m < M;
        const float* xrow = is_x ? F.in[0] + (size_t)m * DM : F.in[1] + (size_t)(m - M) * DM;
        const GAS f32x4* xr = (const GAS f32x4*)xrow + F.lane;
        f32x4 v[4]; float s = 0.f;
#pragma unroll
        for (int j = 0; j < 4; ++j) { v[j] = xr[64 * j]; s += (v[j].x * v[j].x + v[j].y * v[j].y) + (v[j].z * v[j].z + v[j].w * v[j].w); }
        const float rstd = 1.f / sqrtf(wave_sum(s) * (1.f / DM) + EPS);
#pragma unroll
        for (int j = 0; j < 4; ++j) v[j] = v[j] * rstd;
        GAS unsigned long long* o8 = (GAS unsigned long long*)((bf16*)(ws + WS_XN) + (size_t)m * DM) + F.lane;
#pragma unroll
        for (int j = 0; j < 4; ++j) o8[64 * j] = (unsigned long long)pk2(v[j].x, v[j].y) | ((unsigned long long)pk2(v[j].z, v[j].w) << 32);
        if (is_x) {
            float g8[8];
#pragma unroll
            for (int q = 0; q < 8; ++q) { float a = 0.f;
#pragma unroll
                for (int j = 0; j < 4; ++j) { const f32x4 w = *(const LAS f32x4*)(GW + q * 1024 + 256 * j + 4 * F.lane); a += (v[j].x * w.x + v[j].y * w.y) + (v[j].z * w.z + v[j].w * w.w); }
                g8[q] = wave_sum(a); }
            if (F.lane == 0) { f32x4* zg = (f32x4*)((float*)(ws + WS_ZG) + (size_t)m * 8); zg[0] = (f32x4){g8[0], g8[1], g8[2], g8[3]}; zg[1] = (f32x4){g8[4], g8[5], g8[6], g8[7]}; }
        }
    }
}

__device__ __forceinline__ void final_norm(Frame& F) {
    const int gw = F.vcu * NWAVES + F.wave, NGW = F.G * NWAVES;
    const float* ssq = (const float*)(F.ws + WS_SSQ3); const float* g = F.in[29];
    f32x4 gv[4];
#pragma unroll
    for (int j = 0; j < 4; ++j) gv[j] = ((const f32x4*)g)[F.lane + 64 * j];
    for (int m = gw; m < M; m += NGW) {
        const float rs = pg8::row_rstd16(ssq, m, EPS);
        GAS f32x4* o = (GAS f32x4*)(F.out + (size_t)m * DM) + F.lane;
#pragma unroll
        for (int j = 0; j < 4; ++j) { f32x4 v = o[64 * j]; v = v * rs * gv[j]; o[64 * j] = v; }
    }
}

typedef short v4i16_t __attribute__((ext_vector_type(4)));
typedef short s16x4 __attribute__((ext_vector_type(4)));
__device__ __forceinline__ s16x4 lds_tr16(const LAS unsigned char* p) { return __builtin_bit_cast(s16x4, __builtin_amdgcn_ds_read_tr16_b64_v4i16((LAS v4i16_t*)p)); }
__device__ __forceinline__ bf16x8 cat8(s16x4 lo, s16x4 hi) { return (bf16x8){lo[0], lo[1], lo[2], lo[3], hi[0], hi[1], hi[2], hi[3]}; }

constexpr int ML_ROWB = 272;
constexpr int ML_Q = 0, ML_K = 34816, ML_V = 69632, ML_C = 104448, ML_F = 139264;
__device__ __forceinline__ void mlstm_unit(Frame& F, int b, int h) {
    LAS unsigned char* L = F.lds;
    LAS unsigned char *Qs = L + ML_Q, *Ks = L + ML_K, *Vs = L + ML_V, *Cs = L + ML_C;
    LAS float* fl = (LAS float*)(L + ML_F);
    LAS float *dS = fl, *Mrow = fl + 128, *sint = fl + 256, *eden = fl + 384, *wgt = fl + 512, *nvec = fl + 640, *npart = fl + 768, *scal = fl + 1280, *tmp = fl + 1296;
    const int tid = F.tid, lane = F.lane, w = F.wave, fr = lane & 15, G = lane >> 4;
    const bf16* zm = (const bf16*)(F.ws + WS_ZM);
    const float* zg = (const float*)(F.ws + WS_ZG);
    const float* convw = F.in[4];
    const float ib = F.in[5][h], fb = F.in[6][h];
    const float* normw = F.in[7];
    bf16* Y = (bf16*)(F.ws + WS_Y);
    f32x4 Cacc[8];
#pragma unroll
    for (int et = 0; et < 8; ++et) Cacc[et] = (f32x4){0.f, 0.f, 0.f, 0.f};
    if (tid < 128) nvec[tid] = 0.f;
    float m_prev = 0.f;
    const int cp = tid & 127, tq = tid >> 7;
    const bool isk = cp >= 64; const int e2 = 2 * (cp & 63);
    const int zcol = (isk ? 512 : 0) + 128 * h + e2;
    float cw[4][2];
#pragma unroll
    for (int j = 0; j < 4; ++j) { cw[j][0] = convw[j * 1024 + zcol]; cw[j][1] = convw[j * 1024 + zcol + 1]; }
    const float kscale = isk ? 0.08838834764831845f : 1.0f;
    __syncthreads();
    for (int c = 0; c < 16; ++c) {
        const int m0 = b * SEQ + c * 128;
        float lf = 0.f, igv = 0.f;
        if (tid < 128) { const float* zr = zg + (size_t)(m0 + tid) * 8; igv = zr[h] + ib; const float fv = zr[4 + h] + fb; lf = fminf(fv, 0.f) - log1pf(__expf(-fabsf(fv))); }
        float bc = lf;
#pragma unroll
        for (int o = 1; o < 64; o <<= 1) { const float t = __shfl_up(bc, o); if (lane >= o) bc += t; }
        if (w == 0 && lane == 63) tmp[0] = bc;
        __syncthreads();
        if (w == 1) bc += tmp[0];
        const float dl = igv - bc;
        float pm = dl;
#pragma unroll
        for (int o = 1; o < 64; o <<= 1) { const float t = __shfl_up(pm, o); if (lane >= o) pm = fmaxf(pm, t); }
        if (w == 0 && lane == 63) tmp[1] = pm;
        __syncthreads();
        if (w == 1) pm = fmaxf(pm, tmp[1]);
        if (tid == 127) { scal[0] = bc; scal[3] = pm; }
        __syncthreads();
        const float g = scal[0], m_loc = g + scal[3], m_new = fmaxf(g + m_prev, m_loc), s_old = __expf(g + m_prev - m_new);
        if (tid < 128) { const float Ml = fmaxf(m_prev, pm); dS[tid] = dl; Mrow[tid] = Ml; sint[tid] = __expf(m_prev - Ml); eden[tid] = __expf(-bc - Ml); wgt[tid] = __expf(g + dl - m_new); }
        {
            const int tl0 = 32 * tq; const int ts0 = c * 128 + tl0;
            const bf16* zp = zm + (size_t)(m0 + tl0) * NZM + zcol;
            float x0[2] = {0.f, 0.f}, x1[2] = {0.f, 0.f}, x2[2] = {0.f, 0.f};
            if (ts0 >= 3) { const unsigned u = *(const unsigned*)(zp - 3 * NZM); x0[0] = bflo(u); x0[1] = bfhi(u); }
            if (ts0 >= 2) { const unsigned u = *(const unsigned*)(zp - 2 * NZM); x1[0] = bflo(u); x1[1] = bfhi(u); }
            if (ts0 >= 1) { const unsigned u = *(const unsigned*)(zp - 1 * NZM); x2[0] = bflo(u); x2[1] = bfhi(u); }
            LAS unsigned char* dst = (isk ? Ks : Qs) + tl0 * ML_ROWB + e2 * 2;
#pragma unroll 4
            for (int i = 0; i < 32; ++i) {
                const unsigned u = *(const unsigned*)(zp + (size_t)i * NZM); const float x3[2] = {bflo(u), bfhi(u)};
                float o2[2];
#pragma unroll
                for (int q = 0; q < 2; ++q) { const float a = cw[0][q] * x0[q] + cw[1][q] * x1[q] + cw[2][q] * x2[q] + cw[3][q] * x3[q]; o2[q] = a * sigmoidf_(a) * kscale; x0[q] = x1[q]; x1[q] = x2[q]; x2[q] = x3[q]; }
                *(LAS unsigned*)(dst + i * ML_ROWB) = pk2(o2[0], o2[1]);
            }
#pragma unroll
            for (int i = 0; i < 4; ++i) { const int p = tid + 512 * i, row = p >> 4, ch = p & 15;
                const v4u v = *(const v4u*)(zm + (size_t)(m0 + row) * NZM + 1024 + 128 * h + 8 * ch); *(LAS v4u*)(Vs + row * ML_ROWB + ch * 16) = v; }
        }
#pragma unroll
        for (int et = 0; et < 8; ++et)
#pragma unroll
            for (int r = 0; r < 4; ++r) *(LAS unsigned short*)(Cs + (16 * w + 4 * G + r) * ML_ROWB + (16 * et + fr) * 2) = (unsigned short)f2bf(Cacc[et][r]);
        __syncthreads();
        {
            const int lrow = 16 * w + fr;
            bf16x8 qf[4];
#pragma unroll
            for (int ks = 0; ks < 4; ++ks) qf[ks] = *(const LAS bf16x8*)(Qs + lrow * ML_ROWB + (32 * ks + 8 * G) * 2);
            float nq = 0.f;
#pragma unroll
            for (int ks = 0; ks < 4; ++ks)
#pragma unroll
                for (int j = 0; j < 8; ++j) nq += bf2f((unsigned short)qf[ks][j]) * nvec[32 * ks + 8 * G + j];
            nq += __shfl_xor(nq, 16); nq += __shfl_xor(nq, 32);
            const float Ml = Mrow[lrow], si = sint[lrow], ed = eden[lrow];
            f32x4 acc[8];
#pragma unroll
            for (int dt = 0; dt < 8; ++dt) { acc[dt] = (f32x4){0.f, 0.f, 0.f, 0.f};
#pragma unroll
                for (int ks = 0; ks < 4; ++ks) { const bf16x8 a = *(const LAS bf16x8*)(Cs + (16 * dt + fr) * ML_ROWB + (32 * ks + 8 * G) * 2); acc[dt] = __builtin_amdgcn_mfma_f32_16x16x32_bf16(a, qf[ks], acc[dt], 0, 0, 0); }
                acc[dt] = acc[dt] * si; }
            float den = 0.f;
#pragma unroll
            for (int kp = 0; kp < 4; ++kp) {
                if (2 * kp <= w) {
                    float pv[8];
#pragma unroll
                    for (int hh = 0; hh < 2; ++hh) { const int st = 2 * kp + hh;
                        f32x4 s4 = (f32x4){0.f, 0.f, 0.f, 0.f};
                        if (st <= w) {
#pragma unroll
                            for (int ks = 0; ks < 4; ++ks) { const bf16x8 a = *(const LAS bf16x8*)(Ks + (16 * st + fr) * ML_ROWB + (32 * ks + 8 * G) * 2); s4 = __builtin_amdgcn_mfma_f32_16x16x32_bf16(a, qf[ks], s4, 0, 0, 0); }
                        }
                        const f32x4 d4 = *(const LAS f32x4*)(dS + 16 * st + 4 * G);
#pragma unroll
                        for (int r = 0; r < 4; ++r) { const int s = 16 * st + 4 * G + r; const float p = (s <= lrow) ? s4[r] * __expf(d4[r] - Ml) : 0.f; den += p; pv[hh * 4 + r] = p; } }
                    bf16x8 pf; { const unsigned a0 = pk2(pv[0], pv[1]), a1 = pk2(pv[2], pv[3]), a2 = pk2(pv[4], pv[5]), a3 = pk2(pv[6], pv[7]); pf = __builtin_bit_cast(bf16x8, (v4u){a0, a1, a2, a3}); }
                    const LAS unsigned char* vb = Vs + (32 * kp + 4 * G + ((lane >> 2) & 3)) * ML_ROWB + (4 * (lane & 3)) * 2;
#pragma unroll
                    for (int dt = 0; dt < 8; ++dt) { const s16x4 lo = lds_tr16(vb + dt * 32), hi = lds_tr16(vb + 16 * ML_ROWB + dt * 32);
                        acc[dt] = __builtin_amdgcn_mfma_f32_16x16x32_bf16(cat8(lo, hi), pf, acc[dt], 0, 0, 0); }
                }
            }
            den += __shfl_xor(den, 16); den += __shfl_xor(den, 32);
            den += si * nq;
            const float inv = 1.0f / fmaxf(fabsf(den), ed);
            float ss = 0.f;
#pragma unroll
            for (int dt = 0; dt < 8; ++dt) { acc[dt] = acc[dt] * inv; ss += (acc[dt][0] * acc[dt][0] + acc[dt][1] * acc[dt][1]) + (acc[dt][2] * acc[dt][2] + acc[dt][3] * acc[dt][3]); }
            ss += __shfl_xor(ss, 16); ss += __shfl_xor(ss, 32);
            const float rs = 1.0f / sqrtf(ss * (1.0f / 128.0f) + EPS);
            const size_t mrow = (size_t)(m0 + lrow);
#pragma unroll
            for (int dt = 0; dt < 8; ++dt) { const int d0 = 16 * dt + 4 * G;
                const uint2 ov = *(const uint2*)(zm + mrow * NZM + 1536 + 128 * h + d0);
                const f32x4 nw = *(const f32x4*)(normw + 128 * h + d0);
                const float y0 = acc[dt][0] * rs * nw[0] * sigmoidf_(bflo(ov.x)), y1 = acc[dt][1] * rs * nw[1] * sigmoidf_(bfhi(ov.x));
                const float y2 = acc[dt][2] * rs * nw[2] * sigmoidf_(bflo(ov.y)), y3 = acc[dt][3] * rs * nw[3] * sigmoidf_(bfhi(ov.y));
                uint2 o; o.x = pk2(y0, y1); o.y = pk2(y2, y3); *(uint2*)(Y + mrow * DM + 128 * h + d0) = o; }
        }
#pragma unroll
        for (int et = 0; et < 8; ++et) Cacc[et] = Cacc[et] * s_old;
#pragma unroll
        for (int kp = 0; kp < 4; ++kp) {
            const int rb = 32 * kp + 4 * G + ((lane >> 2) & 3), cb = 4 * (lane & 3);
            const s16x4 alo = lds_tr16(Vs + rb * ML_ROWB + (16 * w + cb) * 2), ahi = lds_tr16(Vs + (rb + 16) * ML_ROWB + (16 * w + cb) * 2);
            const f32x4 wl = *(const LAS f32x4*)(wgt + 32 * kp + 4 * G), wh = *(const LAS f32x4*)(wgt + 32 * kp + 16 + 4 * G);
            bf16x8 af; { const unsigned a0 = pk2(bf2f((unsigned short)alo[0]) * wl[0], bf2f((unsigned short)alo[1]) * wl[1]), a1 = pk2(bf2f((unsigned short)alo[2]) * wl[2], bf2f((unsigned short)alo[3]) * wl[3]),
                                          a2 = pk2(bf2f((unsigned short)ahi[0]) * wh[0], bf2f((unsigned short)ahi[1]) * wh[1]), a3 = pk2(bf2f((unsigned short)ahi[2]) * wh[2], bf2f((unsigned short)ahi[3]) * wh[3]);
                af = __builtin_bit_cast(bf16x8, (v4u){a0, a1, a2, a3}); }
#pragma unroll
            for (int et = 0; et < 8; ++et) { const s16x4 blo = lds_tr16(Ks + rb * ML_ROWB + (16 * et + cb) * 2), bhi = lds_tr16(Ks + (rb + 16) * ML_ROWB + (16 * et + cb) * 2);
                Cacc[et] = __builtin_amdgcn_mfma_f32_16x16x32_bf16(af, cat8(blo, bhi), Cacc[et], 0, 0, 0); }
        }
        { const int e = tid & 127, sq = tid >> 7; float p = 0.f;
#pragma unroll 8
            for (int i = 0; i < 32; ++i) { const int s = 32 * sq + i; p += wgt[s] * bf2f(*(const LAS unsigned short*)(Ks + s * ML_ROWB + e * 2)); }
            npart[sq * 128 + e] = p; }
        __syncthreads();
        if (tid < 128) nvec[tid] = s_old * nvec[tid] + ((npart[tid] + npart[128 + tid]) + (npart[256 + tid] + npart[384 + tid]));
        m_prev = m_new;
        __syncthreads();
    }
}

constexpr int RW_R = 0, RW_WD = 16384, RW_K2 = 32768, RW_A2 = 49152, RW_B2 = 65536, RW_V = 81920, RW_YB = 98304;
constexpr int RW_TW = 114688, RW_XA = RW_TW + 64 * 144, RW_SG = RW_XA + 64 * 144, RW_G = RW_SG + 64 * 272, RW_BON = RW_G + 64 * 128;
static_assert(RW_BON + 256 <= MISC_OFF, "rwkv LDS map");
__device__ __forceinline__ int rw_perm(int j) { return (j & 15) * 4 + (j >> 4); }
__device__ __forceinline__ void rwkv_unit(Frame& F, int b, int h) {
    LAS unsigned char* L = F.lds;
    LAS float *R = (LAS float*)(L + RW_R), *WD = (LAS float*)(L + RW_WD), *K2 = (LAS float*)(L + RW_K2), *A2 = (LAS float*)(L + RW_A2), *B2 = (LAS float*)(L + RW_B2), *V = (LAS float*)(L + RW_V), *YB = (LAS float*)(L + RW_YB), *BON = (LAS float*)(L + RW_BON);
    LAS unsigned char *TW = L + RW_TW, *XA = L + RW_XA, *SG = L + RW_SG; LAS unsigned short* Gs = (LAS unsigned short*)(L + RW_G);
    const int tid = F.tid, lane = F.lane, w = F.wave, fr = lane & 15, G = lane >> 4;
    const bf16* zr = (const bf16*)(F.ws + WS_ZR);
    const float* mu = F.in[8];
    const bf16* wup_t = (const bf16*)(F.ws + WS_LORA); const bf16* aup_t = wup_t + 512 * 64; const bf16* gup_t = wup_t + 2 * 512 * 64;
    bf16* Y = (bf16*)(F.ws + WS_Y);
    const int hc0 = 64 * h;
    float s0[4] = {0.f, 0.f, 0.f, 0.f}, s1[4] = {0.f, 0.f, 0.f, 0.f};
    const int tt = w & 3, ct0 = 2 * (w >> 2);
    for (int tb = 0; tb < 32; ++tb) {
        const int t0 = tb * 64; const size_t m0 = (size_t)b * SEQ + t0;
        for (int idx = tid; idx < 224 * 64; idx += NWAVES * 64) {
            const int t = idx / 224, pi = idx - t * 224;
            int zc; if (pi < 96) zc = 512 * (pi >> 5) + hc0 + 2 * (pi & 31); else zc = 1536 + 2 * (pi - 96);
            const bf16* p = zr + (m0 + t) * NZR + zc;
            const unsigned uc = *(const unsigned*)p; const unsigned up = (t0 + t > 0) ? *(const unsigned*)(p - NZR) : 0u;
            const float c0 = bflo(uc), c1 = bfhi(uc), p0 = bflo(up), p1 = bfhi(up);
            const float v0 = c0 + (p0 - c0) * mu[zc], v1 = c1 + (p1 - c1) * mu[zc + 1];
            if (pi < 32) { const int j = 2 * pi; R[t * 64 + rw_perm(j)] = v0; R[t * 64 + rw_perm(j + 1)] = v1; }
            else if (pi < 64) { const int j = 2 * (pi - 32); YB[t * 64 + j] = v0; YB[t * 64 + j + 1] = v1; }
            else if (pi < 96) { const int j = 2 * (pi - 64); V[t * 64 + j] = v0; V[t * 64 + j + 1] = v1; }
            else if (pi < 128) { const int mm = 2 * (pi - 96); *(LAS unsigned*)(TW + t * 144 + mm * 2) = pk2(tanhf(v0), tanhf(v1)); }
            else if (pi < 160) { const int mm = 2 * (pi - 128); *(LAS unsigned*)(XA + t * 144 + mm * 2) = pk2(v0, v1); }
            else { const int mm = 2 * (pi - 160); *(LAS unsigned*)(SG + t * 272 + mm * 2) = pk2(sigmoidf_(v0), sigmoidf_(v1)); }
        }
        __syncthreads();
#pragma unroll
        for (int cc = 0; cc < 2; ++cc) {
            const int ct = ct0 + cc, ch = 16 * ct + fr;
            f32x4 dw = (f32x4){0.f, 0.f, 0.f, 0.f}, da = dw, dg = dw;
#pragma unroll
            for (int ks = 0; ks < 2; ++ks) {
                const bf16x8 a1 = *(const LAS bf16x8*)(TW + (16 * tt + fr) * 144 + (32 * ks + 8 * G) * 2), a2 = *(const LAS bf16x8*)(XA + (16 * tt + fr) * 144 + (32 * ks + 8 * G) * 2);
                const bf16x8 b1 = *(const bf16x8*)(wup_t + (size_t)(hc0 + ch) * 64 + 32 * ks + 8 * G), b2 = *(const bf16x8*)(aup_t + (size_t)(hc0 + ch) * 64 + 32 * ks + 8 * G);
                dw = __builtin_amdgcn_mfma_f32_16x16x32_bf16(a1, b1, dw, 0, 0, 0); da = __builtin_amdgcn_mfma_f32_16x16x32_bf16(a2, b2, da, 0, 0, 0); }
#pragma unroll
            for (int ks = 0; ks < 4; ++ks) {
                const bf16x8 a3 = *(const LAS bf16x8*)(SG + (16 * tt + fr) * 272 + (32 * ks + 8 * G) * 2);
                const bf16x8 b3 = *(const bf16x8*)(gup_t + (size_t)(hc0 + ch) * 128 + 32 * ks + 8 * G);
                dg = __builtin_amdgcn_mfma_f32_16x16x32_bf16(a3, b3, dg, 0, 0, 0); }
            const float w0v = F.in[9][hc0 + ch], a0v = F.in[11][hc0 + ch];
#pragma unroll
            for (int r = 0; r < 4; ++r) { const int t = 16 * tt + 4 * G + r;
                WD[t * 64 + rw_perm(ch)] = __expf(-0.6065306597126334f * sigmoidf_(dw[r] + w0v));
                B2[t * 64 + rw_perm(ch)] = sigmoidf_(da[r] + a0v);
                Gs[t * 64 + ch] = (unsigned short)f2bf(dg[r]); }
        }
        __syncthreads();
        { const int t = tid >> 3, cg = tid & 7; float kr[8], kk[8]; float ssq = 0.f, bon = 0.f;
#pragma unroll
            for (int i = 0; i < 8; ++i) { const int ch = 8 * cg + i; kr[i] = YB[t * 64 + ch]; kk[i] = kr[i] * F.in[14][hc0 + ch]; ssq += kk[i] * kk[i]; }
            ssq = row8_sum(ssq);
            const float inv = 1.0f / fmaxf(sqrtf(ssq), 1e-12f);
#pragma unroll
            for (int i = 0; i < 8; ++i) { const int ch = 8 * cg + i, pp = t * 64 + rw_perm(ch); const float alr = B2[pp]; const float kn = kk[i] * inv;
                const float k2 = kr[i] * (1.0f + (alr - 1.0f) * F.in[15][hc0 + ch]);
                K2[pp] = k2; A2[pp] = -kn; B2[pp] = kn * alr; bon += R[pp] * k2 * F.in[16][hc0 + ch]; }
            bon = row8_sum(bon);
            if (cg == 0) BON[t] = bon; }
        __syncthreads();
        { const int i0 = 8 * w + 2 * G;
#pragma unroll 2
            for (int t = 0; t < 64; ++t) {
                const f32x4 a4 = *(const LAS f32x4*)(A2 + t * 64 + 4 * fr), w4 = *(const LAS f32x4*)(WD + t * 64 + 4 * fr), b4 = *(const LAS f32x4*)(B2 + t * 64 + 4 * fr);
                const f32x4 k4 = *(const LAS f32x4*)(K2 + t * 64 + 4 * fr), r4 = *(const LAS f32x4*)(R + t * 64 + 4 * fr);
                const f32x2 v2 = *(const LAS f32x2*)(V + t * 64 + i0);
                float sa0 = (s0[0] * a4[0] + s0[1] * a4[1]) + (s0[2] * a4[2] + s0[3] * a4[3]);
                float sa1 = (s1[0] * a4[0] + s1[1] * a4[1]) + (s1[2] * a4[2] + s1[3] * a4[3]);
                sa0 = row16_sum(sa0); sa1 = row16_sum(sa1);
#pragma unroll
                for (int c = 0; c < 4; ++c) { s0[c] = s0[c] * w4[c] + sa0 * b4[c] + v2.x * k4[c]; s1[c] = s1[c] * w4[c] + sa1 * b4[c] + v2.y * k4[c]; }
                float y0 = (s0[0] * r4[0] + s0[1] * r4[1]) + (s0[2] * r4[2] + s0[3] * r4[3]);
                float y1 = (s1[0] * r4[0] + s1[1] * r4[1]) + (s1[2] * r4[2] + s1[3] * r4[3]);
                y0 = row16_sum(y0); y1 = row16_sum(y1);
                if (fr == 0) *(LAS f32x2*)(YB + t * 64 + i0) = (f32x2){y0, y1};
            } }
        __syncthreads();
        { const int t = tid >> 3, cg = tid & 7; float y[8]; float s = 0.f;
#pragma unroll
            for (int i = 0; i < 8; ++i) { y[i] = YB[t * 64 + 8 * cg + i]; s += y[i]; }
            const float mean = row8_sum(s) * (1.0f / 64.0f); float q = 0.f;
#pragma unroll
            for (int i = 0; i < 8; ++i) { y[i] -= mean; q += y[i] * y[i]; }
            const float rstd = 1.0f / sqrtf(row8_sum(q) * (1.0f / 64.0f) + RWKV_LN_EPS); const float bon = BON[t];
            float o[8];
#pragma unroll
            for (int i = 0; i < 8; ++i) { const int ch = 8 * cg + i; const float yn = y[i] * rstd * F.in[17][hc0 + ch] + F.in[18][hc0 + ch] + bon * V[t * 64 + ch]; o[i] = yn * bf2f(Gs[t * 64 + ch]); }
            v4u ov; ov.x = pk2(o[0], o[1]); ov.y = pk2(o[2], o[3]); ov.z = pk2(o[4], o[5]); ov.w = pk2(o[6], o[7]);
            *(v4u*)(Y + (m0 + t) * DM + 512 + hc0 + 8 * cg) = ov; }
        __syncthreads();
    }
}

typedef float f32x16 __attribute__((ext_vector_type(16)));
constexpr int AT_ROWB = 528;
__device__ __forceinline__ void attn_load_tile(Frame& F, const bf16* src  ) {
#pragma unroll
    for (int i = 0; i < 16; ++i) { const int p = F.tid + 512 * i, key = p >> 5, ch = p & 31;
        const v4u v = *(const v4u*)(src + (size_t)key * 2048 + 8 * ch); *(LAS v4u*)(F.lds + key * AT_ROWB + ch * 16) = v; }
}
__device__ __forceinline__ void attn_unit(Frame& F, int b, int hd, int qt) {
    const int lane = F.lane, w = F.wave, r32 = lane & 31, hi = lane >> 5;
    const bf16* kv = (const bf16*)(F.ws + WS_KV) + (size_t)b * MEMT * 2048 + 256 * hd;
    bf16* QO = (bf16*)(F.ws + WS_QO);
    const size_t qrow = (size_t)b * SEQ + 256 * qt + 32 * w + r32;
    attn_load_tile(F, kv);
    bf16x8 qf[16];
#pragma unroll
    for (int ks = 0; ks < 16; ++ks) qf[ks] = *(const bf16x8*)(QO + qrow * DM + 256 * hd + 16 * ks + 8 * hi);
    __syncthreads();
    float mxh[2], smh[2];
    bf16x8 pf[16];
#pragma unroll
    for (int half = 0; half < 2; ++half) {
        f32x16 s[4];
#pragma unroll
        for (int k4 = 0; k4 < 4; ++k4) { const int kt = 4 * half + k4;
#pragma unroll
            for (int r = 0; r < 16; ++r) s[k4][r] = 0.f;
#pragma unroll
            for (int ks = 0; ks < 16; ++ks) { const bf16x8 a = *(const LAS bf16x8*)(F.lds + (32 * kt + r32) * AT_ROWB + (16 * ks + 8 * hi) * 2);
                s[k4] = __builtin_amdgcn_mfma_f32_32x32x16_bf16(a, qf[ks], s[k4], 0, 0, 0); }
        }
        float mx = -INFINITY;
#pragma unroll
        for (int k4 = 0; k4 < 4; ++k4)
#pragma unroll
            for (int r = 0; r < 16; ++r) mx = fmaxf(mx, s[k4][r]);
        mx = fmaxf(mx, __shfl_xor(mx, 32));
        float sum = 0.f;
#pragma unroll
        for (int k4 = 0; k4 < 4; ++k4) {
#pragma unroll
            for (int r = 0; r < 16; ++r) { s[k4][r] = __builtin_amdgcn_exp2f(s[k4][r] - mx); sum += s[k4][r]; }
#pragma unroll
            for (int ss = 0; ss < 2; ++ss) { const unsigned a0 = pk2(s[k4][8 * ss + 0], s[k4][8 * ss + 1]), a1 = pk2(s[k4][8 * ss + 2], s[k4][8 * ss + 3]), a2 = pk2(s[k4][8 * ss + 4], s[k4][8 * ss + 5]), a3 = pk2(s[k4][8 * ss + 6], s[k4][8 * ss + 7]);
                pf[8 * half + 2 * k4 + ss] = __builtin_bit_cast(bf16x8, (v4u){a0, a1, a2, a3}); }
        }
        sum += __shfl_xor(sum, 32);
        mxh[half] = mx; smh[half] = sum;
    }
    __syncthreads();
    attn_load_tile(F, kv + 1024);
    const float mxa = fmaxf(mxh[0], mxh[1]);
    float f0 = __builtin_amdgcn_exp2f(mxh[0] - mxa), f1 = __builtin_amdgcn_exp2f(mxh[1] - mxa);
    const float inv = 1.0f / (f0 * smh[0] + f1 * smh[1]);
    f0 *= inv; f1 *= inv;
    __syncthreads();
    const int G4 = lane >> 4;
    const LAS unsigned char* vb = F.lds + (4 * (G4 >> 1) + ((lane >> 2) & 3)) * AT_ROWB + (16 * (G4 & 1) + 4 * (lane & 3)) * 2;
#pragma unroll 1
    for (int dt = 0; dt < 8; ++dt) {
        f32x16 oa, ob;
#pragma unroll
        for (int r = 0; r < 16; ++r) { oa[r] = 0.f; ob[r] = 0.f; }
#pragma unroll
        for (int kk = 0; kk < 8; ++kk) { const s16x4 lo = lds_tr16(vb + (16 * kk) * AT_ROWB + dt * 64), hi4 = lds_tr16(vb + (16 * kk + 8) * AT_ROWB + dt * 64);
            oa = __builtin_amdgcn_mfma_f32_32x32x16_bf16(cat8(lo, hi4), pf[kk], oa, 0, 0, 0);
            const s16x4 lo2 = lds_tr16(vb + (16 * kk + 128) * AT_ROWB + dt * 64), hi42 = lds_tr16(vb + (16 * kk + 136) * AT_ROWB + dt * 64);
            ob = __builtin_amdgcn_mfma_f32_32x32x16_bf16(cat8(lo2, hi42), pf[kk + 8], ob, 0, 0, 0); }
#pragma unroll
        for (int rg = 0; rg < 4; ++rg) { uint2 ov; ov.x = pk2(oa[4 * rg + 0] * f0 + ob[4 * rg + 0] * f1, oa[4 * rg + 1] * f0 + ob[4 * rg + 1] * f1); ov.y = pk2(oa[4 * rg + 2] * f0 + ob[4 * rg + 2] * f1, oa[4 * rg + 3] * f0 + ob[4 * rg + 3] * f1);
            *(uint2*)(QO + qrow * DM + 256 * hd + 32 * dt + 8 * rg + 4 * hi) = ov; }
    }
    __syncthreads();
}

#ifndef MK_N_LAUNCHES
#define MK_N_LAUNCHES 10
#endif
constexpr int N_PHASES = 10;
struct Args { const float* in[30]; float* out; unsigned char* ws; int ph_lo, ph_hi; };
__global__ void __launch_bounds__(NWAVES * 64, 2) mega_fwd(Args args) {
    extern __shared__ __attribute__((aligned(16))) unsigned char lds[];
    Frame F;
    F.lds = (LAS unsigned char*)lds;
    F.tid = threadIdx.x; F.lane = F.tid & 63; F.wave = __builtin_amdgcn_readfirstlane(F.tid >> 6);
    F.G = gridDim.x; { const int bx = blockIdx.x; F.vcu = (F.G % 8 == 0) ? (bx % 8) * (F.G / 8) + bx / 8 : bx; }
#pragma unroll
    for (int i = 0; i < 30; ++i) F.in[i] = args.in[i];
    F.out = args.out; F.ws = args.ws;
    unsigned char* ws = args.ws;
    volatile LAS unsigned* MISC = (volatile LAS unsigned*)(F.lds + MISC_OFF);
    if (F.tid < 64) MISC[F.tid] = 0u;
    __syncthreads();
    const int lo = args.ph_lo, hi = args.ph_hi;
    const bool multi = (hi - lo) > 1;
    XcdBarrier bar; bar.bar = (unsigned*)(ws + WS_CTL) + CW_BAR; bar.x = 0; bar.st = nullptr;
    if (multi) bar = xcd_barrier_post((unsigned*)(ws + WS_CTL) + CW_BAR, MISC + 8);
#ifndef PHASE_MASK
#define PHASE_MASK 0x3ff
#endif
#define IN(k) (((PHASE_MASK >> (k)) & 1) && lo <= (k) && (k) < hi)
#define SEAM(k) do { if (IN(k) && IN((k) + 1)) xcd_barrier(bar); } while (0)
    typedef pg8::bf16_t b16;
    if (IN(0)) { p0_prologue(F); }
    SEAM(0);
    if (IN(1)) {
        pg8::Gemm g{(const b16*)(ws + WS_XN), (const b16*)(ws + WS_WIN), M + MM, NZ + 2048, DM};
        pg8::Order2 S; S.init(F.G, (int)blockIdx.x);
        pg8::EpiZ E{(b16*)(ws + WS_ZM), (b16*)(ws + WS_ZR), (b16*)(ws + WS_KV)};
        pg8::gemm_phase<pg8::EpiZ, pg8::Order2, true, true>(F.lds, g, S, E);
    }
    SEAM(1);
    if (IN(2)) {
        for (int u = F.vcu; u < 128; u += F.G) rwkv_unit(F, u >> 3, u & 7);
        for (int u = F.vcu; u < 192; u += F.G) if (u >= 128) mlstm_unit(F, (u - 128) >> 2, (u - 128) & 3);
    }
    SEAM(2);
    if (IN(3)) {
        pg8::Gemm g{(const b16*)(ws + WS_Y), (const b16*)(ws + WS_WMIX), M, DM, DM};
        pg8::StaticOrder S; S.init(M, DM, F.G, (int)blockIdx.x);
        pg8::EpiRes<true> E{F.in[0], F.out, (b16*)(ws + WS_H1B), (float*)(ws + WS_SSQ1)};
        pg8::gemm_phase<pg8::EpiRes<true>, pg8::StaticOrder, true, true>(F.lds, g, S, E);
    }
    SEAM(3);
    if (IN(4)) {
        pg8::Gemm g{(const b16*)(ws + WS_H1B), (const b16*)(ws + WS_WQ), M, DM, DM};
        pg8::StaticOrder S; S.init(M, DM, F.G, (int)blockIdx.x);
        pg8::EpiQ E{(b16*)(ws + WS_QO), (const float*)(ws + WS_SSQ1), EPS, LOG2E * 0.0625f};
        pg8::gemm_phase<pg8::EpiQ, pg8::StaticOrder, true, true>(F.lds, g, S, E);
    }
    SEAM(4);
    if (IN(5)) {
        for (int u = F.vcu; u < 512; u += F.G) { const int idx = (u % 256) * 2 + u / 256;
            attn_unit(F, idx >> 5, (idx >> 3) & 3, idx & 7); }
    }
    SEAM(5);
    if (IN(6)) {
        pg8::Gemm g{(const b16*)(ws + WS_QO), (const b16*)(ws + WS_WO), M, DM, DM};
        pg8::StaticOrder S; S.init(M, DM, F.G, (int)blockIdx.x);
        pg8::EpiRes<true> E{F.out, F.out, (b16*)(ws + WS_H2B), (float*)(ws + WS_SSQ2)};
        pg8::gemm_phase<pg8::EpiRes<true>, pg8::StaticOrder, true, true>(F.lds, g, S, E);
    }
    SEAM(6);
    if (IN(7)) {
        pg8::Gemm g{(const b16*)(ws + WS_H2B), (const b16*)(ws + WS_WGU), M, 2 * DFF, DM};
        pg8::StaticOrder S; S.init(M, 2 * DFF, F.G, (int)blockIdx.x);
        pg8::EpiGlu E{(b16*)(ws + WS_ACT), (const float*)(ws + WS_SSQ2), EPS};
        pg8::gemm_phase<pg8::EpiGlu, pg8::StaticOrder, true, true>(F.lds, g, S, E);
    }
    SEAM(7);
    if (IN(8)) {
        pg8::Gemm g{(const b16*)(ws + WS_ACT), (const b16*)(ws + WS_WD), M, DM, DFF};
        pg8::StaticOrder S; S.init(M, DM, F.G, (int)blockIdx.x);
        pg8::EpiRes<false> E{F.out, F.out, nullptr, (float*)(ws + WS_SSQ3)};
        pg8::gemm_phase<pg8::EpiRes<false>, pg8::StaticOrder, true, true>(F.lds, g, S, E);
    }
    SEAM(8);
    if (IN(9)) { final_norm(F); }
#undef IN
#undef SEAM
}

extern "C" void kernel_launch(void* const* d_in, const int* in_sizes, int n_in, void* d_out, int out_size, void* d_ws, size_t ws_size, hipStream_t stream) {
    static int grid = 0;
    if (grid == 0) {
        if (n_in != 30 || in_sizes[0] != M * DM || out_size != M * DM || ws_size < WS_END) { fprintf(stderr, "kernel_launch: unexpected problem: n_in %d in0 %d out %d ws %zu (need %zu); nothing launched\n", n_in, n_in > 0 ? in_sizes[0] : -1, out_size, ws_size, (size_t)WS_END); grid = -1; return; }
        int dev = 0, cus = 0, per_cu = 0;
        if (hipGetDevice(&dev) != hipSuccess || hipDeviceGetAttribute(&cus, hipDeviceAttributeMultiprocessorCount, dev) != hipSuccess) { grid = -1; return; }
        if (hipFuncSetAttribute((const void*)mega_fwd, hipFuncAttributeMaxDynamicSharedMemorySize, LDS_BYTES) != hipSuccess) { fprintf(stderr, "kernel_launch: hipFuncSetAttribute(%d B LDS) failed\n", LDS_BYTES); grid = -1; return; }
        if (hipOccupancyMaxActiveBlocksPerMultiprocessor(&per_cu, (const void*)mega_fwd, NWAVES * 64, LDS_BYTES) != hipSuccess || per_cu < 1) { fprintf(stderr, "kernel_launch: occupancy query says %d blocks per CU\n", per_cu); }
        (void)hipGetLastError();
        grid = cus;
    }
    if (grid < 0) return;
    (void)hipMemsetAsync((char*)d_ws + WS_CTL, 0, CTL_ZERO_BYTES, stream);
    Args a{};
    for (int i = 0; i < 30; ++i) a.in[i] = (const float*)d_in[i];
    a.out = (float*)d_out; a.ws = (unsigned char*)d_ws;
#if MK_N_LAUNCHES == 1
    a.ph_lo = 0; a.ph_hi = N_PHASES;
    hipLaunchKernelGGL(mega_fwd, dim3(grid), dim3(NWAVES * 64), LDS_BYTES, stream, a);
#else
    for (int p = 0; p < N_PHASES; ++p) { a.ph_lo = p; a.ph_hi = p + 1; hipLaunchKernelGGL(mega_fwd, dim3(grid), dim3(NWAVES * 64), LDS_BYTES, stream, a); }
#endif
}
```

```cpp
#include <hip/hip_runtime.h>
#include <hip/hip_bf16.h>
#include <cstdio>
#include <cstdint>
namespace pg8 {
#define PG8_LAS __attribute__((address_space(3)))
typedef unsigned short bf16_t;
typedef short bf16x8 __attribute__((ext_vector_type(8)));
typedef float f32x4 __attribute__((ext_vector_type(4)));
typedef unsigned u32x4 __attribute__((ext_vector_type(4)));
constexpr int BM = 256, BK = 64, HALF = 128, HTB = HALF * BK * 2  , STAGE_BYTES = 8 * HTB, NXCD = 8, WGM = 4;

__host__ __device__ __forceinline__ int lds_byte(int r, int c) { const int st = (r >> 4) * 2 + (c >> 5), rr = r & 15, cc = c & 31, ob = rr * 64 + cc * 2; return st * 1024 + (ob ^ (((ob >> 9) & 1) << 5)); }
__host__ __device__ __forceinline__ void stage_rc(int b, int& R, int& C) { const int st = b / 1024, sb = b % 1024, swz = sb ^ (((sb >> 9) & 1) << 5); R = (st >> 1) * 16 + swz / 64; C = (st & 1) * 32 + (swz % 64) / 2; }
__host__ __device__ __forceinline__ int perm32(int rho) { const int n = rho >> 4, i = rho & 15; return 8 * (i >> 2) + 4 * n + (i & 3); }

struct Unit { int pm, pn, ph; };
struct Gemm { const bf16_t* A; const bf16_t* Bt; int M, N, K; };

struct NoChain {
    static constexpr int A_AUX = 0;
    __device__ __forceinline__ const char* pa(const Gemm& g, const Unit& u, size_t tstep) const { return (const char*)g.A + (size_t)u.pm * tstep; }
    __device__ __forceinline__ const char* pb(const Gemm& g, const Unit& u, size_t tstep) const { return (const char*)g.Bt + (size_t)u.pn * tstep; }
    __device__ __forceinline__ void a_ready(const Unit&) const {}
    __device__ __forceinline__ void done(const Unit&) const {}
    __device__ __forceinline__ void flush() const {}
};
struct StaticOrder : NoChain {
    int nM, nN, nwg, G, c;
    __host__ __device__ void init(int M, int N, int G_, int c_) { nM = M / BM; nN = N / BM; nwg = nM * nN; G = G_; c = c_; }
    __host__ __device__ bool next(int i, Unit& u) const {
        const long L = (long)i * G + c; if (L >= nwg) return false;
        int wgid = (int)L; { const int q = nwg / NXCD, r = nwg % NXCD, xcd = wgid % NXCD, off = wgid / NXCD; wgid = (xcd < r ? xcd * (q + 1) : r * (q + 1) + (xcd - r) * q) + off; }
        const int nig = WGM * nN, gid = wgid / nig, fm = gid * WGM, gsz = (nM - fm) < WGM ? (nM - fm) : WGM;
        u.pm = fm + ((wgid % nig) % gsz); u.pn = (wgid % nig) / gsz; return true;
    }
};

__device__ __forceinline__ unsigned cvt_pk_bf16(float lo, float hi) { unsigned r; asm volatile("v_cvt_pk_bf16_f32 %0, %1, %2" : "=v"(r) : "v"(lo), "v"(hi)); return r; }
typedef float f32x2 __attribute__((ext_vector_type(2)));

struct Order2 : NoChain {
    StaticOrder so; int G, c;
    __device__ void init(int G_, int c_) { so.init(32768, 3840, G_, c_); G = G_; c = c_; }
    __device__ bool next(int i, Unit& u) const {
        const long L = (long)i * G + c;
        if (L < 1920) return so.next(i, u);
        const int Lp = (int)(L - 1920); if (Lp >= 128) return false;
        const int xcd = Lp & 7, off = Lp >> 3;
        u.pm = 128 + xcd * 2 + (off & 1); u.pn = 15 + (off >> 1); return true;
    }
};

struct OrderQ : NoChain {
    int G, vcu;
    __device__ void init(int G_, int vcu_) { G = G_; vcu = vcu_; }
    __device__ bool next(int i, Unit& u) const {
        const int U = vcu + G * i; if (U >= 512) return false;
        const int idx = (U % 256) * 2 + U / 256;
        u.pm = 8 * (idx >> 5) + (idx & 7); u.pn = (idx >> 3) & 3; return true;
    }
};


struct EpiZ {
    static constexpr bool PERM = true, AFTER_DRAIN = false;
    __device__ __forceinline__ void prefetch(const Unit&, PG8_LAS unsigned char*, int, int) const {}
    bf16_t* zm; bf16_t* zr; bf16_t* kv;
    __device__ __forceinline__ void operator()(const f32x4 (&acc)[2][2][4][2], const Unit& u, int wr, int wc, int fr, int fq) const {
        bf16_t* base; int ldc; int urow = u.pm * BM + wr * 64; int colt;
        if (u.pm < 128) { if (u.pn < 8) { base = zm; ldc = 2048; colt = u.pn * BM; } else { base = zr; ldc = 1792; colt = (u.pn - 8) * BM; } }
        else { base = kv; ldc = 2048; colt = (u.pn - 15) * BM; urow -= 32768; }
        const unsigned lo = (unsigned)(fr * ldc + 8 * fq) * 2u;
#pragma unroll
        for (int ai = 0; ai < 2; ++ai)
#pragma unroll
            for (int m = 0; m < 4; ++m) { char* ub = (char*)base + ((size_t)(urow + ai * HALF + m * 16) * ldc + colt + wc * 32) * 2;
#pragma unroll
                for (int bj = 0; bj < 2; ++bj) { const f32x4 v0 = acc[ai][bj][m][0], v1 = acc[ai][bj][m][1];
                    u32x4 w; w.x = cvt_pk_bf16(v0[0], v0[1]); w.y = cvt_pk_bf16(v0[2], v0[3]); w.z = cvt_pk_bf16(v1[0], v1[1]); w.w = cvt_pk_bf16(v1[2], v1[3]);
                    *(u32x4*)(ub + bj * HALF * 2 + lo) = w; } }
    }
};

__device__ __forceinline__ float row_rstd16(const float* ssq, int row, float eps) {
    const f32x4* p = (const f32x4*)(ssq + (size_t)row * 16);
    const f32x4 a = p[0], b = p[1], c = p[2], d = p[3];
    const float s = ((a[0] + a[1]) + (a[2] + a[3])) + ((b[0] + b[1]) + (b[2] + b[3])) + ((c[0] + c[1]) + (c[2] + c[3])) + ((d[0] + d[1]) + (d[2] + d[3]));
    return 1.0f / sqrtf(s * (1.0f / 1024.0f) + eps);
}
__device__ __forceinline__ void rows_rstd(const float* ssq, int row0, int fq, float eps, float (&rs)[2][4]) {
    f32x4 pp[2][4];
#pragma unroll
    for (int ai = 0; ai < 2; ++ai)
#pragma unroll
        for (int m = 0; m < 4; ++m) pp[ai][m] = *(const f32x4*)(ssq + (size_t)(row0 + ai * HALF + m * 16) * 16 + 4 * fq);
#pragma unroll
    for (int ai = 0; ai < 2; ++ai)
#pragma unroll
        for (int m = 0; m < 4; ++m) { float t = (pp[ai][m][0] + pp[ai][m][1]) + (pp[ai][m][2] + pp[ai][m][3]); t += __shfl_xor(t, 16); t += __shfl_xor(t, 32); rs[ai][m] = 1.0f / sqrtf(t * (1.0f / 1024.0f) + eps); }
}

constexpr int SSQ_LDS = 131072;
__device__ __forceinline__ void ssq_prefetch(const float* ssq, int pm, PG8_LAS unsigned char* lds, int wid, int lane) {
    const char* g = (const char*)(ssq + ((size_t)pm * BM + 32 * wid) * 16) + lane * 16;
#pragma unroll
    for (int i = 0; i < 2; ++i) __builtin_amdgcn_global_load_lds((const unsigned*)(g + i * 1024), (PG8_LAS unsigned*)(lds + SSQ_LDS + wid * 2048 + i * 1024), 16, 0, 0);
}
__device__ __forceinline__ void rows_rstd_lds(const PG8_LAS unsigned char* lds, int rt0  , int fq, float eps, float (&rs)[2][4]) {
    f32x4 pp[2][4];
#pragma unroll
    for (int ai = 0; ai < 2; ++ai)
#pragma unroll
        for (int m = 0; m < 4; ++m) pp[ai][m] = *(const PG8_LAS f32x4*)(lds + SSQ_LDS + (rt0 + ai * HALF + m * 16) * 64 + 16 * fq);
#pragma unroll
    for (int ai = 0; ai < 2; ++ai)
#pragma unroll
        for (int m = 0; m < 4; ++m) { float t = (pp[ai][m][0] + pp[ai][m][1]) + (pp[ai][m][2] + pp[ai][m][3]); t += __shfl_xor(t, 16); t += __shfl_xor(t, 32); rs[ai][m] = 1.0f / sqrtf(t * (1.0f / 1024.0f) + eps); }
}

struct EpiRes {
    static constexpr bool PERM = true, AFTER_DRAIN = false;
    __device__ __forceinline__ void prefetch(const Unit&, PG8_LAS unsigned char*, int, int) const {}
    const bf16_t* base; bf16_t* hb; float* ssq; const float* rscale;
    __device__ __forceinline__ void operator()(const f32x4 (&acc)[2][2][4][2], const Unit& u, int wr, int wc, int fr, int fq) const {
        const int row0 = u.pm * BM + wr * 64 + fr, col0 = u.pn * BM + wc * 32 + 8 * fq;
        u32x4 bb[2][4][2];
#pragma unroll
        for (int ai = 0; ai < 2; ++ai)
#pragma unroll
            for (int m = 0; m < 4; ++m) { const int row = row0 + ai * HALF + m * 16;
#pragma unroll
                for (int bj = 0; bj < 2; ++bj) bb[ai][m][bj] = *(const u32x4*)(base + (size_t)row * 1024 + col0 + bj * HALF); }
        __builtin_amdgcn_sched_barrier(0);
#pragma unroll
        for (int ai = 0; ai < 2; ++ai)
#pragma unroll
            for (int m = 0; m < 4; ++m) { const int row = row0 + ai * HALF + m * 16; const size_t off = (size_t)row * 1024 + col0; float ss = 0.f; const float r_ = rscale ? rscale[row] : 1.0f;
#pragma unroll
                for (int bj = 0; bj < 2; ++bj) { const u32x4 b4 = bb[ai][m][bj];
                    const f32x4 b0 = (f32x4){__builtin_bit_cast(float, b4.x << 16), __builtin_bit_cast(float, b4.x & 0xffff0000u), __builtin_bit_cast(float, b4.y << 16), __builtin_bit_cast(float, b4.y & 0xffff0000u)};
                    const f32x4 b1 = (f32x4){__builtin_bit_cast(float, b4.z << 16), __builtin_bit_cast(float, b4.z & 0xffff0000u), __builtin_bit_cast(float, b4.w << 16), __builtin_bit_cast(float, b4.w & 0xffff0000u)};
                    const f32x4 v0 = acc[ai][bj][m][0] + b0 * r_, v1 = acc[ai][bj][m][1] + b1 * r_;
                    ss += (v0[0] * v0[0] + v0[1] * v0[1]) + (v0[2] * v0[2] + v0[3] * v0[3]) + (v1[0] * v1[0] + v1[1] * v1[1]) + (v1[2] * v1[2] + v1[3] * v1[3]);
                    u32x4 w; w.x = cvt_pk_bf16(v0[0], v0[1]); w.y = cvt_pk_bf16(v0[2], v0[3]); w.z = cvt_pk_bf16(v1[0], v1[1]); w.w = cvt_pk_bf16(v1[2], v1[3]);
                    *(u32x4*)(hb + off + bj * HALF) = w; }
                ss += __shfl_xor(ss, 16); ss += __shfl_xor(ss, 32);
                if (fq == 0) ssq[(size_t)row * 16 + u.pn * 4 + wc] = ss; }
    }
};

struct EpiResF32 {
    static constexpr bool PERM = true, AFTER_DRAIN = false;
    __device__ __forceinline__ void prefetch(const Unit&, PG8_LAS unsigned char*, int, int) const {}
    const float* base; bf16_t* hb; float* ssq;
    __device__ __forceinline__ void operator()(const f32x4 (&acc)[2][2][4][2], const Unit& u, int wr, int wc, int fr, int fq) const {
        const int row0 = u.pm * BM + wr * 64 + fr, col0 = u.pn * BM + wc * 32 + 8 * fq;
#pragma unroll
        for (int ai = 0; ai < 2; ++ai) {
            f32x4 bb[4][2][2];
#pragma unroll
            for (int m = 0; m < 4; ++m) { const size_t off = (size_t)(row0 + ai * HALF + m * 16) * 1024 + col0;
#pragma unroll
                for (int bj = 0; bj < 2; ++bj) { bb[m][bj][0] = *(const f32x4*)(base + off + bj * HALF); bb[m][bj][1] = *(const f32x4*)(base + off + bj * HALF + 4); } }
            __builtin_amdgcn_sched_barrier(0);
#pragma unroll
            for (int m = 0; m < 4; ++m) { const int row = row0 + ai * HALF + m * 16; const size_t off = (size_t)row * 1024 + col0; float ss = 0.f;
#pragma unroll
                for (int bj = 0; bj < 2; ++bj) { const f32x4 v0 = acc[ai][bj][m][0] + bb[m][bj][0], v1 = acc[ai][bj][m][1] + bb[m][bj][1];
                    ss += (v0[0] * v0[0] + v0[1] * v0[1]) + (v0[2] * v0[2] + v0[3] * v0[3]) + (v1[0] * v1[0] + v1[1] * v1[1]) + (v1[2] * v1[2] + v1[3] * v1[3]);
                    u32x4 w; w.x = cvt_pk_bf16(v0[0], v0[1]); w.y = cvt_pk_bf16(v0[2], v0[3]); w.z = cvt_pk_bf16(v1[0], v1[1]); w.w = cvt_pk_bf16(v1[2], v1[3]);
                    *(u32x4*)(hb + off + bj * HALF) = w; }
                ss += __shfl_xor(ss, 16); ss += __shfl_xor(ss, 32);
                if (fq == 0) ssq[(size_t)row * 16 + u.pn * 4 + wc] = ss; }
            __builtin_amdgcn_sched_barrier(0);
        }
    }
};

struct EpiQ {
    static constexpr bool PERM = true, AFTER_DRAIN = false;
    bf16_t* q; const float* ssq; float eps, scale; PG8_LAS unsigned char* lds;
    __device__ __forceinline__ void prefetch(const Unit& u, PG8_LAS unsigned char* l, int wid, int lane) const { ssq_prefetch(ssq, u.pm, l, wid, lane); }
    __device__ __forceinline__ void operator()(const f32x4 (&acc)[2][2][4][2], const Unit& u, int wr, int wc, int fr, int fq) const {
        const int row0 = u.pm * BM + wr * 64 + fr, col0 = u.pn * BM + wc * 32 + 8 * fq;
        float rs8[2][4]; rows_rstd_lds(lds, wr * 64 + fr, fq, eps, rs8);
#pragma unroll
        for (int ai = 0; ai < 2; ++ai)
#pragma unroll
            for (int m = 0; m < 4; ++m) { const float rs = rs8[ai][m] * scale;
                char* ub = (char*)q + ((size_t)(u.pm * BM + wr * 64 + ai * HALF + m * 16) * 1024 + u.pn * BM + wc * 32) * 2;
#pragma unroll
                for (int bj = 0; bj < 2; ++bj) { const f32x4 v0 = acc[ai][bj][m][0] * rs, v1 = acc[ai][bj][m][1] * rs;
                    u32x4 w; w.x = cvt_pk_bf16(v0[0], v0[1]); w.y = cvt_pk_bf16(v0[2], v0[3]); w.z = cvt_pk_bf16(v1[0], v1[1]); w.w = cvt_pk_bf16(v1[2], v1[3]);
                    *(u32x4*)(ub + bj * HALF * 2 + (unsigned)(fr * 1024 + 8 * fq) * 2u) = w; } }
    }
};

typedef float f32x2cv_ __attribute__((ext_vector_type(2))); typedef __bf16 bf16x2cv_ __attribute__((ext_vector_type(2)));
__device__ __forceinline__ unsigned pk2f(float lo, float hi) { f32x2cv_ v = {lo, hi}; bf16x2cv_ b = __builtin_convertvector(v, bf16x2cv_); return __builtin_bit_cast(unsigned, b); }
typedef float f32x2e __attribute__((ext_vector_type(2)));
struct EpiGlu {
    static constexpr bool PERM = true, AFTER_DRAIN = false;
    bf16_t* act; const float* ssq; float eps; PG8_LAS unsigned char* lds;
    __device__ __forceinline__ void prefetch(const Unit& u, PG8_LAS unsigned char* l, int wid, int lane) const { ssq_prefetch(ssq, u.pm, l, wid, lane); }
    __device__ __forceinline__ void operator()(const f32x4 (&acc)[2][2][4][2], const Unit& u, int wr, int wc, int fr, int fq) const {
        const int row0 = u.pm * BM + wr * 64 + fr, col0 = u.pn * HALF + wc * 32 + 8 * fq;
        float rs8[2][4]; rows_rstd_lds(lds, wr * 64 + fr, fq, eps, rs8);
#pragma unroll
        for (int ai = 0; ai < 2; ++ai)
#pragma unroll
            for (int m = 0; m < 4; ++m) { const int row = row0 + ai * HALF + m * 16; const float rs = rs8[ai][m];
                const f32x2e c1 = {-1.4426950408889634f * rs, -1.4426950408889634f * rs}, c2 = {rs * rs, rs * rs}, one = {1.0f, 1.0f};
                unsigned wv[4];
#pragma unroll
                for (int n = 0; n < 2; ++n)
#pragma unroll
                    for (int hp = 0; hp < 2; ++hp) { const f32x2e g2 = {acc[ai][0][m][n][2 * hp], acc[ai][0][m][n][2 * hp + 1]}, u2 = {acc[ai][1][m][n][2 * hp], acc[ai][1][m][n][2 * hp + 1]};
                        const f32x2e t2 = g2 * c1; f32x2e e2; e2.x = __builtin_amdgcn_exp2f(t2.x); e2.y = __builtin_amdgcn_exp2f(t2.y);
                        const f32x2e d2 = e2 + one; f32x2e r2; r2.x = __builtin_amdgcn_rcpf(d2.x); r2.y = __builtin_amdgcn_rcpf(d2.y);
                        const f32x2e o2 = ((g2 * u2) * c2) * r2;
                        wv[2 * n + hp] = pk2f(o2.x, o2.y); }
                u32x4 w; w.x = wv[0]; w.y = wv[1]; w.z = wv[2]; w.w = wv[3];
                *(u32x4*)(act + (size_t)row * 2816 + col0) = w; }
    }
};
template <class Epi, class Sched, bool ALIGN_EPI = false, bool SP2 = false>
__device__ __forceinline__ void gemm_phase(PG8_LAS unsigned char* lds, const Gemm g, const Sched& S, const Epi& E) {
    const int tid = threadIdx.x, wid = __builtin_amdgcn_readfirstlane(tid >> 6), lane = tid & 63, wr = wid >> 2, wc = wid & 3, fr = lane & 15, fq = lane >> 4;
    const int K = g.K, nt = K / BK;
    unsigned voffA[2], voffB[2];
#pragma unroll
    for (int i = 0; i < 2; ++i) { int R, C; stage_rc(tid * 16 + i * 8192, R, C); const int Rb = Epi::PERM ? ((R & ~31) + perm32(R & 31)) : R;
        voffA[i] = (unsigned)(R * K + C) * 2u; voffB[i] = (unsigned)(Rb * K + C) * 2u; }
    const size_t kstep = (size_t)(BK * 2);
    const size_t hstep = (size_t)HALF * K * 2;
    const size_t tstep = 2 * hstep;
    const unsigned ldsw = (unsigned)wid * 1024u;
    const int aoff = lds_byte(wr * 64 + fr, fq * 8), boff = lds_byte(wc * 32 + fr, fq * 8);
#define PG8_SA(b, h) (((b) * 2 + (h)) * HTB)
#define PG8_SB(b, h) ((4 + (b) * 2 + (h)) * HTB)
#define PG8_STAGE(bufoff, gbase, voff) do { _Pragma("unroll") for (int _i = 0; _i < 2; ++_i) \
        __builtin_amdgcn_global_load_lds((const unsigned*)((const char*)(gbase) + (voff)[_i]), (PG8_LAS unsigned*)(lds + (bufoff) + ldsw + _i * 8192), 16, 0, 0); } while (0)
#define PG8_STAGEA(bufoff, gbase, voff) do { _Pragma("unroll") for (int _i = 0; _i < 2; ++_i) \
        __builtin_amdgcn_global_load_lds((const unsigned*)((const char*)(gbase) + (voff)[_i]), (PG8_LAS unsigned*)(lds + (bufoff) + ldsw + _i * 8192), 16, 0, Sched::A_AUX); } while (0)
#define PG8_LDA(dst, b, h) do { _Pragma("unroll") for (int m = 0; m < 4; ++m) _Pragma("unroll") for (int k = 0; k < 2; ++k) dst[m][k] = *(const PG8_LAS bf16x8*)(lds + PG8_SA(b, h) + aoff + m * 2048 + k * 1024); } while (0)
#define PG8_LDB(dst, b, h) do { _Pragma("unroll") for (int n = 0; n < 2; ++n) _Pragma("unroll") for (int k = 0; k < 2; ++k) dst[n][k] = *(const PG8_LAS bf16x8*)(lds + PG8_SB(b, h) + boff + n * 2048 + k * 1024); } while (0)
#define PG8_MMA(ai, bj, At, Bt) do { __builtin_amdgcn_s_setprio(1); _Pragma("unroll") for (int m = 0; m < 4; ++m) _Pragma("unroll") for (int n = 0; n < 2; ++n) _Pragma("unroll") for (int k = 0; k < 2; ++k) \
        acc[ai][bj][m][n] = __builtin_amdgcn_mfma_f32_16x16x32_bf16(Bt[n][k], At[m][k], acc[ai][bj][m][n], 0, 0, 0); __builtin_amdgcn_s_setprio(0); } while (0)
#define PG8_WAIT_V(n) asm volatile("s_waitcnt vmcnt(" #n ")" ::: "memory")
#define PG8_WAIT_L(n) asm volatile("s_waitcnt lgkmcnt(" #n ")" ::: "memory")
#define PG8_BAR __builtin_amdgcn_s_barrier()
#define PG8_SCHED __builtin_amdgcn_sched_barrier(0)
    Unit cur, nxt; int ui = 0;
    if (!S.next(0, cur)) return;
    f32x4 acc[2][2][4][2];
#pragma unroll
    for (int a = 0; a < 2; ++a)
#pragma unroll
        for (int b = 0; b < 2; ++b)
#pragma unroll
            for (int m = 0; m < 4; ++m)
#pragma unroll
                for (int n = 0; n < 2; ++n) acc[a][b][m][n] = (f32x4){0.f, 0.f, 0.f, 0.f};
    bf16x8 At[4][2], B0[2][2], B1[2][2];
    const char* cA = S.pa(g, cur, tstep); const char* cB = S.pb(g, cur, tstep);
    S.a_ready(cur);
    if constexpr (SP2) {
        PG8_STAGE(PG8_SB(0, 0), cB, voffB); PG8_STAGE(PG8_SB(0, 1), cB + hstep, voffB); PG8_STAGEA(PG8_SA(0, 0), cA, voffA); PG8_STAGEA(PG8_SA(0, 1), cA + hstep, voffA);
        if (wr == 1) PG8_BAR;
        PG8_WAIT_V(2); PG8_BAR;
        PG8_STAGE(PG8_SB(1, 0), cB + kstep, voffB); PG8_STAGEA(PG8_SA(1, 0), cA + kstep, voffA); PG8_STAGE(PG8_SB(1, 1), cB + hstep + kstep, voffB);
        PG8_WAIT_V(6); PG8_BAR;
    } else {
        PG8_STAGE(PG8_SB(0, 0), cB, voffB); PG8_STAGEA(PG8_SA(0, 0), cA, voffA); PG8_STAGE(PG8_SB(0, 1), cB + hstep, voffB); PG8_STAGEA(PG8_SA(0, 1), cA + hstep, voffA);
        if (wr == 1) PG8_BAR;
        PG8_WAIT_V(4); PG8_BAR;
        PG8_STAGE(PG8_SB(1, 0), cB + kstep, voffB); PG8_STAGEA(PG8_SA(1, 0), cA + kstep, voffA); PG8_STAGE(PG8_SB(1, 1), cB + hstep + kstep, voffB);
        PG8_WAIT_V(6); PG8_BAR;
    }
    for (;;) {
        const bool has_next = S.next(ui + 1, nxt);
        const char* nA = has_next ? S.pa(g, nxt, tstep) : cA; const char* nB = has_next ? S.pb(g, nxt, tstep) : cB;
        for (int t = 0; t < nt; t += 2) {
            const bool last = (t == nt - 2);
            const char* a1 = cA + (size_t)(t + 1) * kstep;
            const char* a2 = last ? nA : cA + (size_t)(t + 2) * kstep; const char* b2 = last ? nB : cB + (size_t)(t + 2) * kstep;
            const char* a3 = a2 + kstep; const char* b3 = b2 + kstep;
            if (last) E.prefetch(cur, lds, wid, lane);
            if (last && has_next) S.a_ready(nxt);
            if (t == 2) S.flush();
            if constexpr (SP2) {
            PG8_LDB(B0, 0, 0); PG8_LDB(B1, 0, 1); PG8_SCHED; PG8_LDA(At, 0, 0); PG8_STAGEA(PG8_SA(1, 1), a1 + hstep, voffA);
            PG8_WAIT_V(8); PG8_WAIT_L(0); PG8_BAR; PG8_MMA(0, 0, At, B0); PG8_MMA(0, 1, At, B1); PG8_BAR; PG8_SCHED;
            PG8_LDA(At, 0, 1); PG8_STAGE(PG8_SB(0, 0), b2, voffB); PG8_STAGE(PG8_SB(0, 1), b2 + hstep, voffB); PG8_STAGEA(PG8_SA(0, 0), a2, voffA);
            PG8_WAIT_V(8); PG8_WAIT_L(0); PG8_BAR; PG8_MMA(1, 0, At, B0); PG8_MMA(1, 1, At, B1); PG8_BAR; PG8_SCHED;
            PG8_LDB(B0, 1, 0); PG8_LDB(B1, 1, 1); PG8_SCHED; PG8_LDA(At, 1, 0); PG8_STAGEA(PG8_SA(0, 1), a2 + hstep, voffA);
            PG8_WAIT_V(8); PG8_WAIT_L(0); PG8_BAR; PG8_MMA(0, 0, At, B0); PG8_MMA(0, 1, At, B1); PG8_BAR; PG8_SCHED;
            PG8_LDA(At, 1, 1); PG8_STAGE(PG8_SB(1, 0), b3, voffB); PG8_STAGE(PG8_SB(1, 1), b3 + hstep, voffB); PG8_STAGEA(PG8_SA(1, 0), a3, voffA);
            PG8_WAIT_V(8); PG8_WAIT_L(0); PG8_BAR; PG8_MMA(1, 0, At, B0); PG8_MMA(1, 1, At, B1); PG8_BAR; PG8_SCHED;
            } else {
            PG8_LDB(B0, 0, 0); PG8_SCHED; PG8_LDA(At, 0, 0); PG8_STAGEA(PG8_SA(1, 1), a1 + hstep, voffA);
            PG8_WAIT_L(8); PG8_BAR; PG8_WAIT_L(0); PG8_MMA(0, 0, At, B0); PG8_BAR; PG8_SCHED;
            PG8_LDB(B1, 0, 1); PG8_STAGE(PG8_SB(0, 0), b2, voffB);
            PG8_BAR; PG8_WAIT_L(0); PG8_MMA(0, 1, At, B1); PG8_BAR;
            PG8_LDA(At, 0, 1); PG8_STAGEA(PG8_SA(0, 0), a2, voffA);
            PG8_BAR; PG8_WAIT_L(0); PG8_MMA(1, 0, At, B0); PG8_BAR; PG8_SCHED;
            PG8_STAGE(PG8_SB(0, 1), b2 + hstep, voffB);
            PG8_WAIT_V(6); PG8_BAR; PG8_MMA(1, 1, At, B1); PG8_BAR;
            PG8_LDB(B0, 1, 0); PG8_SCHED; PG8_LDA(At, 1, 0); PG8_STAGEA(PG8_SA(0, 1), a2 + hstep, voffA);
            PG8_WAIT_L(8); PG8_BAR; PG8_WAIT_L(0); PG8_MMA(0, 0, At, B0); PG8_BAR; PG8_SCHED;
            PG8_LDB(B1, 1, 1); PG8_STAGE(PG8_SB(1, 0), b3, voffB);
            PG8_BAR; PG8_WAIT_L(0); PG8_MMA(0, 1, At, B1); PG8_BAR;
            PG8_LDA(At, 1, 1); PG8_STAGEA(PG8_SA(1, 0), a3, voffA);
            PG8_BAR; PG8_WAIT_L(0); PG8_MMA(1, 0, At, B0); PG8_BAR; PG8_SCHED;
            PG8_STAGE(PG8_SB(1, 1), b3 + hstep, voffB);
            PG8_WAIT_V(6); PG8_BAR; PG8_MMA(1, 1, At, B1); PG8_BAR;
            }
        }
        if constexpr (ALIGN_EPI) { if (wr == 0) PG8_BAR; }
        if constexpr (!Epi::AFTER_DRAIN) { E(acc, cur, wr, wc, fr, fq); S.done(cur); }
        if (!has_next) break;
#pragma unroll
        for (int a = 0; a < 2; ++a)
#pragma unroll
            for (int b = 0; b < 2; ++b)
#pragma unroll
                for (int m = 0; m < 4; ++m)
#pragma unroll
                    for (int n = 0; n < 2; ++n) { typedef double d2v_ __attribute__((ext_vector_type(2))); double z0_, z1_;
                        asm volatile("v_mov_b64 %0, 0\n\tv_mov_b64 %1, 0" : "=v"(z0_), "=v"(z1_));
                        acc[a][b][m][n] = __builtin_bit_cast(f32x4, (d2v_){z0_, z1_}); }
        cur = nxt; cA = nA; cB = nB; ++ui;
        if constexpr (ALIGN_EPI) { if (wr == 1) PG8_BAR; }
    }
    PG8_WAIT_V(0);
    S.flush();
    if constexpr (!ALIGN_EPI) { if (wr == 0) PG8_BAR; }
    PG8_BAR;
    if constexpr (Epi::AFTER_DRAIN) { E.fused(acc, cur, wr, wc, fr, fq, lds, wid, lane); S.done(cur); }
#undef PG8_SA
#undef PG8_SB
#undef PG8_STAGE
#undef PG8_STAGEA
#undef PG8_LDA
#undef PG8_LDB
#undef PG8_MMA
#undef PG8_WAIT_V
#undef PG8_WAIT_L
#undef PG8_BAR
#undef PG8_SCHED
}
}
#define GAS __attribute__((address_space(1)))
#define LAS __attribute__((address_space(3)))
typedef unsigned short bf16;
typedef unsigned v4u __attribute__((ext_vector_type(4)));
typedef float f32x4 __attribute__((ext_vector_type(4)));
typedef short bf16x8 __attribute__((ext_vector_type(8)));
typedef GAS unsigned gu32;
typedef GAS unsigned long long gu64;
#define RLX_AGENT __ATOMIC_RELAXED, __HIP_MEMORY_SCOPE_AGENT
#define LDS_WAIT() asm volatile("s_waitcnt lgkmcnt(0)" ::: "memory")
#define VM_WAIT() asm volatile("s_waitcnt vmcnt(0)" ::: "memory")
__device__ __forceinline__ unsigned long long rt() { return __builtin_amdgcn_s_memrealtime(); }
typedef float f32x2_cv __attribute__((ext_vector_type(2))); typedef __bf16 bf16x2_cv __attribute__((ext_vector_type(2)));
__device__ __forceinline__ unsigned pk2(float lo, float hi) { f32x2_cv v = {lo, hi}; bf16x2_cv b = __builtin_convertvector(v, bf16x2_cv); return __builtin_bit_cast(unsigned, b); }
__device__ __forceinline__ unsigned f2bf(float f) { return pk2(f, 0.f) & 0xffffu; }

#define XB_TMO      128
#define XB_XCNT(j)  (256  + 64 * (j))
#define XB_XSUB(j)  (1280 + 64 * (j))
#define XB_XGEN(j)  (2304 + 64 * (j))
#define XB_TOP      3328
#define XB_TOPGEN   3392
#define XCD_BAR_WORDS 3456
#define XB_SPIN_CAP (1u << 18)

__device__ __forceinline__ unsigned xb_ld(unsigned* p)              { return __hip_atomic_load(p, __ATOMIC_RELAXED, __HIP_MEMORY_SCOPE_AGENT); }
__device__ __forceinline__ unsigned xb_add(unsigned* p, unsigned v) { return __hip_atomic_fetch_add(p, v, __ATOMIC_RELAXED, __HIP_MEMORY_SCOPE_AGENT); }
__device__ __forceinline__ unsigned xb_xcc_id() { return (unsigned)__builtin_amdgcn_s_getreg((3 << 11) | 20) & 0xFu; }
#define XB_SPIN(cond, bar) do { unsigned _sp = 0; while (cond) { __builtin_amdgcn_s_sleep(1); \
    if ((++_sp & 255u) == 0u) { if (xb_ld(&(bar)[XB_TMO])) break; if (_sp > XB_SPIN_CAP) { atomicAdd(&(bar)[XB_TMO], 1u); break; } } } } while (0)

struct XcdBarrier {
    unsigned* bar; unsigned x;
    volatile LAS unsigned* st;
};

__device__ __forceinline__ XcdBarrier xcd_barrier_post(unsigned* bar, volatile LAS unsigned* st) {
    XcdBarrier b; b.bar = bar; b.x = xb_xcc_id(); b.st = st;
    if (threadIdx.x == 0) (void)xb_add(&bar[XB_XCNT(b.x)], 1u);
    return b;
}
__device__ __forceinline__ void xcd_barrier_complete(unsigned* bar, unsigned x, unsigned& nloc, unsigned& nx) {
    const unsigned G = gridDim.x * gridDim.y * gridDim.z;
    unsigned sum, cnt, mine, sp = 0u;
    for (;;) {
        sum = 0u; cnt = 0u; mine = 0u;
#pragma unroll
        for (unsigned j = 0; j < 16; ++j) { const unsigned c = xb_ld(&bar[XB_XCNT(j)]); sum += c; cnt += (c > 0u) ? 1u : 0u; mine = (j == x) ? c : mine; }
        if (sum == G) break;
        __builtin_amdgcn_s_sleep(1);
        if ((++sp & 255u) == 0u) { if (xb_ld(&bar[XB_TMO])) break; if (sp > XB_SPIN_CAP) { atomicAdd(&bar[XB_TMO], 1u); break; } }
    }
    nloc = mine > 0u ? mine : 1u; nx = cnt > 0u ? cnt : 1u;
}

__device__ __forceinline__ void xcd_barrier(const XcdBarrier& b) {
    asm volatile("s_waitcnt vmcnt(0)" ::: "memory");
    __syncthreads();
    if (threadIdx.x == 0) {
        unsigned* bar = b.bar;
        __builtin_amdgcn_s_waitcnt(0);
        unsigned nloc = b.st[0], nx = b.st[1];
        if (nloc == 0u) { xcd_barrier_complete(bar, b.x, nloc, nx); b.st[0] = nloc; b.st[1] = nx; }
        const unsigned old = xb_add(&bar[XB_XSUB(b.x)], 1u);
        const unsigned gen = old / nloc;
        if (old + 1u == (gen + 1u) * nloc) {
            __builtin_amdgcn_fence(__ATOMIC_RELEASE, "agent");
            asm volatile("s_waitcnt vmcnt(0)" ::: "memory");
            const unsigned og = xb_add(&bar[XB_TOP], 1u);
            const unsigned tg = og / nx;
            if (og + 1u == (tg + 1u) * nx) xb_add(&bar[XB_TOPGEN], 1u);
            else XB_SPIN(xb_ld(&bar[XB_TOPGEN]) == tg, bar);
            __builtin_amdgcn_fence(__ATOMIC_ACQUIRE, "agent");
            xb_add(&bar[XB_XGEN(b.x)], 1u);
            asm volatile("s_waitcnt vmcnt(0)" ::: "memory");
        } else {
            XB_SPIN(xb_ld(&bar[XB_XGEN(b.x)]) == gen, bar);
            __builtin_amdgcn_fence(__ATOMIC_ACQUIRE, "agent");
            asm volatile("s_waitcnt vmcnt(0)" ::: "memory");
        }
    }
    __syncthreads();
}

__device__ __forceinline__ void xcd_barrier_local(const XcdBarrier& b) {
    asm volatile("s_waitcnt vmcnt(0)" ::: "memory");
    __syncthreads();
    if (threadIdx.x == 0) {
        unsigned* bar = b.bar;
        __builtin_amdgcn_s_waitcnt(0);
        const unsigned nloc = b.st[0];
        const unsigned old = xb_add(&bar[XB_XSUB(b.x)], 1u);
        const unsigned gen = old / nloc;
        if (old + 1u == (gen + 1u) * nloc) xb_add(&bar[XB_XGEN(b.x)], 1u);
        else XB_SPIN(xb_ld(&bar[XB_XGEN(b.x)]) == gen, bar);
        __builtin_amdgcn_fence(__ATOMIC_ACQUIRE, "agent");
        asm volatile("s_waitcnt vmcnt(0)" ::: "memory");
    }
    __syncthreads();
}

namespace pg8 {
constexpr int CH_STRIDE = 32;
__device__ __forceinline__ int ch_word(int stage, int pm) { return CH_STRIDE * (128 * stage + pm); }
__device__ __forceinline__ bool ch_lane0() { return __builtin_amdgcn_mbcnt_hi(~0u, __builtin_amdgcn_mbcnt_lo(~0u, 0u)) == 0u; }
__device__ __forceinline__ void ch_wait(unsigned* w, unsigned need, unsigned* tmo) {
    unsigned sp = 0;
    while ((unsigned)__builtin_amdgcn_readfirstlane(__hip_atomic_load(w, __ATOMIC_RELAXED, __HIP_MEMORY_SCOPE_AGENT)) < need) {
        __builtin_amdgcn_s_sleep(1);
        if ((++sp & 255u) == 0u) { if (__builtin_amdgcn_readfirstlane(__hip_atomic_load(tmo, __ATOMIC_RELAXED, __HIP_MEMORY_SCOPE_AGENT)) != 0u) break; if (sp > XB_SPIN_CAP) { if (ch_lane0()) atomicAdd(tmo, 1u); break; } }
    }
}
constexpr int CH_LDS_ARRIVE = 163840 - 256 + 48;
__device__ __forceinline__ void ch_arrive(unsigned* w, bool colo) {
    if (colo) { if (ch_lane0()) (void)__hip_atomic_fetch_add(w, 1u, __ATOMIC_RELAXED, __HIP_MEMORY_SCOPE_AGENT); }
    else {
        unsigned old = 0u;
        if (ch_lane0()) old = __hip_atomic_fetch_add((LAS unsigned*)CH_LDS_ARRIVE, 1u, __ATOMIC_RELAXED, __HIP_MEMORY_SCOPE_WORKGROUP);
        old = (unsigned)__builtin_amdgcn_readfirstlane(old);
        if ((old & 7u) == 7u) { __builtin_amdgcn_fence(__ATOMIC_RELEASE, "agent"); asm volatile("s_waitcnt vmcnt(0)" ::: "memory");
            if (ch_lane0()) (void)__hip_atomic_fetch_add(w, 8u, __ATOMIC_RELAXED, __HIP_MEMORY_SCOPE_AGENT); }
    }
}
__device__ __forceinline__ void ch_publish_now(unsigned* w, bool colo) {
    asm volatile("s_waitcnt vmcnt(0)" ::: "memory");
    ch_arrive(w, colo);
}
struct ChainHooks {
    static constexpr int A_AUX = 0;
    unsigned* chn; unsigned* tmo; bool colo; int wave;
    int wait_k0, wait_k1, pub_k0, pub_k1; unsigned need0, need1;
    mutable int pend, acq;
    __device__ __forceinline__ void hooks_init(unsigned* chn_, unsigned* tmo_, bool colo_, int wave_) { chn = chn_; tmo = tmo_; colo = colo_; wave = wave_; pend = -1; acq = -1; }
    __device__ __forceinline__ void a_ready(const Unit& u) const {
        const int k = u.ph ? wait_k1 : wait_k0; if (k < 0) return;
        const int w = ch_word(k, u.pm); if (w == acq) return;
        acq = w;
        if (wave == 0) {
            ch_wait(chn + w, u.ph ? need1 : need0, tmo);
            if (!colo) { __builtin_amdgcn_fence(__ATOMIC_ACQUIRE, "agent"); asm volatile("s_waitcnt vmcnt(0)" ::: "memory"); }
        }
        asm volatile("" ::: "memory"); __builtin_amdgcn_s_barrier(); asm volatile("" ::: "memory");
    }
    __device__ __forceinline__ void done(const Unit& u) const {
        const int k = u.ph ? pub_k1 : pub_k0; if (k < 0) return;
        const int w = ch_word(k, u.pm);
        if (colo) pend = w; else ch_publish_now(chn + w, false);
    }
    __device__ __forceinline__ void flush() const {
        if (pend >= 0) { if (ch_lane0()) (void)__hip_atomic_fetch_add(chn + pend, 1u, __ATOMIC_RELAXED, __HIP_MEMORY_SCOPE_AGENT); pend = -1; }
    }
};
template <class O0, class O1> struct StreamOrder : ChainHooks {
    O0 o0; O1 o1; int n0; const bf16_t* A1; const bf16_t* B1;
    __device__ __forceinline__ void count0() { n0 = 0; Unit t; while (o0.next(n0, t)) ++n0; }
    __device__ __forceinline__ bool next(int i, Unit& u) const { if (i < n0) { u.ph = 0; return o0.next(i, u); } u.ph = 1; return o1.next(i - n0, u); }
    __device__ __forceinline__ const char* pa(const Gemm& g, const Unit& u, size_t tstep) const { return (const char*)(u.ph ? A1 : g.A) + (size_t)u.pm * tstep; }
    __device__ __forceinline__ const char* pb(const Gemm& g, const Unit& u, size_t tstep) const { return (const char*)(u.ph ? B1 : g.Bt) + (size_t)u.pn * tstep; }
};
struct ChainOrder : ChainHooks {
    StaticOrder so;
    __device__ __forceinline__ bool next(int i, Unit& u) const { u.ph = 0; return so.next(i, u); }
    __device__ __forceinline__ const char* pa(const Gemm& g, const Unit& u, size_t tstep) const { return (const char*)g.A + (size_t)u.pm * tstep; }
    __device__ __forceinline__ const char* pb(const Gemm& g, const Unit& u, size_t tstep) const { return (const char*)g.Bt + (size_t)u.pn * tstep; }
};
template <int N> __device__ __forceinline__ void ch_wait_n(unsigned* w0, int stride, unsigned need, unsigned* tmo, bool colo) {
    unsigned v[N];
#pragma unroll
    for (int k = 0; k < N; ++k) v[k] = __hip_atomic_load(w0 + stride * k, __ATOMIC_RELAXED, __HIP_MEMORY_SCOPE_AGENT);
    bool ok = true;
#pragma unroll
    for (int k = 0; k < N; ++k) ok = ok && ((unsigned)__builtin_amdgcn_readfirstlane(v[k]) >= need);
    if (!ok) {
#pragma unroll 1
        for (int k = 0; k < N; ++k) ch_wait(w0 + stride * k, need, tmo); }
    if (!colo) { __builtin_amdgcn_fence(__ATOMIC_ACQUIRE, "agent"); asm volatile("s_waitcnt vmcnt(0)" ::: "memory"); }
}
struct Order2C : ChainHooks {
    Order2 o;
    __device__ __forceinline__ bool next(int i, Unit& u) const { u.ph = 0; return o.next(i, u); }
    __device__ __forceinline__ const char* pa(const Gemm& g, const Unit& u, size_t tstep) const { return (const char*)g.A + (size_t)u.pm * tstep; }
    __device__ __forceinline__ const char* pb(const Gemm& g, const Unit& u, size_t tstep) const { return (const char*)g.Bt + (size_t)u.pn * tstep; }
};
template <class E0, class E1> struct EpiPair {
    static constexpr bool PERM = E0::PERM, AFTER_DRAIN = false;
    static_assert(E0::PERM == E1::PERM && !E0::AFTER_DRAIN && !E1::AFTER_DRAIN, "EpiPair");
    E0 e0; E1 e1;
    __device__ __forceinline__ void prefetch(const Unit& u, PG8_LAS unsigned char* l, int wid, int lane) const { if (u.ph == 0) e0.prefetch(u, l, wid, lane); else e1.prefetch(u, l, wid, lane); }
    __device__ __forceinline__ void operator()(const f32x4 (&acc)[2][2][4][2], const Unit& u, int wr, int wc, int fr, int fq) const {
        if (u.ph == 0) e0(acc, u, wr, wc, fr, fq); else e1(acc, u, wr, wc, fr, fq);
    }
};
}

namespace pg8 {
struct EpiResNorm {
    static constexpr bool PERM = true, AFTER_DRAIN = false;
    __device__ __forceinline__ void prefetch(const Unit&, PG8_LAS unsigned char*, int, int) const {}
    const bf16_t* base; float* out; float* ssq; const float* gain; float eps;
    unsigned* chn; unsigned* tmo; bool colo, ychk;
    __device__ __forceinline__ void operator()(const f32x4 (&acc)[2][2][4][2], const Unit& u, int wr, int wc, int fr, int fq) const {
        const int row0 = u.pm * BM + wr * 64 + fr, col0 = u.pn * BM + wc * 32 + 8 * fq;
        u32x4 bb[2][4][2];
#pragma unroll
        for (int ai = 0; ai < 2; ++ai)
#pragma unroll
            for (int m = 0; m < 4; ++m) { const int row = row0 + ai * HALF + m * 16;
#pragma unroll
                for (int bj = 0; bj < 2; ++bj) bb[ai][m][bj] = *(const u32x4*)(base + (size_t)row * 1024 + col0 + bj * HALF); }
        __builtin_amdgcn_sched_barrier(0);
        f32x4 v[2][4][2][2];
#pragma unroll
        for (int ai = 0; ai < 2; ++ai)
#pragma unroll
            for (int m = 0; m < 4; ++m) { const int row = row0 + ai * HALF + m * 16; float ss = 0.f;
#pragma unroll
                for (int bj = 0; bj < 2; ++bj) { const u32x4 b4 = bb[ai][m][bj];
                    const f32x4 b0 = (f32x4){__builtin_bit_cast(float, b4.x << 16), __builtin_bit_cast(float, b4.x & 0xffff0000u), __builtin_bit_cast(float, b4.y << 16), __builtin_bit_cast(float, b4.y & 0xffff0000u)};
                    const f32x4 b1 = (f32x4){__builtin_bit_cast(float, b4.z << 16), __builtin_bit_cast(float, b4.z & 0xffff0000u), __builtin_bit_cast(float, b4.w << 16), __builtin_bit_cast(float, b4.w & 0xffff0000u)};
                    const f32x4 v0 = acc[ai][bj][m][0] + b0, v1 = acc[ai][bj][m][1] + b1;
                    ss += (v0[0] * v0[0] + v0[1] * v0[1]) + (v0[2] * v0[2] + v0[3] * v0[3]) + (v1[0] * v1[0] + v1[1] * v1[1]) + (v1[2] * v1[2] + v1[3] * v1[3]);
                    v[ai][m][bj][0] = v0; v[ai][m][bj][1] = v1; }
                ss += __shfl_xor(ss, 16); ss += __shfl_xor(ss, 32);
                if (fq == 0) ssq[(size_t)row * 16 + u.pn * 4 + wc] = ss; }
        unsigned* w = chn + ch_word(4, u.pm);
        ch_publish_now(w, colo);
        ch_wait(w, 32u, tmo);
        if (ychk && u.pm < 64) ch_wait(chn + ch_word(5, u.pm >> 3), 32u, tmo);
        if (u.pm >= 64) { ch_wait(chn + ch_word(2, 2 * (u.pm - 64)), 32u, tmo); ch_wait(chn + ch_word(2, 2 * (u.pm - 64) + 1), 32u, tmo); }
        if (!colo) { __builtin_amdgcn_fence(__ATOMIC_ACQUIRE, "agent"); asm volatile("s_waitcnt vmcnt(0)" ::: "memory"); }
        float rs8[2][4]; rows_rstd(ssq, row0, fq, eps, rs8);
        f32x4 gv[2][2];
#pragma unroll
        for (int bj = 0; bj < 2; ++bj) { gv[bj][0] = *(const f32x4*)(gain + col0 + bj * HALF); gv[bj][1] = *(const f32x4*)(gain + col0 + bj * HALF + 4); }
#pragma unroll
        for (int ai = 0; ai < 2; ++ai)
#pragma unroll
            for (int m = 0; m < 4; ++m) { const int row = row0 + ai * HALF + m * 16; float* o = out + (size_t)row * 1024 + col0; const float rs = rs8[ai][m];
#pragma unroll
                for (int bj = 0; bj < 2; ++bj) { *(f32x4*)(o + bj * HALF) = v[ai][m][bj][0] * rs * gv[bj][0]; *(f32x4*)(o + bj * HALF + 4) = v[ai][m][bj][1] * rs * gv[bj][1]; } }
    }
};
}

__device__ __forceinline__ void wsplit_arrive(const XcdBarrier& b, unsigned* wb) {
    asm volatile("s_waitcnt vmcnt(0)" ::: "memory");
    __syncthreads();
    if (threadIdx.x == 0) {
        const unsigned nloc = b.st[0];
        const unsigned old = xb_add(&wb[64 * b.x], 1u);
        if (old + 1u == nloc) { __builtin_amdgcn_fence(__ATOMIC_RELEASE, "agent"); asm volatile("s_waitcnt vmcnt(0)" ::: "memory"); xb_add(&wb[64 * 16], 1u); }
    }
}
__device__ __forceinline__ void wsplit_wait(const XcdBarrier& b, unsigned* wb) {
    if (threadIdx.x == 0) {
        const unsigned nx = b.st[1];
        XB_SPIN(xb_ld(&wb[64 * 16]) < nx, b.bar);
        __builtin_amdgcn_fence(__ATOMIC_ACQUIRE, "agent"); asm volatile("s_waitcnt vmcnt(0)" ::: "memory");
    }
    __syncthreads();
}

typedef float f32x2 __attribute__((ext_vector_type(2)));
typedef unsigned u32x2v __attribute__((ext_vector_type(2)));
constexpr int NWAVES = 8;
constexpr int BATCH = 16, SEQ = 2048, DM = 1024, M = BATCH * SEQ;
constexpr int MEMT = 256, MM = BATCH * MEMT;
constexpr int DIN = 3848, NZM = 2048, NZR = 1792, NZ = NZM + NZR;
constexpr int DFF = 2816;
constexpr float EPS = 1e-6f, RWKV_LN_EPS = 64e-5f;
constexpr float LOG2E = 1.4426950408889634f;

constexpr size_t MiB = 1u << 20;
constexpr size_t WS_CTL = 0, CTL_ZERO_BYTES = 320 * 1024;
constexpr size_t WS_ZG = 1 * MiB;
constexpr size_t WS_SSQ1 = 2 * MiB, WS_SSQ2 = 4 * MiB, WS_SSQ3 = 6 * MiB;
constexpr size_t WS_RMS = 43 * MiB + 512 * 1024;
constexpr size_t WS_WIN = 8 * MiB;
constexpr size_t WS_WKV = WS_WIN + (size_t)NZ * DM * 2;
constexpr size_t WS_WMIX = 20 * MiB, WS_WQ = 22 * MiB, WS_WO = 24 * MiB, WS_WGU = 26 * MiB  , WS_WD = 37 * MiB  ;
constexpr size_t WS_LORA = 43 * MiB;
constexpr size_t WS_KV = 44 * MiB;
constexpr size_t WS_XN = 60 * MiB;
constexpr size_t WS_MN = WS_XN + (size_t)M * DM * 2;
constexpr size_t WS_ZM = 132 * MiB;
constexpr size_t WS_ZR = 260 * MiB;
constexpr size_t WS_H1B = WS_XN;
constexpr size_t OUT_QO = 64 * MiB;
constexpr size_t WS_OB = WS_ZR + 64 * MiB;
constexpr size_t WS_H2B = WS_XN;
constexpr size_t WS_H3B = WS_XN;
constexpr size_t WS_ACT = WS_ZR + 64 * MiB;
constexpr size_t WS_E = 372 * MiB, WS_AL = 436 * MiB, WS_GG = 468 * MiB;
constexpr size_t WS_END = 500 * MiB;
static_assert(WS_WKV + (size_t)2048 * DM * 2 <= WS_WMIX && WS_WD + (size_t)DM * DFF * 2 <= WS_LORA && WS_MN + (size_t)MM * DM * 2 <= WS_ZM && WS_ZR + (size_t)M * NZR * 2 <= WS_END && WS_ACT + (size_t)M * DFF * 2 <= WS_END, "d_ws map");
constexpr int CW_BAR = 1024;
constexpr int CW_CHN = 16384;
constexpr int CW_WSP = 9216;
constexpr int CW_GRP = 8192;

constexpr int LDS_BYTES = 163840;
constexpr int MISC_OFF = LDS_BYTES - 256; static_assert(pg8::CH_LDS_ARRIVE == LDS_BYTES - 256 + 48, "p3_chain's LDS arrival word is MISC[12]");
constexpr int MISC_OFF_ = MISC_OFF;

__device__ __forceinline__ float bf2f(unsigned short h) { return __builtin_bit_cast(float, (unsigned)h << 16); }
__device__ __forceinline__ float bflo(unsigned w) { return __builtin_bit_cast(float, w << 16); }
__device__ __forceinline__ float bfhi(unsigned w) { return __builtin_bit_cast(float, w & 0xffff0000u); }
__device__ __forceinline__ float sigmoidf_(float x) { return __builtin_amdgcn_rcpf(1.0f + __builtin_amdgcn_exp2f(-LOG2E * x)); }
__device__ __forceinline__ float expf_(float x) { return __builtin_amdgcn_exp2f(LOG2E * x); }
__device__ __forceinline__ float wave_sum(float v) {
#pragma unroll
    for (int o = 1; o < 64; o <<= 1) v += __shfl_xor(v, o);
    return v;
}
template <int CTRL> __device__ __forceinline__ float dpp_f(float v) { return __builtin_bit_cast(float, __builtin_amdgcn_update_dpp(0, __builtin_bit_cast(int, v), CTRL, 0xF, 0xF, false)); }
__device__ __forceinline__ float row16_sum(float v) { v += dpp_f<0xB1>(v); v += dpp_f<0x4E>(v); v += dpp_f<0x141>(v); v += dpp_f<0x140>(v); return v; }
__device__ __forceinline__ float row8_sum(float v) { v += dpp_f<0xB1>(v); v += dpp_f<0x4E>(v); v += dpp_f<0x141>(v); return v; }

struct InPtrs {
    const float* const __attribute__((address_space(4)))* p;
    __device__ __forceinline__ const float* operator[](int i) const { const float* const __attribute__((address_space(4)))* q = p; asm volatile("" : "+s"(q)); return q[i]; }
};
struct Frame {
    LAS unsigned char* lds;
    int tid, lane, wave, vcu, G; bool colo;
    InPtrs in; float* out; unsigned char* ws;
};

__device__ __forceinline__ void transpose_item(const float* W, int ldw, int src_col0, bf16* WT, int K, int dst_row0, const float* kscale, int k0, LAS float* scr, int lane) {
    float v[32], sc[32];
    const float* wp = W + (size_t)(k0 + (lane >> 5)) * ldw + src_col0 + (lane & 31);
#pragma unroll
    for (int i = 0; i < 32; ++i) v[i] = wp[(size_t)(2 * i) * ldw];
    if (kscale) {
#pragma unroll
        for (int i = 0; i < 32; ++i) sc[i] = kscale[k0 + 2 * i + (lane >> 5)];
#pragma unroll
        for (int i = 0; i < 32; ++i) v[i] *= sc[i]; }
#pragma unroll
    for (int i = 0; i < 32; ++i) scr[(2 * i + (lane >> 5)) * 33 + (lane & 31)] = v[i];
    LDS_WAIT(); asm volatile("" ::: "memory");
    const int c = lane & 7;
#pragma unroll
    for (int j = 0; j < 4; ++j) { const int n = (lane >> 3) + 8 * j; const LAS float* s = scr + (8 * c) * 33 + n;
        v4u o; o.x = pk2(s[0 * 33], s[1 * 33]); o.y = pk2(s[2 * 33], s[3 * 33]); o.z = pk2(s[4 * 33], s[5 * 33]); o.w = pk2(s[6 * 33], s[7 * 33]);
        *(GAS v4u*)(WT + (size_t)(dst_row0 + n) * K + k0 + 8 * c) = o; }
    LDS_WAIT(); asm volatile("" ::: "memory");
}

constexpr int I_WIN = 120 * 16, I_WKV = 64 * 16, I_L64 = 16, I_L128 = 32, I_SQ = 32 * 16, I_WGU = 176 * 16, I_WD = 32 * 44;
constexpr int W_EARLY = I_WIN + I_WKV + 2 * I_L64 + I_L128, W_ALL = W_EARLY + 3 * I_SQ + I_WGU + I_WD;
__device__ __forceinline__ void weight_item(Frame& F, int it, LAS float* scr) {
    unsigned char* ws = F.ws; int r = it;
    if (r < I_WIN) { const int seg = r >> 4, kb = r & 15, n0 = seg * 32; transpose_item(F.in[3], DIN, n0 < 2048 ? n0 : n0 + 8, (bf16*)(ws + WS_WIN), 1024, n0, F.in[2], kb * 64, scr, F.lane); return; } r -= I_WIN;
    if (r < I_WKV) { const int seg = r >> 4, kb = r & 15; transpose_item(F.in[23], 2048, seg * 32, (bf16*)(ws + WS_WKV), 1024, seg * 32, F.in[21], kb * 64, scr, F.lane); return; } r -= I_WKV;
    if (r < I_L64) { transpose_item(F.in[10], 512, r * 32, (bf16*)(ws + WS_LORA), 64, r * 32, nullptr, 0, scr, F.lane); return; } r -= I_L64;
    if (r < I_L64) { transpose_item(F.in[12], 512, r * 32, (bf16*)(ws + WS_LORA) + 512 * 64, 64, r * 32, nullptr, 0, scr, F.lane); return; } r -= I_L64;
    if (r < I_L128) { const int seg = r >> 1, kb = r & 1; transpose_item(F.in[13], 512, seg * 32, (bf16*)(ws + WS_LORA) + 2 * 512 * 64, 128, seg * 32, nullptr, kb * 64, scr, F.lane); return; } r -= I_L128;
    if (r < I_SQ) { const int seg = r >> 4, kb = r & 15; transpose_item(F.in[19], 1024, seg * 32, (bf16*)(ws + WS_WMIX), 1024, seg * 32, nullptr, kb * 64, scr, F.lane); return; } r -= I_SQ;
    if (r < I_SQ) { const int seg = r >> 4, kb = r & 15; transpose_item(F.in[22], 1024, seg * 32, (bf16*)(ws + WS_WQ), 1024, seg * 32, F.in[20], kb * 64, scr, F.lane); return; } r -= I_SQ;
    if (r < I_SQ) { const int seg = r >> 4, kb = r & 15; transpose_item(F.in[24], 1024, seg * 32, (bf16*)(ws + WS_WO), 1024, seg * 32, nullptr, kb * 64, scr, F.lane); return; } r -= I_SQ;
    if (r < I_WGU) { const int seg = r >> 4, kb = r & 15, r0 = seg * 32, blk = r0 >> 8, within = r0 & 255;
        transpose_item(within < 128 ? F.in[26] : F.in[27], DFF, blk * 128 + (within & 127), (bf16*)(ws + WS_WGU), 1024, r0, F.in[25], kb * 64, scr, F.lane); return; } r -= I_WGU;
    { const int seg = r / 44, kb = r % 44; transpose_item(F.in[28], 1024, seg * 32, (bf16*)(ws + WS_WD), DFF, seg * 32, nullptr, kb * 64, scr, F.lane); }
}
__device__ __forceinline__ void late_weights(Frame& F, int wg, int nwg) {
    LAS float* scr = (LAS float*)(F.lds + F.wave * 8704);
    for (int it = W_EARLY + wg * NWAVES + F.wave; it < W_ALL; it += nwg * NWAVES) weight_item(F, it, scr);
}
__device__ __forceinline__ void p0_row(Frame& F, LAS float* GW, unsigned char* ws, int m, bool is_x, f32x4 (&v)[4], float s) {
        const float rms = sqrtf(wave_sum(s) * (1.f / DM) + EPS), rstd = 1.f / rms;
        if (is_x && F.lane == 0) ((float*)(ws + WS_RMS))[m] = rms;
#pragma unroll
        for (int j = 0; j < 4; ++j) v[j] = v[j] * rstd;
        GAS unsigned long long* o8 = (GAS unsigned long long*)((bf16*)(ws + WS_XN) + (size_t)m * DM) + F.lane;
#pragma unroll
        for (int j = 0; j < 4; ++j) o8[64 * j] = (unsigned long long)pk2(v[j].x, v[j].y) | ((unsigned long long)pk2(v[j].z, v[j].w) << 32);
        if (is_x) {
            float g8[8];
#pragma unroll
            for (int q = 0; q < 8; ++q) { float a = 0.f;
#pragma unroll
                for (int j = 0; j < 4; ++j) { const f32x4 w = *(const LAS f32x4*)(GW + q * 1024 + 256 * j + 4 * F.lane); a += (v[j].x * w.x + v[j].y * w.y) + (v[j].z * w.z + v[j].w * w.w); }
                g8[q] = a; }
#pragma unroll
            for (int q = 0; q < 4; ++q) { const bool up = F.lane & 32; const float keep = up ? g8[q + 4] : g8[q], send = up ? g8[q] : g8[q + 4]; g8[q] = keep + __shfl_xor(send, 32); }
#pragma unroll
            for (int q = 0; q < 2; ++q) { const bool up = F.lane & 16; const float keep = up ? g8[q + 2] : g8[q], send = up ? g8[q] : g8[q + 2]; g8[q] = keep + __shfl_xor(send, 16); }
            { const bool up = F.lane & 8; const float keep = up ? g8[1] : g8[0], send = up ? g8[0] : g8[1]; g8[0] = keep + __shfl_xor(send, 8); }
            g8[0] = row8_sum(g8[0]);
            if ((F.lane & 7) == 0) { const int q = ((F.lane >> 5) & 1) * 4 + ((F.lane >> 4) & 1) * 2 + ((F.lane >> 3) & 1); ((float*)(ws + WS_ZG))[(size_t)m * 8 + q] = g8[0]; }
        }
}
__device__ __forceinline__ void p0_prologue(Frame& F) {
    LAS float* scr = (LAS float*)(F.lds + F.wave * 8704);
    LAS float* GW = (LAS float*)(F.lds + 98304);
    const float* w_in = F.in[3]; const float* g_in = F.in[2]; const float* x_in = F.in[0]; const float* m_in = F.in[1];
    { float wv[16], gvv[16];
#pragma unroll
      for (int i = 0; i < 16; ++i) { const int idx = F.tid + i * NWAVES * 64, q = idx >> 10, k = idx & 1023; wv[i] = w_in[(size_t)k * DIN + 2048 + q]; gvv[i] = g_in[k]; }
      __builtin_amdgcn_sched_barrier(0);
#pragma unroll
      for (int i = 0; i < 16; ++i) GW[F.tid + i * NWAVES * 64] = gvv[i] * wv[i]; }
    __syncthreads();
    const int gw = F.vcu * NWAVES + F.wave, NGW = F.G * NWAVES;
    unsigned char* ws = F.ws;
    for (int it = gw; it < W_EARLY; it += NGW) weight_item(F, it, scr);
#define P0_LOAD(dst, mm) do { const int mm_ = (mm); if (mm_ < M + MM) { const float* xrow_ = mm_ < M ? x_in + (size_t)mm_ * DM : m_in + (size_t)(mm_ - M) * DM; const GAS f32x4* xr_ = (const GAS f32x4*)xrow_ + F.lane; \
        _Pragma("unroll") for (int j_ = 0; j_ < 4; ++j_) dst[j_] = xr_[64 * j_]; } } while (0)
    f32x4 ra[4], rb[4], rc[4];
    P0_LOAD(ra, gw); P0_LOAD(rb, gw + NGW); P0_LOAD(rc, gw + 2 * NGW);
#define P0_ROW(buf, mm) do { const int m = (mm); if (m < M + MM) { const bool is_x = m < M; \
        f32x4 v[4]; float s = 0.f; \
        _Pragma("unroll") for (int j = 0; j < 4; ++j) { v[j] = buf[j]; s += (v[j].x * v[j].x + v[j].y * v[j].y) + (v[j].z * v[j].z + v[j].w * v[j].w); } \
        P0_LOAD(buf, m + 3 * NGW); \
        p0_row(F, GW, ws, m, is_x, v, s); } } while (0)
    for (int m0 = gw; m0 < M + MM; m0 += 3 * NGW) { P0_ROW(ra, m0); P0_ROW(rb, m0 + NGW); P0_ROW(rc, m0 + 2 * NGW); }
#undef P0_ROW
#undef P0_LOAD
}

__device__ __forceinline__ void final_norm(Frame& F) {
    const bool blk = (F.G == 256);
    const int gw = blk ? F.vcu * 128 + F.wave : F.vcu * NWAVES + F.wave, NGW = blk ? NWAVES : F.G * NWAVES, MEND = blk ? F.vcu * 128 + 128 : M;
    const float* ssq = (const float*)(F.ws + WS_SSQ3); const float* g = F.in[29];
    const bf16* h3 = (const bf16*)(F.ws + WS_H3B);
    f32x4 gv[4];
#pragma unroll
    for (int j = 0; j < 4; ++j) gv[j] = *(const f32x4*)(g + 4 * F.lane + 256 * j);
    float rs_l = 0.f;
    { const int mk = gw + F.lane * NGW; if (mk < MEND) rs_l = pg8::row_rstd16(ssq, mk, EPS); }
    u32x2v nx[4];
    if (gw < MEND) {
#pragma unroll
        for (int j = 0; j < 4; ++j) nx[j] = *(const u32x2v*)(h3 + (size_t)gw * DM + 4 * F.lane + 256 * j); }
    int k = 0;
    for (int m = gw; m < MEND; m += NGW, ++k) {
        u32x2v c[4];
#pragma unroll
        for (int j = 0; j < 4; ++j) c[j] = nx[j];
        const int mn = m + NGW;
        if (mn < MEND) {
#pragma unroll
            for (int j = 0; j < 4; ++j) nx[j] = *(const u32x2v*)(h3 + (size_t)mn * DM + 4 * F.lane + 256 * j); }
        const float rs = (k < 64) ? __shfl(rs_l, k) : pg8::row_rstd16(ssq, m, EPS);
        float* o = F.out + (size_t)m * DM + 4 * F.lane;
#pragma unroll
        for (int j = 0; j < 4; ++j) *(f32x4*)(o + 256 * j) = (f32x4){bflo(c[j].x), bfhi(c[j].x), bflo(c[j].y), bfhi(c[j].y)} * rs * gv[j];
    }
}

typedef short v4i16_t __attribute__((ext_vector_type(4)));
typedef short s16x4 __attribute__((ext_vector_type(4)));
__device__ __forceinline__ s16x4 lds_tr16(const LAS unsigned char* p) { return __builtin_bit_cast(s16x4, __builtin_amdgcn_ds_read_tr16_b64_v4i16((LAS v4i16_t*)p)); }
__device__ __forceinline__ bf16x8 cat8(s16x4 lo, s16x4 hi) { return (bf16x8){lo[0], lo[1], lo[2], lo[3], hi[0], hi[1], hi[2], hi[3]}; }

constexpr int ML_ROWB = 272;
constexpr int ML_Q = 0, ML_K = 34816, ML_V = 69632, ML_C = 104448, ML_F = 139264;
template <bool OUTP> __device__ __forceinline__ void mlstm_chunk(Frame& F, int b, int h, int c, f32x4 (&Cacc)[8], float& m_prev, const float ib, const float fb, const float* normw) {
    LAS unsigned char* L = F.lds;
    LAS unsigned char *Qs = L + ML_Q, *Ks = L + ML_K, *Vs = L + ML_V, *Cs = L + ML_C;
    LAS float* fl = (LAS float*)(L + ML_F);
    LAS float *dS = fl, *Mrow = fl + 128, *sint = fl + 256, *eden = fl + 384, *wgt = fl + 512, *nvec = fl + 640, *npart = fl + 768, *scal = fl + 1280, *tmp = fl + 1296;
    LAS float* cwL = fl + 1552;
    const int tid = F.tid, lane0 = F.lane, w = F.wave;
    const bf16* zm = (const bf16*)(F.ws + WS_ZM);
    const float* zg = (const float*)(F.ws + WS_ZG);
    bf16* Y = (bf16*)F.out;
    unsigned craw[35]; float graw[2] = {0.f, 0.f};
#define ML_ISSUE(cn) do { const int m0_ = b * SEQ + (cn) * 128; const int ts0_ = (cn) * 128 + 32 * tq; const char* zb_ = (const char*)(zm + (size_t)m0_ * NZM); \
        if (isk || outp) { craw[0] = (ts0_ >= 3) ? *(const unsigned*)(zb_ - 3 * NZM * 2 + cvoff) : 0u; craw[1] = (ts0_ >= 2) ? *(const unsigned*)(zb_ - 2 * NZM * 2 + cvoff) : 0u; craw[2] = (ts0_ >= 1) ? *(const unsigned*)(zb_ - 1 * NZM * 2 + cvoff) : 0u; \
        _Pragma("unroll") for (int i_ = 0; i_ < 32; ++i_) craw[3 + i_] = *(const unsigned*)(zb_ + (size_t)i_ * NZM * 2 + cvoff); } \
        if (tidv < 128) { const float* zr_ = zg + (size_t)(m0_ + tidv) * 8; graw[0] = zr_[h]; graw[1] = zr_[4 + h]; } } while (0)
        const int m0 = b * SEQ + c * 128; constexpr bool outp = OUTP;
        int lane = lane0, tidv = tid; asm volatile("" : "+v"(lane), "+v"(tidv));
        const int fr = lane & 15, G = lane >> 4;
        const int cp = tidv & 127, tq = tidv >> 7; const bool isk = cp >= 64; const int e2 = 2 * (cp & 63); const float kscale = isk ? 0.08838834764831845f : 1.0f;
        const unsigned cvoff = (unsigned)((32 * (tidv >> 7)) * NZM + (((tidv & 127) >= 64) ? 512 : 0) + 128 * h + 2 * (tidv & 63)) * 2u;
        ML_ISSUE(c);
        v4u vraw[4];
#pragma unroll
        for (int i = 0; i < 4; ++i) vraw[i] = *(const v4u*)((const char*)(zm + (size_t)(m0 + 32 * i) * NZM + 1024 + 128 * h) + (unsigned)((tidv >> 4) * NZM + 8 * (tidv & 15)) * 2u);
        float lf = 0.f, igv = 0.f;
        if (tidv < 128) { igv = graw[0] + ib; const float fv = graw[1] + fb; lf = fminf(fv, 0.f) - log1pf(__expf(-fabsf(fv))); }
        float bc = lf;
#pragma unroll
        for (int o = 1; o < 64; o <<= 1) { const float t = __shfl_up(bc, o); if (lane >= o) bc += t; }
        if (w == 0 && lane == 63) tmp[0] = bc;
        __syncthreads();
        if (w == 1) bc += tmp[0];
        const float dl = igv - bc;
        float pm = dl;
#pragma unroll
        for (int o = 1; o < 64; o <<= 1) { const float t = __shfl_up(pm, o); if (lane >= o) pm = fmaxf(pm, t); }
        if (w == 0 && lane == 63) tmp[1] = pm;
        __syncthreads();
        if (w == 1) pm = fmaxf(pm, tmp[1]);
        if (tidv == 127) { scal[0] = bc; scal[3] = pm; }
        __syncthreads();
        const float g = scal[0], m_loc = g + scal[3], m_new = fmaxf(g + m_prev, m_loc), s_old = __expf(g + m_prev - m_new);
        if (tidv < 128) { const float Ml = fmaxf(m_prev, pm); dS[tidv] = dl; Mrow[tidv] = Ml; sint[tidv] = __expf(m_prev - Ml); eden[tidv] = __expf(-bc - Ml); wgt[tidv] = __expf(g + dl - m_new); }
        {
            const int tl0 = 32 * tq;
            float cw[4][2];
            { const f32x4 c0 = *(const LAS f32x4*)(cwL + cp * 8), c1 = *(const LAS f32x4*)(cwL + cp * 8 + 4); cw[0][0] = c0[0]; cw[0][1] = c0[1]; cw[1][0] = c0[2]; cw[1][1] = c0[3]; cw[2][0] = c1[0]; cw[2][1] = c1[1]; cw[3][0] = c1[2]; cw[3][1] = c1[3]; }
            LAS unsigned char* dst = (isk ? Ks : Qs) + tl0 * ML_ROWB + e2 * 2;
            if (isk || outp)
#pragma unroll
            for (int i = 0; i < 32; ++i) {
                typedef float f2 __attribute__((ext_vector_type(2)));
                const f2 xa = {bflo(craw[i]), bfhi(craw[i])}, xb = {bflo(craw[i + 1]), bfhi(craw[i + 1])}, xc = {bflo(craw[i + 2]), bfhi(craw[i + 2])}, xd = {bflo(craw[i + 3]), bfhi(craw[i + 3])};
                const f2 w0 = {cw[0][0], cw[0][1]}, w1 = {cw[1][0], cw[1][1]}, w2 = {cw[2][0], cw[2][1]}, w3 = {cw[3][0], cw[3][1]};
                const f2 a = w0 * xa + (w1 * xb + (w2 * xc + w3 * xd));
                const f2 t = a * (f2){-LOG2E, -LOG2E}; f2 e; e.x = __builtin_amdgcn_exp2f(t.x); e.y = __builtin_amdgcn_exp2f(t.y);
                const f2 d = e + (f2){1.0f, 1.0f}; f2 r; r.x = __builtin_amdgcn_rcpf(d.x); r.y = __builtin_amdgcn_rcpf(d.y);
                const f2 o2 = (a * (f2){kscale, kscale}) * r;
                *(LAS unsigned*)(dst + i * ML_ROWB) = pk2(o2.x, o2.y);
            }
#pragma unroll
            for (int i = 0; i < 4; ++i) { const int p = tidv + 512 * i, row = p >> 4, ch = p & 15; *(LAS v4u*)(Vs + row * ML_ROWB + ch * 16) = vraw[i]; }
        }
        if (outp)
#pragma unroll
        for (int et = 0; et < 8; ++et)
#pragma unroll
            for (int r = 0; r < 4; ++r) *(LAS unsigned short*)(Cs + (16 * w + 4 * G + r) * ML_ROWB + (16 * et + fr) * 2) = (unsigned short)f2bf(Cacc[et][r]);
        __syncthreads();
        if (outp) {
            int lrow = 16 * w + fr; asm volatile("" : "+v"(lrow));
            bf16x8 qf[4];
#pragma unroll
            for (int ks = 0; ks < 4; ++ks) qf[ks] = *(const LAS bf16x8*)(Qs + lrow * ML_ROWB + (32 * ks + 8 * G) * 2);
            float nq = 0.f;
#pragma unroll
            for (int ks = 0; ks < 4; ++ks)
#pragma unroll
                for (int j = 0; j < 8; ++j) nq += bf2f((unsigned short)qf[ks][j]) * nvec[32 * ks + 8 * G + j];
            nq += __shfl_xor(nq, 16); nq += __shfl_xor(nq, 32);
            const float Ml = Mrow[lrow], si = sint[lrow], ed = eden[lrow];
            f32x4 acc[8];
#pragma unroll
            for (int dt = 0; dt < 8; ++dt) { acc[dt] = (f32x4){0.f, 0.f, 0.f, 0.f};
#pragma unroll
                for (int ks = 0; ks < 4; ++ks) { const bf16x8 a = *(const LAS bf16x8*)(Cs + (16 * dt + fr) * ML_ROWB + (32 * ks + 8 * G) * 2); acc[dt] = __builtin_amdgcn_mfma_f32_16x16x32_bf16(a, qf[ks], acc[dt], 0, 0, 0); }
                acc[dt] = acc[dt] * si; __builtin_amdgcn_sched_barrier(0); }
            float den = 0.f;
#pragma unroll
            for (int kp = 0; kp < 4; ++kp) {
                if (2 * kp <= w) {
                    s16x4 vlo[8], vhi[8];
                    { const LAS unsigned char* vb = Vs + (32 * kp + 4 * G + ((lane >> 2) & 3)) * ML_ROWB + (4 * (lane & 3)) * 2;
#pragma unroll
                      for (int dt = 0; dt < 8; ++dt) { vlo[dt] = lds_tr16(vb + dt * 32); vhi[dt] = lds_tr16(vb + 16 * ML_ROWB + dt * 32); } }
                    __builtin_amdgcn_sched_barrier(0);
                    float pv[8];
#pragma unroll
                    for (int hh = 0; hh < 2; ++hh) { const int st = 2 * kp + hh;
                        f32x4 s4 = (f32x4){0.f, 0.f, 0.f, 0.f};
                        if (st <= w) {
#pragma unroll
                            for (int ks = 0; ks < 4; ++ks) { const bf16x8 a = *(const LAS bf16x8*)(Ks + (16 * st + fr) * ML_ROWB + (32 * ks + 8 * G) * 2); s4 = __builtin_amdgcn_mfma_f32_16x16x32_bf16(a, qf[ks], s4, 0, 0, 0); }
                        }
                        const f32x4 d4 = *(const LAS f32x4*)(dS + 16 * st + 4 * G);
#pragma unroll
                        for (int r = 0; r < 4; ++r) { const int s = 16 * st + 4 * G + r; const float p = (s <= lrow) ? s4[r] * __expf(d4[r] - Ml) : 0.f; den += p; pv[hh * 4 + r] = p; } }
                    bf16x8 pf; { const unsigned a0 = pk2(pv[0], pv[1]), a1 = pk2(pv[2], pv[3]), a2 = pk2(pv[4], pv[5]), a3 = pk2(pv[6], pv[7]); pf = __builtin_bit_cast(bf16x8, (v4u){a0, a1, a2, a3}); }
#pragma unroll
                    for (int dt = 0; dt < 8; ++dt) acc[dt] = __builtin_amdgcn_mfma_f32_16x16x32_bf16(cat8(vlo[dt], vhi[dt]), pf, acc[dt], 0, 0, 0);
                    __builtin_amdgcn_sched_barrier(0);
                }
            }
            den += __shfl_xor(den, 16); den += __shfl_xor(den, 32);
            den += si * nq;
            const float inv = 1.0f / fmaxf(fabsf(den), ed);
            float ss = 0.f;
#pragma unroll
            for (int dt = 0; dt < 8; ++dt) { acc[dt] = acc[dt] * inv; ss += (acc[dt][0] * acc[dt][0] + acc[dt][1] * acc[dt][1]) + (acc[dt][2] * acc[dt][2] + acc[dt][3] * acc[dt][3]); }
            ss += __shfl_xor(ss, 16); ss += __shfl_xor(ss, 32);
            const float rs = 1.0f / sqrtf(ss * (1.0f / 128.0f) + EPS);
            const size_t mrow = (size_t)(m0 + lrow);
#pragma unroll
            for (int dt = 0; dt < 8; ++dt) { const int d0 = 16 * dt + 4 * G;
                const uint2 ov = *(const uint2*)(zm + mrow * NZM + 1536 + 128 * h + d0);
                const f32x4 nw = *(const f32x4*)(normw + 128 * h + d0);
                const float y0 = acc[dt][0] * rs * nw[0] * sigmoidf_(bflo(ov.x)), y1 = acc[dt][1] * rs * nw[1] * sigmoidf_(bfhi(ov.x));
                const float y2 = acc[dt][2] * rs * nw[2] * sigmoidf_(bflo(ov.y)), y3 = acc[dt][3] * rs * nw[3] * sigmoidf_(bfhi(ov.y));
                uint2 o; o.x = pk2(y0, y1); o.y = pk2(y2, y3); *(uint2*)(Y + mrow * DM + 128 * h + d0) = o; }
        }
#pragma unroll
        for (int et = 0; et < 8; ++et) Cacc[et] = Cacc[et] * s_old;
        { s16x4 blo[2][8], bhi[2][8], alo[2], ahi[2];
          const int rq = 4 * G + ((lane >> 2) & 3), cb = 4 * (lane & 3);
#define ML_LD7(buf, kp_) do { const int rb_ = 32 * (kp_) + rq; alo[buf] = lds_tr16(Vs + rb_ * ML_ROWB + (16 * w + cb) * 2); ahi[buf] = lds_tr16(Vs + (rb_ + 16) * ML_ROWB + (16 * w + cb) * 2); \
            _Pragma("unroll") for (int et = 0; et < 8; ++et) { blo[buf][et] = lds_tr16(Ks + rb_ * ML_ROWB + (16 * et + cb) * 2); bhi[buf][et] = lds_tr16(Ks + (rb_ + 16) * ML_ROWB + (16 * et + cb) * 2); } } while (0)
          ML_LD7(0, 0);
#pragma unroll
          for (int kp = 0; kp < 4; ++kp) {
            __builtin_amdgcn_sched_barrier(0);
            if (kp + 1 < 4) ML_LD7((kp + 1) & 1, kp + 1);
            __builtin_amdgcn_sched_barrier(0);
            const f32x4 wl = *(const LAS f32x4*)(wgt + 32 * kp + 4 * G), wh = *(const LAS f32x4*)(wgt + 32 * kp + 16 + 4 * G);
            const s16x4 a_lo = alo[kp & 1], a_hi = ahi[kp & 1];
            bf16x8 af; { const unsigned a0 = pk2(bf2f((unsigned short)a_lo[0]) * wl[0], bf2f((unsigned short)a_lo[1]) * wl[1]), a1 = pk2(bf2f((unsigned short)a_lo[2]) * wl[2], bf2f((unsigned short)a_lo[3]) * wl[3]),
                                          a2 = pk2(bf2f((unsigned short)a_hi[0]) * wh[0], bf2f((unsigned short)a_hi[1]) * wh[1]), a3 = pk2(bf2f((unsigned short)a_hi[2]) * wh[2], bf2f((unsigned short)a_hi[3]) * wh[3]);
                af = __builtin_bit_cast(bf16x8, (v4u){a0, a1, a2, a3}); }
#pragma unroll
            for (int et = 0; et < 8; ++et) Cacc[et] = __builtin_amdgcn_mfma_f32_16x16x32_bf16(af, cat8(blo[kp & 1][et], bhi[kp & 1][et]), Cacc[et], 0, 0, 0);
          }
#undef ML_LD7
        }
        { const int e = tidv & 127, sq = tidv >> 7; float p = 0.f;
#pragma unroll 8
            for (int i = 0; i < 32; ++i) { const int s = 32 * sq + i; p += wgt[s] * bf2f(*(const LAS unsigned short*)(Ks + s * ML_ROWB + e * 2)); }
            npart[sq * 128 + e] = p; }
        __syncthreads();
        if (tidv < 128) nvec[tidv] = s_old * nvec[tidv] + ((npart[tidv] + npart[128 + tidv]) + (npart[256 + tidv] + npart[384 + tidv]));
        m_prev = m_new;
        __syncthreads();
#undef ML_ISSUE
}
__device__ __forceinline__ void mlstm_unit(Frame& F, int b, int h, int c_end, int c_out0) {
    pg8::ch_wait_n<8>((unsigned*)(F.ws + WS_CTL) + CW_CHN + pg8::ch_word(11, 8 * b), pg8::CH_STRIDE, 120u, (unsigned*)(F.ws + WS_CTL) + CW_BAR + XB_TMO, F.colo);
    LAS float* fl = (LAS float*)(F.lds + ML_F);
    LAS float *nvec = fl + 640, *cwL = fl + 1552;
    const float* convw = F.in[4];
    f32x4 Cacc[8];
#pragma unroll
    for (int et = 0; et < 8; ++et) Cacc[et] = (f32x4){0.f, 0.f, 0.f, 0.f};
    float m_prev = 0.f;
    { const int tp = F.tid;
      if (tp < 128) { nvec[tp] = 0.f; const int zc0 = ((tp >= 64) ? 512 : 0) + 128 * h + 2 * (tp & 63);
#pragma unroll
        for (int j = 0; j < 4; ++j) { cwL[tp * 8 + 2 * j] = convw[j * 1024 + zc0]; cwL[tp * 8 + 2 * j + 1] = convw[j * 1024 + zc0 + 1]; } } }
    __syncthreads();
    const int c_mid = c_out0 < c_end ? c_out0 : c_end;
    const float ib = F.in[5][h], fb = F.in[6][h]; const float* normw = F.in[7];
    for (int c = 0; c < c_mid; ++c) mlstm_chunk<false>(F, b, h, c, Cacc, m_prev, ib, fb, normw);
    unsigned* const ycnt = (unsigned*)(F.ws + WS_CTL) + CW_CHN + pg8::ch_word(10, 8 * b);
    for (int c = c_mid; c < c_end; ++c) { mlstm_chunk<true>(F, b, h, c, Cacc, m_prev, ib, fb, normw); if (c & 1) pg8::ch_publish_now(ycnt + pg8::CH_STRIDE * (c >> 1), F.colo); }
}

constexpr int LO_TW = 0, LO_XA = 9216, LO_SG = 18432, LO_ST = 36864, LO_STW = 9216;
__device__ __forceinline__ void lora_unit(Frame& F, int b, int tb) {
    LAS unsigned char* L = F.lds;
    const int tid = F.tid, lane = F.lane, w = F.wave, fr = lane & 15, G = lane >> 4;
    const bf16* zr = (const bf16*)(F.ws + WS_ZR);
    const size_t m0 = (size_t)b * SEQ + 64 * tb;
    {
        unsigned* pc = (unsigned*)(F.ws + WS_CTL) + CW_CHN + pg8::ch_word(11, 8 * b + (tb >> 2)); unsigned* tm = (unsigned*)(F.ws + WS_CTL) + CW_BAR + XB_TMO;
        if ((tb & 3) == 0 && tb > 0) pg8::ch_wait_n<2>(pc - pg8::CH_STRIDE, pg8::CH_STRIDE, 120u, tm, F.colo); else pg8::ch_wait_n<1>(pc, pg8::CH_STRIDE, 120u, tm, F.colo); }
    { const int grp = tid & 31, run = tid >> 5; const int zc = 1536 + 8 * grp;
        float mu8[8]; const float* mu_in = F.in[8];
#pragma unroll
        for (int i = 0; i < 8; ++i) mu8[i] = mu_in[zc + i];
        const bf16* p = zr + (m0 + 4 * run) * NZR + zc;
        v4u raw[5];
        raw[0] = (64 * tb + 4 * run > 0) ? *(const v4u*)(p - NZR) : (v4u){0u, 0u, 0u, 0u};
#pragma unroll
        for (int i = 0; i < 4; ++i) raw[1 + i] = *(const v4u*)(p + (size_t)i * NZR);
        const int kind = grp < 8 ? 1 : (grp < 16 ? 0 : 2); const float asc = kind == 1 ? 2.0f : 1.0f;
        LAS unsigned char* dst = grp < 8 ? L + LO_TW + (4 * run) * 144 + (8 * grp) * 2 : (grp < 16 ? L + LO_XA + (4 * run) * 144 + (8 * (grp - 8)) * 2 : L + LO_SG + (4 * run) * 272 + (8 * (grp - 16)) * 2);
        const int dstride = grp < 16 ? 144 : 272;
#pragma unroll
        for (int i = 0; i < 4; ++i) { const v4u uc = raw[1 + i], up = raw[i]; float v[8];
#pragma unroll
            for (int q = 0; q < 4; ++q) { const float c0 = bflo(uc[q]), c1 = bfhi(uc[q]), p0 = bflo(up[q]), p1 = bfhi(up[q]);
                v[2 * q] = c0 + (p0 - c0) * mu8[2 * q]; v[2 * q + 1] = c1 + (p1 - c1) * mu8[2 * q + 1]; }
            if (kind != 0) {
#pragma unroll
                for (int q = 0; q < 8; ++q) { const float g = sigmoidf_(v[q] * asc); v[q] = kind == 1 ? 2.0f * g - 1.0f : g; } }
            v4u o; o.x = pk2(v[0], v[1]); o.y = pk2(v[2], v[3]); o.z = pk2(v[4], v[5]); o.w = pk2(v[6], v[7]);
            *(LAS v4u*)(dst + i * dstride) = o; }
    }
    __syncthreads();
    const bf16* wup_t = (const bf16*)(F.ws + WS_LORA); const bf16* aup_t = wup_t + 512 * 64; const bf16* gup_t = wup_t + 2 * 512 * 64;
    LAS unsigned char* stg = L + LO_ST + w * LO_STW;
    LAS unsigned char* est = stg; LAS unsigned char* ast = stg + 2304; LAS unsigned char* gst = stg + 4608;
    bf16* Eo = (bf16*)(F.ws + WS_E); bf16* ALo = (bf16*)(F.ws + WS_AL); bf16* GGo = (bf16*)(F.ws + WS_GG);
    const float* w0_in = F.in[9]; const float* a0_in = F.in[11];
    bf16x8 wf[4][8];
#pragma unroll
    for (int c4 = 0; c4 < 4; ++c4) { const int ch = 64 * w + 16 * c4 + fr;
#pragma unroll
        for (int ks = 0; ks < 2; ++ks) { wf[c4][ks] = *(const bf16x8*)(wup_t + (size_t)ch * 64 + 32 * ks + 8 * G); wf[c4][2 + ks] = *(const bf16x8*)(aup_t + (size_t)ch * 64 + 32 * ks + 8 * G); }
#pragma unroll
        for (int ks = 0; ks < 4; ++ks) wf[c4][4 + ks] = *(const bf16x8*)(gup_t + (size_t)ch * 128 + 32 * ks + 8 * G); }
#pragma unroll 1
    for (int tt = 0; tt < 4; ++tt) {
        bf16x8 fw[2], fa[2], fg[4];
#pragma unroll
        for (int ks = 0; ks < 2; ++ks) { fw[ks] = *(const LAS bf16x8*)(L + LO_TW + (16 * tt + fr) * 144 + (32 * ks + 8 * G) * 2); fa[ks] = *(const LAS bf16x8*)(L + LO_XA + (16 * tt + fr) * 144 + (32 * ks + 8 * G) * 2); }
#pragma unroll
        for (int ks = 0; ks < 4; ++ks) fg[ks] = *(const LAS bf16x8*)(L + LO_SG + (16 * tt + fr) * 272 + (32 * ks + 8 * G) * 2);
#pragma unroll
        for (int c4 = 0; c4 < 4; ++c4) {
            f32x4 dw = (f32x4){0.f, 0.f, 0.f, 0.f}, da = dw, dg = dw;
#pragma unroll
            for (int ks = 0; ks < 2; ++ks) { dw = __builtin_amdgcn_mfma_f32_16x16x32_bf16(wf[c4][ks], fw[ks], dw, 0, 0, 0); da = __builtin_amdgcn_mfma_f32_16x16x32_bf16(wf[c4][2 + ks], fa[ks], da, 0, 0, 0); }
#pragma unroll
            for (int ks = 0; ks < 4; ++ks) dg = __builtin_amdgcn_mfma_f32_16x16x32_bf16(wf[c4][4 + ks], fg[ks], dg, 0, 0, 0);
            const f32x4 w0 = *(const f32x4*)(w0_in + 64 * w + 16 * c4 + 4 * G), a0 = *(const f32x4*)(a0_in + 64 * w + 16 * c4 + 4 * G);
            f32x4 ev, av;
#pragma unroll
            for (int r = 0; r < 4; ++r) { ev[r] = 0.6065306597126334f * sigmoidf_(dw[r] + w0[r]); av[r] = sigmoidf_(da[r] + a0[r]); }
            u32x2v oe, oa, og; oe.x = pk2(ev[0], ev[1]); oe.y = pk2(ev[2], ev[3]); *(LAS u32x2v*)(est + fr * 144 + (16 * c4 + 4 * G) * 2) = oe;
            oa.x = pk2(av[0], av[1]); oa.y = pk2(av[2], av[3]); og.x = pk2(dg[0], dg[1]); og.y = pk2(dg[2], dg[3]);
            *(LAS u32x2v*)(ast + fr * 144 + (16 * c4 + 4 * G) * 2) = oa; *(LAS u32x2v*)(gst + fr * 144 + (16 * c4 + 4 * G) * 2) = og; }
        asm volatile("s_waitcnt lgkmcnt(0)" ::: "memory");
        const size_t mr = m0 + 16 * tt;
#pragma unroll
        for (int i = 0; i < 2; ++i) { const int tok = 8 * i + (lane >> 3), pc = lane & 7;
            *(v4u*)(Eo + (mr + tok) * 512 + 64 * w + 8 * pc) = *(const LAS v4u*)(est + tok * 144 + pc * 16); *(v4u*)(ALo + (mr + tok) * 512 + 64 * w + 8 * pc) = *(const LAS v4u*)(ast + tok * 144 + pc * 16); *(v4u*)(GGo + (mr + tok) * 512 + 64 * w + 8 * pc) = *(const LAS v4u*)(gst + tok * 144 + pc * 16); }
        asm volatile("s_waitcnt lgkmcnt(0)" ::: "memory");
    }
    __syncthreads();
    pg8::ch_publish_now((unsigned*)(F.ws + WS_CTL) + CW_CHN + pg8::ch_word(6, 32 * b + tb), F.colo);
}

constexpr int RW_FS = 68;
constexpr int RW_RF = 0, RW_KF = 17408, RW_EF = 34816, RW_AL = 52224;
constexpr int RW_OPS = 144;
constexpr int RW_AT = 0, RW_RT = 9216, RW_BT = 18432, RW_KT = 27648, RW_BH = 36864, RW_KH = 46080, RW_VI = 55296;
constexpr int RW_VF = 69632;
constexpr int RW_TW = 87040, RW_XA = 96256, RW_SG = 105472;
constexpr int RW_GAB = 87040, RW_GAK = 96256, RW_GBR = 105472, RW_GKR = 114688;
constexpr int RW_G = 123904;
constexpr int RW_YT = 132096;
constexpr int RW_DIAG = 149504;
constexpr int RW_DB = 153600;
constexpr int RW_WC = 158720, RW_BON = 158976, RW_ESEG = 159232, RW_PAR = 161280, RW_END = 162560;
static_assert(RW_END <= MISC_OFF, "rwkv LDS map");
__device__ __forceinline__ int rw_pos(int k) { return (k & 32) + 8 * ((k >> 2) & 3) + 4 * ((k >> 4) & 1) + (k & 3); }
__device__ __forceinline__ bf16x8 pack8(const f32x4& lo, const f32x4& hi) { const unsigned a0 = pk2(lo[0], lo[1]), a1 = pk2(lo[2], lo[3]), a2 = pk2(hi[0], hi[1]), a3 = pk2(hi[2], hi[3]); return __builtin_bit_cast(bf16x8, (v4u){a0, a1, a2, a3}); }
__device__ __forceinline__ bf16x8 pack4z(const f32x4& lo) { const unsigned a0 = pk2(lo[0], lo[1]), a1 = pk2(lo[2], lo[3]); return __builtin_bit_cast(bf16x8, (v4u){a0, a1, 0u, 0u}); }
#define RW_MFMA(a, b, c) __builtin_amdgcn_mfma_f32_16x16x32_bf16((a), (b), (c), 0, 0, 0)
#define RW_LDA(base, row, ks) (*(const LAS bf16x8*)(L + (base) + (row) * RW_OPS + (32 * (ks) + 8 * G) * 2))
#define RW_LDT(base, c16, ks) cat8(lds_tr16(L + (base) + (32 * (ks) + 4 * G + ((lane >> 2) & 3)) * RW_OPS + (16 * (c16) + 4 * (lane & 3)) * 2), lds_tr16(L + (base) + (32 * (ks) + 16 + 4 * G + ((lane >> 2) & 3)) * RW_OPS + (16 * (c16) + 4 * (lane & 3)) * 2))
__device__ __forceinline__ void rwkv_unit(Frame& F, int b, int h) {
    LAS unsigned char* L = F.lds;
    LAS float *Rf = (LAS float*)(L + RW_RF), *Kf = (LAS float*)(L + RW_KF), *Ef = (LAS float*)(L + RW_EF), *ALf = (LAS float*)(L + RW_AL), *Vf = (LAS float*)(L + RW_VF);
    LAS float *YT = (LAS float*)(L + RW_YT), *DIAG = (LAS float*)(L + RW_DIAG), *WC = (LAS float*)(L + RW_WC), *BON = (LAS float*)(L + RW_BON), *ESEG = (LAS float*)(L + RW_ESEG);
    LAS unsigned char *TW = L + RW_TW, *XA = L + RW_XA, *SG = L + RW_SG; LAS unsigned short* Gs = (LAS unsigned short*)(L + RW_G);
    const int tid = F.tid, lane0 = F.lane, w = F.wave, fr0 = lane0 & 15, G0 = lane0 >> 4;
    const bf16* zr = (const bf16*)(F.ws + WS_ZR);
    const float* mu = F.in[8];
    const bf16* wup_t = (const bf16*)(F.ws + WS_LORA); const bf16* aup_t = wup_t + 512 * 64; const bf16* gup_t = wup_t + 2 * 512 * 64;
    bf16* Y = (bf16*)F.out;
    const int hc0 = 64 * h;
    f32x4 ST[4];
#pragma unroll
    for (int jt = 0; jt < 4; ++jt) ST[jt] = (f32x4){0.f, 0.f, 0.f, 0.f};
    for (int i = tid; i < 4 * 16 * 20; i += NWAVES * 64) ((LAS unsigned*)(L + RW_DB))[i] = 0u;
    LAS float* PAR = (LAS float*)(L + RW_PAR);
    if (tid < 320) { const int a = tid >> 6, c = tid & 63; const float* src = a == 0 ? F.in[14] : (a == 1 ? F.in[15] : (a == 2 ? F.in[16] : (a == 3 ? F.in[17] : F.in[18]))); PAR[tid] = src[hc0 + c]; }
    const bool ld_on = tid < 384; const int grp = ld_on ? tid % 24 : 0, run4 = ld_on ? tid / 24 : 0;
    const int zc = 512 * (grp >> 3) + hc0 + 8 * (grp & 7);
    float mu8[8];
#pragma unroll
    for (int i = 0; i < 8; ++i) mu8[i] = mu[zc + i];
    LAS unsigned char* const adst = L + (grp < 8 ? RW_RF : (grp < 16 ? RW_KF : RW_VF)) + (4 * run4) * 272 + (8 * (grp & 7)) * 4;
    const bf16* Eg = (const bf16*)(F.ws + WS_E); const bf16* ALg = (const bf16*)(F.ws + WS_AL); const bf16* GGg = (const bf16*)(F.ws + WS_GG);
    v4u raw[5]; v4u eraw, alraw, graw;
    const unsigned rvoff = (unsigned)((4 * run4) * NZR + zc) * 2u;
    const unsigned agoff = (unsigned)((tid >> 3) * 512 + hc0 + 8 * (tid & 7)) * 2u;
#define RW_ISSUE(tbn) do { const size_t mb_ = (size_t)b * SEQ + (tbn) * 64; \
        if (ld_on) { const char* zb_ = (const char*)(zr + mb_ * NZR); \
            raw[0] = ((tbn) * 64 + 4 * run4 > 0) ? *(const v4u*)(zb_ - NZR * 2 + rvoff) : (v4u){0u, 0u, 0u, 0u}; \
            _Pragma("unroll") for (int i_ = 0; i_ < 4; ++i_) raw[1 + i_] = *(const v4u*)(zb_ + (size_t)i_ * NZR * 2 + rvoff); } \
        eraw = *(const v4u*)((const char*)(Eg + mb_ * 512) + agoff); \
        alraw = *(const v4u*)((const char*)(ALg + mb_ * 512) + agoff); graw = *(const v4u*)((const char*)(GGg + mb_ * 512) + agoff); } while (0)
    unsigned* const lctr = (unsigned*)(F.ws + WS_CTL) + CW_CHN + pg8::ch_word(6, 32 * b); unsigned* const ltmo = (unsigned*)(F.ws + WS_CTL) + CW_BAR + XB_TMO;
    unsigned* const ycnt = (unsigned*)(F.ws + WS_CTL) + CW_CHN + pg8::ch_word(10, 8 * b);
    pg8::ch_wait_n<8>((unsigned*)(F.ws + WS_CTL) + CW_CHN + pg8::ch_word(11, 8 * b), pg8::CH_STRIDE, 120u, ltmo, F.colo);
    pg8::ch_wait(lctr, 8u, ltmo);
    if (!F.colo) { __builtin_amdgcn_fence(__ATOMIC_ACQUIRE, "agent"); asm volatile("s_waitcnt vmcnt(0)" ::: "memory"); }
    RW_ISSUE(0);
    __syncthreads();
    for (int tb = 0; tb < 32; ++tb) {
        unsigned lpv = 8u; if (tb + 1 < 32) lpv = __hip_atomic_load(lctr + pg8::CH_STRIDE * (tb + 1), __ATOMIC_RELAXED, __HIP_MEMORY_SCOPE_AGENT);
        const size_t m0 = (size_t)b * SEQ + tb * 64;
        int lane = lane0, fr = fr0, G = G0, ct = tid >> 3, cg = tid & 7;
        asm volatile("" : "+v"(lane), "+v"(fr), "+v"(G), "+v"(ct), "+v"(cg));
        if (ld_on) {
            LAS unsigned char* ap = adst; asm volatile("" : "+v"(ap));
#pragma unroll
            for (int i = 0; i < 4; ++i) { const v4u uc = raw[1 + i], up = raw[i]; float v[8];
#pragma unroll
                for (int q = 0; q < 4; ++q) { const float c0 = bflo(uc[q]), c1 = bfhi(uc[q]), p0 = bflo(up[q]), p1 = bfhi(up[q]);
                    v[2 * q] = c0 + (p0 - c0) * mu8[2 * q]; v[2 * q + 1] = c1 + (p1 - c1) * mu8[2 * q + 1]; }
                *(LAS f32x4*)ap = (f32x4){v[0], v[1], v[2], v[3]}; *(LAS f32x4*)(ap + 16) = (f32x4){v[4], v[5], v[6], v[7]};
                ap += 272; asm volatile("" : "+v"(ap)); }
        }
        { LAS float* ep_ = Ef + ct * RW_FS + 8 * cg; *(LAS f32x4*)ep_ = (f32x4){bflo(eraw.x), bfhi(eraw.x), bflo(eraw.y), bfhi(eraw.y)}; *(LAS f32x4*)(ep_ + 4) = (f32x4){bflo(eraw.z), bfhi(eraw.z), bflo(eraw.w), bfhi(eraw.w)}; }
        const v4u gpk = graw;
        __syncthreads();
        if (tb >= 5 && ((tb - 5) & 3) == 0) {
            if (F.colo) pg8::ch_arrive(ycnt + pg8::CH_STRIDE * ((tb - 5) >> 2), true); else pg8::ch_publish_now(ycnt + pg8::CH_STRIDE * ((tb - 5) >> 2), false); }
        { float c8[8]; float run_ = 0.f;
#pragma unroll
            for (int q = 0; q < 8; ++q) { run_ += Ef[(8 * w + q) * RW_FS + lane]; c8[q] = run_; }
            ESEG[w * 64 + lane] = run_;
            __syncthreads();
            float off = 0.f;
#pragma unroll
            for (int q = 0; q < 7; ++q) off += (q < w) ? ESEG[q * 64 + lane] : 0.f;
#pragma unroll
            for (int q = 0; q < 8; ++q) Ef[(8 * w + q) * RW_FS + lane] = c8[q] + off;
            if (w == 7) WC[lane] = __expf(-(c8[7] + off)); }
        __syncthreads();
        float o_at[8], o_rt[8], o_bt[8], o_kt[8], o_bh[8], o_kh[8], o_v[8];
        { float kr[8], kk[8], rr[8], ec[8], ep[8], eC[8], al[8]; float ssq = 0.f, bon = 0.f;
#pragma unroll
            for (int q = 0; q < 4; ++q) { al[2 * q] = bflo(alraw[q]); al[2 * q + 1] = bfhi(alraw[q]); }
#pragma unroll
            for (int q = 0; q < 2; ++q) { const f32x4 a = *(const LAS f32x4*)(Kf + ct * RW_FS + 8 * cg + 4 * q), bq = *(const LAS f32x4*)(Rf + ct * RW_FS + 8 * cg + 4 * q),
                    d = *(const LAS f32x4*)(Ef + ct * RW_FS + 8 * cg + 4 * q), e2 = *(const LAS f32x4*)(Ef + 63 * RW_FS + 8 * cg + 4 * q), vv = *(const LAS f32x4*)(Vf + ct * RW_FS + 8 * cg + 4 * q);
                f32x4 p = (f32x4){0.f, 0.f, 0.f, 0.f}; if (ct > 0) p = *(const LAS f32x4*)(Ef + (ct - 1) * RW_FS + 8 * cg + 4 * q);
#pragma unroll
                for (int i = 0; i < 4; ++i) { kr[4 * q + i] = a[i]; rr[4 * q + i] = bq[i]; ec[4 * q + i] = d[i]; eC[4 * q + i] = e2[i]; ep[4 * q + i] = p[i]; o_v[4 * q + i] = vv[i]; } }
#pragma unroll
            for (int i = 0; i < 8; ++i) { kk[i] = kr[i] * PAR[8 * cg + i]; ssq += kk[i] * kk[i]; }
            ssq = row8_sum(ssq);
            const float inv = 1.0f / fmaxf(sqrtf(ssq), 1e-12f);
#pragma unroll
            for (int i = 0; i < 8; ++i) { const int ch = hc0 + 8 * cg + i; const float kn = kk[i] * inv, k2 = kr[i] * (1.0f + (al[i] - 1.0f) * PAR[64 + 8 * cg + i]), bb = kn * al[i];
                const float Wt = __expf(-ec[i]), iWt = __expf(ec[i]), Wp = __expf(-ep[i]), rat = __expf(ec[i] - eC[i]);
                o_at[i] = -kn * Wp; o_rt[i] = rr[i] * Wt; o_bt[i] = bb * iWt; o_kt[i] = k2 * iWt; o_bh[i] = bb * rat; o_kh[i] = k2 * rat;
                bon += rr[i] * k2 * PAR[128 + 8 * cg + i]; }
            bon = row8_sum(bon);
            if (cg == 0) BON[ct] = bon; }
        __syncthreads();
        { const int p0 = 32 * (cg >> 2) + 8 * ((2 * cg) & 3) + 4 * ((cg >> 1) & 1), p1 = 32 * (cg >> 2) + 8 * ((2 * cg + 1) & 3) + 4 * ((cg >> 1) & 1);
#define RW_ST4(base, arr) do { u32x2v lo_, hi_; lo_.x = pk2(arr[0], arr[1]); lo_.y = pk2(arr[2], arr[3]); hi_.x = pk2(arr[4], arr[5]); hi_.y = pk2(arr[6], arr[7]); \
            *(LAS u32x2v*)(L + (base) + ct * RW_OPS + p0 * 2) = lo_; *(LAS u32x2v*)(L + (base) + ct * RW_OPS + p1 * 2) = hi_; } while (0)
            RW_ST4(RW_AT, o_at); RW_ST4(RW_RT, o_rt); RW_ST4(RW_BT, o_bt); RW_ST4(RW_KT, o_kt);
#undef RW_ST4
#define RW_ST4N(base, arr) do { u32x2v lo_, hi_; lo_.x = pk2(arr[0], arr[1]); lo_.y = pk2(arr[2], arr[3]); hi_.x = pk2(arr[4], arr[5]); hi_.y = pk2(arr[6], arr[7]); \
            *(LAS u32x2v*)(L + (base) + ct * RW_OPS + (8 * cg) * 2) = lo_; *(LAS u32x2v*)(L + (base) + ct * RW_OPS + (8 * cg + 4) * 2) = hi_; } while (0)
            RW_ST4N(RW_BH, o_bh); RW_ST4N(RW_KH, o_kh); RW_ST4N(RW_VI, o_v);
#undef RW_ST4N
        }
        __syncthreads();
        if (tb + 1 < 32) {
            if ((unsigned)__builtin_amdgcn_readfirstlane(lpv) < 8u) pg8::ch_wait(lctr + pg8::CH_STRIDE * (tb + 1), 8u, ltmo);
            if (!F.colo) { __builtin_amdgcn_fence(__ATOMIC_ACQUIRE, "agent"); asm volatile("s_waitcnt vmcnt(0)" ::: "memory"); }
            RW_ISSUE(tb + 1); }
        bf16x8 dfa[2][2], dfr[2][2], dfb[2][2], dfk[2][2];
#pragma unroll
        for (int qq = 0; qq < 2; ++qq) { const int q = 2 * w + qq, tq = q >> 2, sq = q & 3;
#pragma unroll
            for (int ks = 0; ks < 2; ++ks) { dfa[qq][ks] = RW_LDA(RW_AT, 16 * tq + fr, ks); dfr[qq][ks] = RW_LDA(RW_RT, 16 * tq + fr, ks); dfb[qq][ks] = RW_LDA(RW_BT, 16 * sq + fr, ks); dfk[qq][ks] = RW_LDA(RW_KT, 16 * sq + fr, ks); } }
        __builtin_amdgcn_sched_barrier(0);
#pragma unroll
        for (int qq = 0; qq < 2; ++qq) { const int q = 2 * w + qq, tq = q >> 2, sq = q & 3;
            f32x4 gab = (f32x4){0.f, 0.f, 0.f, 0.f}, gak = gab, gbr = gab, gkr = gab;
            if (sq <= tq) {
#pragma unroll
                for (int ks = 0; ks < 2; ++ks) { gab = RW_MFMA(dfb[qq][ks], dfa[qq][ks], gab); gak = RW_MFMA(dfk[qq][ks], dfa[qq][ks], gak); gbr = RW_MFMA(dfb[qq][ks], dfr[qq][ks], gbr); gkr = RW_MFMA(dfk[qq][ks], dfr[qq][ks], gkr); } }
            const int t = 16 * tq + fr, s0 = 16 * sq + 4 * G, ps = rw_pos(s0);
            if (sq == tq) {
#pragma unroll
                for (int r = 0; r < 4; ++r) { const bool lt = (4 * G + r) < fr, le = (4 * G + r) <= fr; gab[r] = lt ? gab[r] : 0.f; gak[r] = lt ? gak[r] : 0.f; gbr[r] = le ? gbr[r] : 0.f; gkr[r] = le ? gkr[r] : 0.f; }
                *(LAS f32x4*)(DIAG + tq * 256 + fr * 16 + 4 * G) = gab;
                gab = (f32x4){0.f, 0.f, 0.f, 0.f}; }
            u32x2v o;
            o.x = pk2(gab[0], gab[1]); o.y = pk2(gab[2], gab[3]); *(LAS u32x2v*)(L + RW_GAB + t * RW_OPS + ps * 2) = o;
            o.x = pk2(gak[0], gak[1]); o.y = pk2(gak[2], gak[3]); *(LAS u32x2v*)(L + RW_GAK + t * RW_OPS + ps * 2) = o;
            o.x = pk2(gbr[0], gbr[1]); o.y = pk2(gbr[2], gbr[3]); *(LAS u32x2v*)(L + RW_GBR + t * RW_OPS + ps * 2) = o;
            o.x = pk2(gkr[0], gkr[1]); o.y = pk2(gkr[2], gkr[3]); *(LAS u32x2v*)(L + RW_GKR + t * RW_OPS + ps * 2) = o; }
        __syncthreads();
        if (w == 7) { const int blk = lane >> 4; int c = lane & 15; asm volatile("" : "+v"(c)); float z[16];
            f32x4 Lr[16][4];
#define RW_ELOAD(t0_, t1_) _Pragma("unroll") for (int t = (t0_); t < (t1_); ++t) _Pragma("unroll") for (int q = 0; q < 4; ++q) if (4 * q < t) Lr[t][q] = *(const LAS f32x4*)(DIAG + blk * 256 + t * 16 + 4 * q);
#define RW_ESTEP(t0_, t1_) _Pragma("unroll") for (int t = (t0_); t < (t1_); ++t) { float p4[4] = {(t == c) ? 1.0f : 0.0f, 0.f, 0.f, 0.f}; \
                _Pragma("unroll") for (int q = 0; q < 4; ++q) if (4 * q < t) { _Pragma("unroll") for (int e = 0; e < 4; ++e) if (4 * q + e < t) p4[q] += Lr[t][q][e] * z[4 * q + e]; } \
                z[t] = (p4[0] + p4[1]) + (p4[2] + p4[3]); }
            RW_ELOAD(1, 11)
            asm volatile("s_waitcnt lgkmcnt(0)" ::: "memory"); __builtin_amdgcn_sched_barrier(0);
            RW_ESTEP(0, 7)
            __builtin_amdgcn_sched_barrier(0);
            RW_ELOAD(11, 16)
            __builtin_amdgcn_sched_barrier(0);
            RW_ESTEP(7, 11)
            asm volatile("s_waitcnt lgkmcnt(0)" ::: "memory"); __builtin_amdgcn_sched_barrier(0);
            RW_ESTEP(11, 16)
#undef RW_ELOAD
#undef RW_ESTEP
            const int slot = 8 * (c >> 2) + (c & 3);
#pragma unroll
            for (int t = 0; t < 16; ++t) *(LAS unsigned short*)(L + RW_DB + blk * 1280 + t * 80 + slot * 2) = (unsigned short)f2bf(z[t]); }
        const f32x4 z4 = (f32x4){0.f, 0.f, 0.f, 0.f};
        bf16x8 sb[2], vf[2], ub[2];
        f32x4 XT[4];
        if (w < 4) {
            bf16x8 fa[4][2], fk[4][2];
            vf[0] = RW_LDT(RW_VI, w, 0); vf[1] = RW_LDT(RW_VI, w, 1);
#pragma unroll
            for (int t4 = 0; t4 < 4; ++t4) { fa[t4][0] = RW_LDA(RW_AT, 16 * t4 + fr, 0); fa[t4][1] = RW_LDA(RW_AT, 16 * t4 + fr, 1); fk[t4][0] = RW_LDA(RW_GAK, 16 * t4 + fr, 0); if (t4 >= 2) fk[t4][1] = RW_LDA(RW_GAK, 16 * t4 + fr, 1); }
            __builtin_amdgcn_sched_barrier(0);
            sb[0] = pack8(ST[0], ST[1]); sb[1] = pack8(ST[2], ST[3]);
#pragma unroll
            for (int t4 = 0; t4 < 4; ++t4) { f32x4 acc = z4;
                acc = RW_MFMA(fa[t4][0], sb[0], acc); acc = RW_MFMA(fa[t4][1], sb[1], acc);
                acc = RW_MFMA(fk[t4][0], vf[0], acc); if (t4 >= 2) acc = RW_MFMA(fk[t4][1], vf[1], acc);
                XT[t4] = acc; }
        }
        __syncthreads();
        if (w < 4) {
#define RW_DBF(blk) (*(const LAS bf16x8*)(L + RW_DB + (blk) * 1280 + fr * 80 + (8 * G) * 2))
            bf16x8 fd[4], fg[4];
#pragma unroll
            for (int q = 0; q < 4; ++q) fd[q] = RW_DBF(q);
            fg[0] = RW_LDA(RW_GAB, 16 + fr, 0); fg[1] = RW_LDA(RW_GAB, 32 + fr, 0); fg[2] = RW_LDA(RW_GAB, 48 + fr, 0); fg[3] = RW_LDA(RW_GAB, 48 + fr, 1);
            __builtin_amdgcn_sched_barrier(0);
            const f32x4 U0 = RW_MFMA(fd[0], pack4z(XT[0]), z4);
            ub[0] = pack4z(U0);
            const f32x4 Z1 = RW_MFMA(fg[0], ub[0], XT[1]);
            const f32x4 U1 = RW_MFMA(fd[1], pack4z(Z1), z4);
            ub[0] = pack8(U0, U1);
            const f32x4 Z2 = RW_MFMA(fg[1], ub[0], XT[2]);
            const f32x4 U2 = RW_MFMA(fd[2], pack4z(Z2), z4);
            ub[1] = pack4z(U2);
            f32x4 Z3 = RW_MFMA(fg[2], ub[0], XT[3]); Z3 = RW_MFMA(fg[3], ub[1], Z3);
            const f32x4 U3 = RW_MFMA(fd[3], pack4z(Z3), z4);
            ub[1] = pack8(U2, U3);
#undef RW_DBF
            __builtin_amdgcn_sched_barrier(0);
            bf16x8 fy[4][2], fbr[4][2], fkr[4][2];
#pragma unroll
            for (int t4 = 0; t4 < 4; ++t4) { fy[t4][0] = RW_LDA(RW_RT, 16 * t4 + fr, 0); fy[t4][1] = RW_LDA(RW_RT, 16 * t4 + fr, 1); fbr[t4][0] = RW_LDA(RW_GBR, 16 * t4 + fr, 0); fkr[t4][0] = RW_LDA(RW_GKR, 16 * t4 + fr, 0);
                if (t4 >= 2) { fbr[t4][1] = RW_LDA(RW_GBR, 16 * t4 + fr, 1); fkr[t4][1] = RW_LDA(RW_GKR, 16 * t4 + fr, 1); } }
            __builtin_amdgcn_sched_barrier(0);
#pragma unroll
            for (int t4 = 0; t4 < 4; ++t4) { f32x4 acc = z4;
                acc = RW_MFMA(fy[t4][0], sb[0], acc); acc = RW_MFMA(fy[t4][1], sb[1], acc);
                acc = RW_MFMA(fbr[t4][0], ub[0], acc); acc = RW_MFMA(fkr[t4][0], vf[0], acc);
                if (t4 >= 2) { acc = RW_MFMA(fbr[t4][1], ub[1], acc); acc = RW_MFMA(fkr[t4][1], vf[1], acc); }
#pragma unroll
                for (int r = 0; r < 4; ++r) YT[(16 * t4 + 4 * G + r) * RW_FS + 16 * w + fr] = acc[r]; }
            __builtin_amdgcn_sched_barrier(0);
            bf16x8 fbh[4][2], fkh[4][2];
#pragma unroll
            for (int jt = 0; jt < 4; ++jt) { fbh[jt][0] = RW_LDT(RW_BH, jt, 0); fbh[jt][1] = RW_LDT(RW_BH, jt, 1); fkh[jt][0] = RW_LDT(RW_KH, jt, 0); fkh[jt][1] = RW_LDT(RW_KH, jt, 1); }
            __builtin_amdgcn_sched_barrier(0);
#pragma unroll
            for (int jt = 0; jt < 4; ++jt) { const f32x4 wc4 = *(const LAS f32x4*)(WC + 16 * jt + 4 * G); f32x4 acc = ST[jt] * wc4;
                acc = RW_MFMA(fbh[jt][0], ub[0], acc); acc = RW_MFMA(fbh[jt][1], ub[1], acc);
                acc = RW_MFMA(fkh[jt][0], vf[0], acc); acc = RW_MFMA(fkh[jt][1], vf[1], acc);
                ST[jt] = acc; }
        }
        __syncthreads();
        { float y[8]; float s = 0.f;
#pragma unroll
            for (int q = 0; q < 2; ++q) { const f32x4 a = *(const LAS f32x4*)(YT + ct * RW_FS + 8 * cg + 4 * q); y[4 * q] = a[0]; y[4 * q + 1] = a[1]; y[4 * q + 2] = a[2]; y[4 * q + 3] = a[3]; s += (a[0] + a[1]) + (a[2] + a[3]); }
            const float mean = row8_sum(s) * (1.0f / 64.0f); float qv = 0.f;
#pragma unroll
            for (int i = 0; i < 8; ++i) { y[i] -= mean; qv += y[i] * y[i]; }
            const float rstd = 1.0f / sqrtf(row8_sum(qv) * (1.0f / 64.0f) + RWKV_LN_EPS); const float bon = BON[ct];
            float o[8]; const v4u vpk = *(const LAS v4u*)(L + RW_VI + ct * RW_OPS + (8 * cg) * 2);
#pragma unroll
            for (int i = 0; i < 8; ++i) { const int ch = 8 * cg + i; const float vv = (i & 1) ? bfhi(vpk[i >> 1]) : bflo(vpk[i >> 1]); const float yn = y[i] * rstd * PAR[192 + ch] + PAR[256 + ch] + bon * vv; o[i] = yn * ((i & 1) ? bfhi(gpk[i >> 1]) : bflo(gpk[i >> 1])); }
            v4u ov; ov.x = pk2(o[0], o[1]); ov.y = pk2(o[2], o[3]); ov.z = pk2(o[4], o[5]); ov.w = pk2(o[6], o[7]);
            *(v4u*)(Y + (m0 + ct) * DM + 512 + hc0 + 8 * cg) = ov; }
        __syncthreads();
    }
    pg8::ch_publish_now(ycnt + pg8::CH_STRIDE * 7, F.colo);
#undef RW_ISSUE
}
#undef RW_MFMA
#undef RW_LDA
#undef RW_LDT

typedef float f32x16 __attribute__((ext_vector_type(16)));
constexpr int AT_ROWB = 528;
__device__ __forceinline__ void attn_load_tile(Frame& F, const bf16* src  ) {
    const unsigned voff = (unsigned)(F.tid >> 5) * 4096u + (unsigned)(F.tid & 31) * 16u;
    LAS unsigned char* dst = F.lds + (F.tid >> 5) * AT_ROWB + (F.tid & 31) * 16;
#pragma unroll
    for (int hh = 0; hh < 2; ++hh) { v4u r[8];
#pragma unroll
        for (int i = 0; i < 8; ++i) r[i] = *(const v4u*)((const char*)src + (size_t)(8 * hh + i) * 65536 + voff);
#pragma unroll
        for (int i = 0; i < 8; ++i) *(LAS v4u*)(dst + (8 * hh + i) * 16 * AT_ROWB) = r[i]; }
}
__device__ __forceinline__ void attn_unit(Frame& F, int b, int hd, int qt) {
    const int lane = F.lane, w = F.wave, r32 = lane & 31, hi = lane >> 5;
    const bf16* kv = (const bf16*)(F.ws + WS_KV) + (size_t)b * MEMT * 2048 + 256 * hd;
    bf16* QO = (bf16*)((unsigned char*)F.out + OUT_QO);
    const size_t qrow = (size_t)b * SEQ + 256 * qt + 32 * w + r32;
    attn_load_tile(F, kv);
    bf16x8 qf[16];
#pragma unroll
    for (int ks = 0; ks < 16; ++ks) qf[ks] = *(const bf16x8*)((const char*)(QO + ((size_t)b * SEQ + 256 * qt + 32 * w) * DM + 256 * hd + 16 * ks) + (unsigned)(r32 * 2048 + hi * 16));
    __syncthreads();
    float mxh[2], smh[2];
    bf16x8 pf[16];
#pragma unroll
    for (int half = 0; half < 2; ++half) {
        f32x16 s[4];
#pragma unroll
        for (int k4 = 0; k4 < 4; ++k4)
#pragma unroll
            for (int r = 0; r < 16; ++r) s[k4][r] = 0.f;
        bf16x8 fa[2][4];
#define AT_LDB(buf, hb) _Pragma("unroll") for (int j_ = 0; j_ < 4; ++j_) fa[buf][j_] = *(const LAS bf16x8*)(F.lds + (32 * (4 * half + ((hb) >> 2)) + r32) * AT_ROWB + (16 * (4 * ((hb) & 3) + j_) + 8 * hi) * 2);
        AT_LDB(0, 0)
#pragma unroll
        for (int hb = 0; hb < 16; ++hb) {
            __builtin_amdgcn_sched_barrier(0);
            if (hb + 1 < 16) { AT_LDB((hb + 1) & 1, hb + 1) }
            __builtin_amdgcn_sched_barrier(0);
#pragma unroll
            for (int j = 0; j < 4; ++j) s[hb >> 2] = __builtin_amdgcn_mfma_f32_32x32x16_bf16(fa[hb & 1][j], qf[4 * (hb & 3) + j], s[hb >> 2], 0, 0, 0);
        }
#undef AT_LDB
        float mx = -INFINITY;
#pragma unroll
        for (int k4 = 0; k4 < 4; ++k4)
#pragma unroll
            for (int r = 0; r < 16; ++r) mx = fmaxf(mx, s[k4][r]);
        mx = fmaxf(mx, __shfl_xor(mx, 32));
        float sum = 0.f;
#pragma unroll
        for (int k4 = 0; k4 < 4; ++k4) {
#pragma unroll
            for (int r = 0; r < 16; ++r) { s[k4][r] = __builtin_amdgcn_exp2f(s[k4][r] - mx); sum += s[k4][r]; }
#pragma unroll
            for (int ss = 0; ss < 2; ++ss) { const unsigned a0 = pk2(s[k4][8 * ss + 0], s[k4][8 * ss + 1]), a1 = pk2(s[k4][8 * ss + 2], s[k4][8 * ss + 3]), a2 = pk2(s[k4][8 * ss + 4], s[k4][8 * ss + 5]), a3 = pk2(s[k4][8 * ss + 6], s[k4][8 * ss + 7]);
                pf[8 * half + 2 * k4 + ss] = __builtin_bit_cast(bf16x8, (v4u){a0, a1, a2, a3}); }
        }
        sum += __shfl_xor(sum, 32);
        mxh[half] = mx; smh[half] = sum;
    }
    __syncthreads();
    attn_load_tile(F, kv + 1024);
    const float mxa = fmaxf(mxh[0], mxh[1]);
    float f0 = __builtin_amdgcn_exp2f(mxh[0] - mxa), f1 = __builtin_amdgcn_exp2f(mxh[1] - mxa);
    const float inv = 1.0f / (f0 * smh[0] + f1 * smh[1]);
    f0 *= inv; f1 *= inv;
    __syncthreads();
    const int G4 = lane >> 4;
    const LAS unsigned char* vb = F.lds + (4 * (G4 >> 1) + ((lane >> 2) & 3)) * AT_ROWB + (16 * (G4 & 1) + 4 * (lane & 3)) * 2;
#pragma unroll 1
    for (int dt = 0; dt < 8; ++dt) {
        f32x16 oa, ob;
#pragma unroll
        for (int r = 0; r < 16; ++r) { oa[r] = 0.f; ob[r] = 0.f; }
#pragma unroll
        for (int kk = 0; kk < 8; ++kk) { const s16x4 lo = lds_tr16(vb + (16 * kk) * AT_ROWB + dt * 64), hi4 = lds_tr16(vb + (16 * kk + 8) * AT_ROWB + dt * 64);
            oa = __builtin_amdgcn_mfma_f32_32x32x16_bf16(cat8(lo, hi4), pf[kk], oa, 0, 0, 0);
            const s16x4 lo2 = lds_tr16(vb + (16 * kk + 128) * AT_ROWB + dt * 64), hi42 = lds_tr16(vb + (16 * kk + 136) * AT_ROWB + dt * 64);
            ob = __builtin_amdgcn_mfma_f32_32x32x16_bf16(cat8(lo2, hi42), pf[kk + 8], ob, 0, 0, 0); }
#pragma unroll
        for (int rg = 0; rg < 4; ++rg) { uint2 ov; ov.x = pk2(oa[4 * rg + 0] * f0 + ob[4 * rg + 0] * f1, oa[4 * rg + 1] * f0 + ob[4 * rg + 1] * f1); ov.y = pk2(oa[4 * rg + 2] * f0 + ob[4 * rg + 2] * f1, oa[4 * rg + 3] * f0 + ob[4 * rg + 3] * f1);
            *(uint2*)(QO + qrow * DM + 256 * hd + 32 * dt + 8 * rg + 4 * hi) = ov; }
    }
    __syncthreads();
}

#ifndef MK_N_LAUNCHES
#define MK_N_LAUNCHES 1
#endif
constexpr int N_PHASES = 10;
struct Args { const float* in[30]; float* out; unsigned char* ws; int ph_lo, ph_hi; };
__global__ void __launch_bounds__(NWAVES * 64, 2) mega_fwd(Args args) {
    extern __shared__ __attribute__((aligned(16))) unsigned char lds[];
    Frame F;
    F.lds = (LAS unsigned char*)lds;
    F.tid = threadIdx.x; F.lane = F.tid & 63; F.wave = __builtin_amdgcn_readfirstlane(F.tid >> 6);
    F.G = gridDim.x; { const int bx = blockIdx.x; F.vcu = (F.G % 8 == 0) ? (bx % 8) * (F.G / 8) + bx / 8 : bx; }
    F.in.p = (const float* const __attribute__((address_space(4)))*)__builtin_amdgcn_kernarg_segment_ptr();
    F.out = args.out; F.ws = args.ws;
    unsigned char* ws = args.ws;
    volatile LAS unsigned* MISC = (volatile LAS unsigned*)(F.lds + MISC_OFF);
    if (F.tid < 64) MISC[F.tid] = 0u;
    __syncthreads();
    const int lo = args.ph_lo, hi = args.ph_hi;
    const bool multi = (hi - lo) > 1;
    XcdBarrier bar; bar.bar = (unsigned*)(ws + WS_CTL) + CW_BAR; bar.x = 0; bar.st = nullptr;
    if (multi) { bar = xcd_barrier_post((unsigned*)(ws + WS_CTL) + CW_BAR, MISC + 8);
        if (F.tid == 0) (void)__hip_atomic_fetch_or((unsigned*)(ws + WS_CTL) + CW_GRP + 64 * (blockIdx.x & 7), 1u << bar.x, __ATOMIC_RELAXED, __HIP_MEMORY_SCOPE_AGENT); }
    bool colo = false;
#ifndef PHASE_MASK
#define PHASE_MASK 0x3ff
#endif
#define IN(k) (((PHASE_MASK >> (k)) & 1) && lo <= (k) && (k) < hi)
#ifndef REP2_MASK
#define REP2_MASK 0
#endif
#define REPS(k) (((REP2_MASK >> (k)) & 1) ? 2 : 1)
#define SEAM(k) do { if (IN(k) && IN((k) + 1)) xcd_barrier(bar); } while (0)
#define LSEAM(k) do { if (IN(k) && IN((k) + 1)) { if (colo) xcd_barrier_local(bar); else xcd_barrier(bar); } } while (0)
    typedef pg8::bf16_t b16;
    if (IN(0)) { for (int rp = 0; rp < REPS(0); ++rp) { p0_prologue(F); __syncthreads(); } }
    SEAM(0);
    if (multi) {
        if (F.tid == 0) { unsigned ok = (F.G == 256) ? 1u : 0u;
#pragma unroll
            for (int j = 0; j < 8; ++j) { const unsigned m = xb_ld((unsigned*)(ws + WS_CTL) + CW_GRP + 64 * j); ok &= (m != 0u && (m & (m - 1u)) == 0u) ? 1u : 0u; }
            MISC[10] = ok; }
        __syncthreads();
        colo = __builtin_amdgcn_readfirstlane(MISC[10]) != 0u;
    }
    F.colo = colo;
    unsigned* chn = (unsigned*)(ws + WS_CTL) + CW_CHN; unsigned* tmo = (unsigned*)(ws + WS_CTL) + CW_BAR + XB_TMO;
    if (IN(1)) for (int rp = 0; rp < REPS(1); ++rp) {
        pg8::Gemm g{(const b16*)(ws + WS_XN), (const b16*)(ws + WS_WIN), M + MM, NZ + 2048, DM};
        pg8::Order2C S; S.o.init(F.G, (int)blockIdx.x);
        S.hooks_init(chn, tmo, colo, F.wave); S.wait_k0 = -1; S.need0 = 0u; S.pub_k0 = 11; S.wait_k1 = -1; S.need1 = 0u; S.pub_k1 = -1;
        pg8::EpiZ E{(b16*)(ws + WS_ZM), (b16*)(ws + WS_ZR), (b16*)(ws + WS_KV)};
        pg8::gemm_phase<pg8::EpiZ, pg8::Order2C, true, true>(F.lds, g, S, E);
    }
    if (IN(2)) {
#ifndef REP_LO
#define REP_LO 1
#endif
        const int gq = (int)(blockIdx.x & 7), jq = (int)(blockIdx.x >> 3), vq = jq - 16;
        const int pu = (F.G != 256) ? F.vcu : (jq < 16 ? 16 * gq + jq : 128 + 64 * (vq & 1) + 8 * gq + 4 * (vq >> 3) + ((vq >> 1) & 3));
        if (F.G != 256) late_weights(F, F.vcu, F.G); else if (pu >= 128) late_weights(F, pu - 128, 128);
        wsplit_arrive(bar, (unsigned*)(ws + WS_CTL) + CW_WSP);
        { const int nl = (F.G != 256) ? (512 - F.vcu + F.G - 1) / F.G : (jq < 16 ? 1 : 3);
          for (int s3 = 0; s3 < nl; ++s3) { int lb, ltb;
            if (F.G != 256) { const int u = F.vcu + F.G * s3; lb = u >> 5; ltb = u & 31; }
            else if (jq < 16) { lb = 2 * gq + (jq >> 3); ltb = jq & 7; }
            else { const int n = 16 * s3 + vq; lb = 2 * gq + (n & 1); ltb = 8 + (n >> 1); }
            lora_unit(F, lb, ltb); } }
#ifndef ML_SPLIT
#define ML_SPLIT 10
#endif
#ifndef REP_RW
#define REP_RW 1
#endif
#ifndef REP_ML
#define REP_ML 1
#endif
        for (int rep = 0; rep < REP_RW; ++rep) for (int u = pu; u < 128; u += F.G) rwkv_unit(F, u >> 3, u & 7);
        for (int rep = 0; rep < REP_ML; ++rep) for (int u = pu; u < 256; u += F.G) if (u >= 128) { const int v = (u - 128) & 63; mlstm_unit(F, v >> 2, v & 3, u < 192 ? ML_SPLIT : 16, u < 192 ? 0 : ML_SPLIT); }
    }
    if (IN(2)) { __syncthreads(); if (F.tid == 0) (void)__hip_atomic_fetch_add((unsigned*)(ws + WS_CTL) + CW_CHN + pg8::ch_word(5, 8), 1u, __ATOMIC_RELAXED, __HIP_MEMORY_SCOPE_AGENT); }
    if (IN(3)) {
        wsplit_wait(bar, (unsigned*)(ws + WS_CTL) + CW_WSP);
        pg8::Gemm g{(const b16*)F.out, (const b16*)(ws + WS_WMIX), M, DM, DM};
        typedef pg8::StreamOrder<pg8::OrderQ, pg8::OrderQ> Ord; typedef pg8::EpiPair<pg8::EpiRes, pg8::EpiQ> Epi;
        Ord S; S.o0.init(F.G, F.vcu); S.o1.init(F.G, F.vcu); S.count0(); S.A1 = (const b16*)(ws + WS_H1B); S.B1 = (const b16*)(ws + WS_WQ);
        S.hooks_init(chn, tmo, colo, F.wave); S.wait_k0 = 10; S.need0 = 96u; S.pub_k0 = 0; S.wait_k1 = 0; S.need1 = 32u; S.pub_k1 = -1;
        Epi E{pg8::EpiRes{(const b16*)(ws + WS_XN), (b16*)(ws + WS_H1B), (float*)(ws + WS_SSQ1), (const float*)(ws + WS_RMS)},
              pg8::EpiQ{(b16*)((unsigned char*)F.out + OUT_QO), (const float*)(ws + WS_SSQ1), EPS, LOG2E * 0.0625f, F.lds}};
        pg8::gemm_phase<Epi, Ord, true, true>(F.lds, g, S, E);
        if (F.tid == 0) (void)__hip_atomic_fetch_add(chn + pg8::ch_word(5, (int)(blockIdx.x & 7)), 1u, __ATOMIC_RELAXED, __HIP_MEMORY_SCOPE_AGENT);
    }
    if (IN(5)) {
        pg8::OrderQ S; S.init(F.G, F.vcu); pg8::Unit u;
        for (int i = 0; S.next(i, u); ++i) { pg8::ch_wait_n<1>(chn + pg8::ch_word(11, 128 + (u.pm >> 3)), pg8::CH_STRIDE, 64u, tmo, colo);
            attn_unit(F, u.pm >> 3, u.pn, u.pm & 7); pg8::ch_publish_now(chn + pg8::ch_word(1, u.pm), colo); }
        if (F.wave == 0) asm volatile("buffer_inv sc1" ::: "memory");
    }
    if (IN(6)) {
        if (F.wave == 0) pg8::ch_wait(chn + pg8::ch_word(5, 8), (unsigned)F.G, tmo);
        __syncthreads();
        pg8::Gemm g{(const b16*)((unsigned char*)F.out + OUT_QO), (const b16*)(ws + WS_WO), M, DM, DM};
        typedef pg8::StreamOrder<pg8::StaticOrder, pg8::StaticOrder> Ord; typedef pg8::EpiPair<pg8::EpiRes, pg8::EpiGlu> Epi;
        Ord S; S.o0.init(M, DM, F.G, (int)blockIdx.x); S.o1.init(M, 2 * DFF, F.G, (int)blockIdx.x); S.count0(); S.A1 = (const b16*)(ws + WS_H2B); S.B1 = (const b16*)(ws + WS_WGU);
        S.hooks_init(chn, tmo, colo, F.wave); S.wait_k0 = 1; S.need0 = 32u; S.pub_k0 = 2; S.wait_k1 = 2; S.need1 = 32u; S.pub_k1 = 3;
        Epi E{pg8::EpiRes{(const b16*)(ws + WS_H1B), (b16*)(ws + WS_H2B), (float*)(ws + WS_SSQ2), nullptr},
              pg8::EpiGlu{(b16*)(ws + WS_ACT), (const float*)(ws + WS_SSQ2), EPS, F.lds}};
        pg8::gemm_phase<Epi, Ord, true, true>(F.lds, g, S, E);
    }
    if (IN(8)) {
        if (F.G != 256) xcd_barrier(bar);
        pg8::Gemm g{(const b16*)(ws + WS_ACT), (const b16*)(ws + WS_WD), M, DM, DFF};
        pg8::ChainOrder S; S.so.init(M, DM, F.G, (int)blockIdx.x);
        S.hooks_init(chn, tmo, colo, F.wave); S.wait_k0 = 3; S.need0 = 176u; S.pub_k0 = -1; S.wait_k1 = -1; S.need1 = 0u; S.pub_k1 = -1;
        pg8::EpiResNorm E{(const b16*)(ws + WS_H2B), F.out, (float*)(ws + WS_SSQ3), F.in[29], EPS, chn, tmo, colo, F.G == 256};
        pg8::gemm_phase<pg8::EpiResNorm, pg8::ChainOrder, true, true>(F.lds, g, S, E);
        if (xb_ld(tmo) != 0u) F.out[(size_t)F.vcu * 128 * DM + F.tid] = __builtin_nanf("");
    }
#undef IN
#undef SEAM
#undef LSEAM
}

extern "C" void kernel_launch(void* const* d_in, const int* in_sizes, int n_in, void* d_out, int out_size, void* d_ws, size_t ws_size, hipStream_t stream) {
    static int grid = 0;
    if (grid == 0) {
        if (n_in != 30 || in_sizes[0] != M * DM || out_size != M * DM || ws_size < WS_END) { fprintf(stderr, "kernel_launch: unexpected problem: n_in %d in0 %d out %d ws %zu (need %zu); nothing launched\n", n_in, n_in > 0 ? in_sizes[0] : -1, out_size, ws_size, (size_t)WS_END); grid = -1; return; }
        int dev = 0, cus = 0, per_cu = 0;
        if (hipGetDevice(&dev) != hipSuccess || hipDeviceGetAttribute(&cus, hipDeviceAttributeMultiprocessorCount, dev) != hipSuccess) { grid = -1; return; }
        if (hipFuncSetAttribute((const void*)mega_fwd, hipFuncAttributeMaxDynamicSharedMemorySize, LDS_BYTES) != hipSuccess) { fprintf(stderr, "kernel_launch: hipFuncSetAttribute(%d B LDS) failed\n", LDS_BYTES); grid = -1; return; }
        if (hipOccupancyMaxActiveBlocksPerMultiprocessor(&per_cu, (const void*)mega_fwd, NWAVES * 64, LDS_BYTES) != hipSuccess || per_cu < 1) { fprintf(stderr, "kernel_launch: occupancy query says %d blocks per CU\n", per_cu); }
        (void)hipGetLastError();
        grid = cus;
    }
    if (grid < 0) return;
    (void)hipMemsetAsync((char*)d_ws + WS_CTL, 0, CTL_ZERO_BYTES, stream);
    Args a{};
    for (int i = 0; i < 30; ++i) a.in[i] = (const float*)d_in[i];
    a.out = (float*)d_out; a.ws = (unsigned char*)d_ws;
#if MK_N_LAUNCHES == 1
    static_assert(MK_N_LAUNCHES == 1 && (ML_SPLIT & 1) == 0, "one launch (counter hand-offs); the mLSTM split must not cut a 256-token row panel");
    a.ph_lo = 0; a.ph_hi = N_PHASES;
    hipLaunchKernelGGL(mega_fwd, dim3(grid), dim3(NWAVES * 64), LDS_BYTES, stream, a);
#else
    for (int p = 0; p < N_PHASES; ++p) { a.ph_lo = p; a.ph_hi = p + 1; hipLaunchKernelGGL(mega_fwd, dim3(grid), dim3(NWAVES * 64), LDS_BYTES, stream, a); }
#endif
}
```

```cpp
#include <hip/hip_runtime.h>
#include <hip/hip_bf16.h>
#include <cstdio>
#include <cstdint>
namespace pg8 {
#define PG8_LAS __attribute__((address_space(3)))
typedef unsigned short bf16_t;
typedef short bf16x8 __attribute__((ext_vector_type(8)));
typedef float f32x4 __attribute__((ext_vector_type(4)));
typedef unsigned u32x4 __attribute__((ext_vector_type(4)));
constexpr int BM = 256, BK = 64, HALF = 128, HTB = HALF * BK * 2  , STAGE_BYTES = 8 * HTB, NXCD = 8, WGM = 4;

__host__ __device__ __forceinline__ int lds_byte(int r, int c) { const int st = (r >> 4) * 2 + (c >> 5), rr = r & 15, cc = c & 31, ob = rr * 64 + cc * 2; return st * 1024 + (ob ^ (((ob >> 9) & 1) << 5)); }
__host__ __device__ __forceinline__ void stage_rc(int b, int& R, int& C) { const int st = b / 1024, sb = b % 1024, swz = sb ^ (((sb >> 9) & 1) << 5); R = (st >> 1) * 16 + swz / 64; C = (st & 1) * 32 + (swz % 64) / 2; }
__host__ __device__ __forceinline__ int perm32(int rho) { const int n = rho >> 4, i = rho & 15; return 8 * (i >> 2) + 4 * n + (i & 3); }

struct Unit { int pm, pn, ph; };
struct Gemm { const bf16_t* A; const bf16_t* Bt; int M, N, K; };

struct NoChain {
    static constexpr int A_AUX = 0;
    __device__ __forceinline__ const char* pa(const Gemm& g, const Unit& u, size_t tstep) const { return (const char*)g.A + (size_t)u.pm * tstep; }
    __device__ __forceinline__ const char* pb(const Gemm& g, const Unit& u, size_t tstep) const { return (const char*)g.Bt + (size_t)u.pn * tstep; }
    __device__ __forceinline__ void a_ready(const Unit&) const {}
    __device__ __forceinline__ void done(const Unit&) const {}
    __device__ __forceinline__ void flush() const {}
};
struct StaticOrder : NoChain {
    int nM, nN, nwg, G, c;
    __host__ __device__ void init(int M, int N, int G_, int c_) { nM = M / BM; nN = N / BM; nwg = nM * nN; G = G_; c = c_; }
    __host__ __device__ bool next(int i, Unit& u) const {
        const long L = (long)i * G + c; if (L >= nwg) return false;
        int wgid = (int)L; { const int q = nwg / NXCD, r = nwg % NXCD, xcd = wgid % NXCD, off = wgid / NXCD; wgid = (xcd < r ? xcd * (q + 1) : r * (q + 1) + (xcd - r) * q) + off; }
        const int nig = WGM * nN, gid = wgid / nig, fm = gid * WGM, gsz = (nM - fm) < WGM ? (nM - fm) : WGM;
        u.pm = fm + ((wgid % nig) % gsz); u.pn = (wgid % nig) / gsz; return true;
    }
};

__device__ __forceinline__ unsigned cvt_pk_bf16(float lo, float hi) { unsigned r; asm volatile("v_cvt_pk_bf16_f32 %0, %1, %2" : "=v"(r) : "v"(lo), "v"(hi)); return r; }
typedef float f32x2 __attribute__((ext_vector_type(2)));

struct Order2 : NoChain {
    StaticOrder so; int G, c;
    __device__ void init(int G_, int c_) { so.init(32768, 3840, G_, c_); G = G_; c = c_; }
    __device__ bool next(int i, Unit& u) const {
        const long L = (long)i * G + c;
        if (L < 1920) return so.next(i, u);
        const int Lp = (int)(L - 1920); if (Lp >= 128) return false;
        const int xcd = Lp & 7, off = Lp >> 3;
        u.pm = 128 + xcd * 2 + (off & 1); u.pn = 15 + (off >> 1); return true;
    }
};

struct OrderQ : NoChain {
    int G, vcu;
    __device__ void init(int G_, int vcu_) { G = G_; vcu = vcu_; }
    __device__ bool next(int i, Unit& u) const {
        const int U = vcu + G * i; if (U >= 512) return false;
        const int idx = (U % 256) * 2 + U / 256;
        u.pm = 8 * (idx >> 5) + (idx & 7); u.pn = (idx >> 3) & 3; return true;
    }
};


struct EpiZ {
    static constexpr bool PERM = true, AFTER_DRAIN = false;
    __device__ __forceinline__ void prefetch(const Unit&, PG8_LAS unsigned char*, int, int) const {}
    bf16_t* zm; bf16_t* zr; bf16_t* kv;
    __device__ __forceinline__ void operator()(const f32x4 (&acc)[2][2][4][2], const Unit& u, int wr, int wc, int fr, int fq) const {
        bf16_t* base; int ldc; int row0 = u.pm * BM + wr * 64 + fr; int colt;
        if (u.pm < 128) { if (u.pn < 8) { base = zm; ldc = 2048; colt = u.pn * BM; } else { base = zr; ldc = 1792; colt = (u.pn - 8) * BM; } }
        else { base = kv; ldc = 2048; colt = (u.pn - 15) * BM; row0 -= 32768; }
        const int col0 = colt + wc * 32 + 8 * fq;
#pragma unroll
        for (int ai = 0; ai < 2; ++ai)
#pragma unroll
            for (int m = 0; m < 4; ++m) { bf16_t* rowp = base + (size_t)(row0 + ai * HALF + m * 16) * ldc + col0;
#pragma unroll
                for (int bj = 0; bj < 2; ++bj) { const f32x4 v0 = acc[ai][bj][m][0], v1 = acc[ai][bj][m][1];
                    u32x4 w; w.x = cvt_pk_bf16(v0[0], v0[1]); w.y = cvt_pk_bf16(v0[2], v0[3]); w.z = cvt_pk_bf16(v1[0], v1[1]); w.w = cvt_pk_bf16(v1[2], v1[3]);
                    *(u32x4*)(rowp + bj * HALF) = w; } }
    }
};

__device__ __forceinline__ float row_rstd16(const float* ssq, int row, float eps) {
    const f32x4* p = (const f32x4*)(ssq + (size_t)row * 16);
    const f32x4 a = p[0], b = p[1], c = p[2], d = p[3];
    const float s = ((a[0] + a[1]) + (a[2] + a[3])) + ((b[0] + b[1]) + (b[2] + b[3])) + ((c[0] + c[1]) + (c[2] + c[3])) + ((d[0] + d[1]) + (d[2] + d[3]));
    return 1.0f / sqrtf(s * (1.0f / 1024.0f) + eps);
}
__device__ __forceinline__ void rows_rstd(const float* ssq, int row0, int fq, float eps, float (&rs)[2][4]) {
    f32x4 pp[2][4];
#pragma unroll
    for (int ai = 0; ai < 2; ++ai)
#pragma unroll
        for (int m = 0; m < 4; ++m) pp[ai][m] = *(const f32x4*)(ssq + (size_t)(row0 + ai * HALF + m * 16) * 16 + 4 * fq);
#pragma unroll
    for (int ai = 0; ai < 2; ++ai)
#pragma unroll
        for (int m = 0; m < 4; ++m) { float t = (pp[ai][m][0] + pp[ai][m][1]) + (pp[ai][m][2] + pp[ai][m][3]); t += __shfl_xor(t, 16); t += __shfl_xor(t, 32); rs[ai][m] = 1.0f / sqrtf(t * (1.0f / 1024.0f) + eps); }
}

constexpr int SSQ_LDS = 131072;
__device__ __forceinline__ void ssq_prefetch(const float* ssq, int pm, PG8_LAS unsigned char* lds, int wid, int lane) {
    const char* g = (const char*)(ssq + ((size_t)pm * BM + 32 * wid) * 16) + lane * 16;
#pragma unroll
    for (int i = 0; i < 2; ++i) __builtin_amdgcn_global_load_lds((const unsigned*)(g + i * 1024), (PG8_LAS unsigned*)(lds + SSQ_LDS + wid * 2048 + i * 1024), 16, 0, 0);
}
__device__ __forceinline__ void rows_rstd_lds(const PG8_LAS unsigned char* lds, int rt0  , int fq, float eps, float (&rs)[2][4]) {
    f32x4 pp[2][4];
#pragma unroll
    for (int ai = 0; ai < 2; ++ai)
#pragma unroll
        for (int m = 0; m < 4; ++m) pp[ai][m] = *(const PG8_LAS f32x4*)(lds + SSQ_LDS + (rt0 + ai * HALF + m * 16) * 64 + 16 * fq);
#pragma unroll
    for (int ai = 0; ai < 2; ++ai)
#pragma unroll
        for (int m = 0; m < 4; ++m) { float t = (pp[ai][m][0] + pp[ai][m][1]) + (pp[ai][m][2] + pp[ai][m][3]); t += __shfl_xor(t, 16); t += __shfl_xor(t, 32); rs[ai][m] = 1.0f / sqrtf(t * (1.0f / 1024.0f) + eps); }
}

struct EpiRes {
    static constexpr bool PERM = true, AFTER_DRAIN = false;
    __device__ __forceinline__ void prefetch(const Unit&, PG8_LAS unsigned char*, int, int) const {}
    const bf16_t* base; bf16_t* hb; float* ssq; const float* rscale;
    __device__ __forceinline__ void operator()(const f32x4 (&acc)[2][2][4][2], const Unit& u, int wr, int wc, int fr, int fq) const {
        const int row0 = u.pm * BM + wr * 64 + fr, col0 = u.pn * BM + wc * 32 + 8 * fq;
        u32x4 bb[2][4][2];
#pragma unroll
        for (int ai = 0; ai < 2; ++ai)
#pragma unroll
            for (int m = 0; m < 4; ++m) { const int row = row0 + ai * HALF + m * 16;
#pragma unroll
                for (int bj = 0; bj < 2; ++bj) bb[ai][m][bj] = *(const u32x4*)(base + (size_t)row * 1024 + col0 + bj * HALF); }
        __builtin_amdgcn_sched_barrier(0);
#pragma unroll
        for (int ai = 0; ai < 2; ++ai)
#pragma unroll
            for (int m = 0; m < 4; ++m) { const int row = row0 + ai * HALF + m * 16; const size_t off = (size_t)row * 1024 + col0; float ss = 0.f; const float r_ = rscale ? rscale[row] : 1.0f;
#pragma unroll
                for (int bj = 0; bj < 2; ++bj) { const u32x4 b4 = bb[ai][m][bj];
                    const f32x4 b0 = (f32x4){__builtin_bit_cast(float, b4.x << 16), __builtin_bit_cast(float, b4.x & 0xffff0000u), __builtin_bit_cast(float, b4.y << 16), __builtin_bit_cast(float, b4.y & 0xffff0000u)};
                    const f32x4 b1 = (f32x4){__builtin_bit_cast(float, b4.z << 16), __builtin_bit_cast(float, b4.z & 0xffff0000u), __builtin_bit_cast(float, b4.w << 16), __builtin_bit_cast(float, b4.w & 0xffff0000u)};
                    const f32x4 v0 = acc[ai][bj][m][0] + b0 * r_, v1 = acc[ai][bj][m][1] + b1 * r_;
                    ss += (v0[0] * v0[0] + v0[1] * v0[1]) + (v0[2] * v0[2] + v0[3] * v0[3]) + (v1[0] * v1[0] + v1[1] * v1[1]) + (v1[2] * v1[2] + v1[3] * v1[3]);
                    u32x4 w; w.x = cvt_pk_bf16(v0[0], v0[1]); w.y = cvt_pk_bf16(v0[2], v0[3]); w.z = cvt_pk_bf16(v1[0], v1[1]); w.w = cvt_pk_bf16(v1[2], v1[3]);
                    *(u32x4*)(hb + off + bj * HALF) = w; }
                ss += __shfl_xor(ss, 16); ss += __shfl_xor(ss, 32);
                if (fq == 0) ssq[(size_t)row * 16 + u.pn * 4 + wc] = ss; }
    }
};

struct EpiResF32 {
    static constexpr bool PERM = true, AFTER_DRAIN = false;
    __device__ __forceinline__ void prefetch(const Unit&, PG8_LAS unsigned char*, int, int) const {}
    const float* base; bf16_t* hb; float* ssq;
    __device__ __forceinline__ void operator()(const f32x4 (&acc)[2][2][4][2], const Unit& u, int wr, int wc, int fr, int fq) const {
        const int row0 = u.pm * BM + wr * 64 + fr, col0 = u.pn * BM + wc * 32 + 8 * fq;
#pragma unroll
        for (int ai = 0; ai < 2; ++ai) {
            f32x4 bb[4][2][2];
#pragma unroll
            for (int m = 0; m < 4; ++m) { const size_t off = (size_t)(row0 + ai * HALF + m * 16) * 1024 + col0;
#pragma unroll
                for (int bj = 0; bj < 2; ++bj) { bb[m][bj][0] = *(const f32x4*)(base + off + bj * HALF); bb[m][bj][1] = *(const f32x4*)(base + off + bj * HALF + 4); } }
            __builtin_amdgcn_sched_barrier(0);
#pragma unroll
            for (int m = 0; m < 4; ++m) { const int row = row0 + ai * HALF + m * 16; const size_t off = (size_t)row * 1024 + col0; float ss = 0.f;
#pragma unroll
                for (int bj = 0; bj < 2; ++bj) { const f32x4 v0 = acc[ai][bj][m][0] + bb[m][bj][0], v1 = acc[ai][bj][m][1] + bb[m][bj][1];
                    ss += (v0[0] * v0[0] + v0[1] * v0[1]) + (v0[2] * v0[2] + v0[3] * v0[3]) + (v1[0] * v1[0] + v1[1] * v1[1]) + (v1[2] * v1[2] + v1[3] * v1[3]);
                    u32x4 w; w.x = cvt_pk_bf16(v0[0], v0[1]); w.y = cvt_pk_bf16(v0[2], v0[3]); w.z = cvt_pk_bf16(v1[0], v1[1]); w.w = cvt_pk_bf16(v1[2], v1[3]);
                    *(u32x4*)(hb + off + bj * HALF) = w; }
                ss += __shfl_xor(ss, 16); ss += __shfl_xor(ss, 32);
                if (fq == 0) ssq[(size_t)row * 16 + u.pn * 4 + wc] = ss; }
            __builtin_amdgcn_sched_barrier(0);
        }
    }
};

struct EpiQ {
    static constexpr bool PERM = true, AFTER_DRAIN = false;
    bf16_t* q; const float* ssq; float eps, scale; PG8_LAS unsigned char* lds;
    __device__ __forceinline__ void prefetch(const Unit& u, PG8_LAS unsigned char* l, int wid, int lane) const { ssq_prefetch(ssq, u.pm, l, wid, lane); }
    __device__ __forceinline__ void operator()(const f32x4 (&acc)[2][2][4][2], const Unit& u, int wr, int wc, int fr, int fq) const {
        const int row0 = u.pm * BM + wr * 64 + fr, col0 = u.pn * BM + wc * 32 + 8 * fq;
        float rs8[2][4]; rows_rstd_lds(lds, wr * 64 + fr, fq, eps, rs8);
#pragma unroll
        for (int ai = 0; ai < 2; ++ai)
#pragma unroll
            for (int m = 0; m < 4; ++m) { const int row = row0 + ai * HALF + m * 16; const float rs = rs8[ai][m] * scale; bf16_t* rowp = q + (size_t)row * 1024 + col0;
#pragma unroll
                for (int bj = 0; bj < 2; ++bj) { const f32x4 v0 = acc[ai][bj][m][0] * rs, v1 = acc[ai][bj][m][1] * rs;
                    u32x4 w; w.x = cvt_pk_bf16(v0[0], v0[1]); w.y = cvt_pk_bf16(v0[2], v0[3]); w.z = cvt_pk_bf16(v1[0], v1[1]); w.w = cvt_pk_bf16(v1[2], v1[3]);
                    *(u32x4*)(rowp + bj * HALF) = w; } }
    }
};

typedef float f32x2cv_ __attribute__((ext_vector_type(2))); typedef __bf16 bf16x2cv_ __attribute__((ext_vector_type(2)));
__device__ __forceinline__ unsigned pk2f(float lo, float hi) { f32x2cv_ v = {lo, hi}; bf16x2cv_ b = __builtin_convertvector(v, bf16x2cv_); return __builtin_bit_cast(unsigned, b); }
typedef float f32x2e __attribute__((ext_vector_type(2)));
struct EpiGlu {
    static constexpr bool PERM = true, AFTER_DRAIN = false;
    bf16_t* act; const float* ssq; float eps; PG8_LAS unsigned char* lds;
    __device__ __forceinline__ void prefetch(const Unit& u, PG8_LAS unsigned char* l, int wid, int lane) const { ssq_prefetch(ssq, u.pm, l, wid, lane); }
    __device__ __forceinline__ void operator()(const f32x4 (&acc)[2][2][4][2], const Unit& u, int wr, int wc, int fr, int fq) const {
        const int row0 = u.pm * BM + wr * 64 + fr, col0 = u.pn * HALF + wc * 32 + 8 * fq;
        float rs8[2][4]; rows_rstd_lds(lds, wr * 64 + fr, fq, eps, rs8);
#pragma unroll
        for (int ai = 0; ai < 2; ++ai)
#pragma unroll
            for (int m = 0; m < 4; ++m) { const int row = row0 + ai * HALF + m * 16; const float rs = rs8[ai][m];
                const f32x2e c1 = {-1.4426950408889634f * rs, -1.4426950408889634f * rs}, c2 = {rs * rs, rs * rs}, one = {1.0f, 1.0f};
                unsigned wv[4];
#pragma unroll
                for (int n = 0; n < 2; ++n)
#pragma unroll
                    for (int hp = 0; hp < 2; ++hp) { const f32x2e g2 = {acc[ai][0][m][n][2 * hp], acc[ai][0][m][n][2 * hp + 1]}, u2 = {acc[ai][1][m][n][2 * hp], acc[ai][1][m][n][2 * hp + 1]};
                        const f32x2e t2 = g2 * c1; f32x2e e2; e2.x = __builtin_amdgcn_exp2f(t2.x); e2.y = __builtin_amdgcn_exp2f(t2.y);
                        const f32x2e d2 = e2 + one; f32x2e r2; r2.x = __builtin_amdgcn_rcpf(d2.x); r2.y = __builtin_amdgcn_rcpf(d2.y);
                        const f32x2e o2 = ((g2 * u2) * c2) * r2;
                        wv[2 * n + hp] = pk2f(o2.x, o2.y); }
                u32x4 w; w.x = wv[0]; w.y = wv[1]; w.z = wv[2]; w.w = wv[3];
                *(u32x4*)(act + (size_t)row * 2816 + col0) = w; }
    }
};
template <class Epi, class Sched, bool ALIGN_EPI = false, bool SP2 = false>
__device__ __forceinline__ void gemm_phase(PG8_LAS unsigned char* lds, const Gemm g, const Sched& S, const Epi& E) {
    const int tid = threadIdx.x, wid = __builtin_amdgcn_readfirstlane(tid >> 6), lane = tid & 63, wr = wid >> 2, wc = wid & 3, fr = lane & 15, fq = lane >> 4;
    const int K = g.K, nt = K / BK;
    unsigned voffA[2], voffB[2];
#pragma unroll
    for (int i = 0; i < 2; ++i) { int R, C; stage_rc(tid * 16 + i * 8192, R, C); const int Rb = Epi::PERM ? ((R & ~31) + perm32(R & 31)) : R;
        voffA[i] = (unsigned)(R * K + C) * 2u; voffB[i] = (unsigned)(Rb * K + C) * 2u; }
    const size_t kstep = (size_t)(BK * 2);
    const size_t hstep = (size_t)HALF * K * 2;
    const size_t tstep = 2 * hstep;
    const unsigned ldsw = (unsigned)wid * 1024u;
    const int aoff = lds_byte(wr * 64 + fr, fq * 8), boff = lds_byte(wc * 32 + fr, fq * 8);
#define PG8_SA(b, h) (((b) * 2 + (h)) * HTB)
#define PG8_SB(b, h) ((4 + (b) * 2 + (h)) * HTB)
#define PG8_STAGE(bufoff, gbase, voff) do { _Pragma("unroll") for (int _i = 0; _i < 2; ++_i) \
        __builtin_amdgcn_global_load_lds((const unsigned*)((const char*)(gbase) + (voff)[_i]), (PG8_LAS unsigned*)(lds + (bufoff) + ldsw + _i * 8192), 16, 0, 0); } while (0)
#define PG8_STAGEA(bufoff, gbase, voff) do { _Pragma("unroll") for (int _i = 0; _i < 2; ++_i) \
        __builtin_amdgcn_global_load_lds((const unsigned*)((const char*)(gbase) + (voff)[_i]), (PG8_LAS unsigned*)(lds + (bufoff) + ldsw + _i * 8192), 16, 0, Sched::A_AUX); } while (0)
#define PG8_LDA(dst, b, h) do { _Pragma("unroll") for (int m = 0; m < 4; ++m) _Pragma("unroll") for (int k = 0; k < 2; ++k) dst[m][k] = *(const PG8_LAS bf16x8*)(lds + PG8_SA(b, h) + aoff + m * 2048 + k * 1024); } while (0)
#define PG8_LDB(dst, b, h) do { _Pragma("unroll") for (int n = 0; n < 2; ++n) _Pragma("unroll") for (int k = 0; k < 2; ++k) dst[n][k] = *(const PG8_LAS bf16x8*)(lds + PG8_SB(b, h) + boff + n * 2048 + k * 1024); } while (0)
#define PG8_MMA(ai, bj, At, Bt) do { __builtin_amdgcn_s_setprio(1); _Pragma("unroll") for (int m = 0; m < 4; ++m) _Pragma("unroll") for (int n = 0; n < 2; ++n) _Pragma("unroll") for (int k = 0; k < 2; ++k) \
        acc[ai][bj][m][n] = __builtin_amdgcn_mfma_f32_16x16x32_bf16(Bt[n][k], At[m][k], acc[ai][bj][m][n], 0, 0, 0); __builtin_amdgcn_s_setprio(0); } while (0)
#define PG8_WAIT_V(n) asm volatile("s_waitcnt vmcnt(" #n ")" ::: "memory")
#define PG8_WAIT_L(n) asm volatile("s_waitcnt lgkmcnt(" #n ")" ::: "memory")
#define PG8_BAR __builtin_amdgcn_s_barrier()
#define PG8_SCHED __builtin_amdgcn_sched_barrier(0)
    Unit cur, nxt; int ui = 0;
    if (!S.next(0, cur)) return;
    f32x4 acc[2][2][4][2];
#pragma unroll
    for (int a = 0; a < 2; ++a)
#pragma unroll
        for (int b = 0; b < 2; ++b)
#pragma unroll
            for (int m = 0; m < 4; ++m)
#pragma unroll
                for (int n = 0; n < 2; ++n) acc[a][b][m][n] = (f32x4){0.f, 0.f, 0.f, 0.f};
    bf16x8 At[4][2], B0[2][2], B1[2][2];
    const char* cA = S.pa(g, cur, tstep); const char* cB = S.pb(g, cur, tstep);
    S.a_ready(cur);
    if constexpr (SP2) {
        PG8_STAGE(PG8_SB(0, 0), cB, voffB); PG8_STAGE(PG8_SB(0, 1), cB + hstep, voffB); PG8_STAGEA(PG8_SA(0, 0), cA, voffA); PG8_STAGEA(PG8_SA(0, 1), cA + hstep, voffA);
        if (wr == 1) PG8_BAR;
        PG8_WAIT_V(2); PG8_BAR;
        PG8_STAGE(PG8_SB(1, 0), cB + kstep, voffB); PG8_STAGEA(PG8_SA(1, 0), cA + kstep, voffA); PG8_STAGE(PG8_SB(1, 1), cB + hstep + kstep, voffB);
        PG8_WAIT_V(6); PG8_BAR;
    } else {
        PG8_STAGE(PG8_SB(0, 0), cB, voffB); PG8_STAGEA(PG8_SA(0, 0), cA, voffA); PG8_STAGE(PG8_SB(0, 1), cB + hstep, voffB); PG8_STAGEA(PG8_SA(0, 1), cA + hstep, voffA);
        if (wr == 1) PG8_BAR;
        PG8_WAIT_V(4); PG8_BAR;
        PG8_STAGE(PG8_SB(1, 0), cB + kstep, voffB); PG8_STAGEA(PG8_SA(1, 0), cA + kstep, voffA); PG8_STAGE(PG8_SB(1, 1), cB + hstep + kstep, voffB);
        PG8_WAIT_V(6); PG8_BAR;
    }
    for (;;) {
        const bool has_next = S.next(ui + 1, nxt);
        const char* nA = has_next ? S.pa(g, nxt, tstep) : cA; const char* nB = has_next ? S.pb(g, nxt, tstep) : cB;
        for (int t = 0; t < nt; t += 2) {
            const bool last = (t == nt - 2);
            const char* a1 = cA + (size_t)(t + 1) * kstep;
            const char* a2 = last ? nA : cA + (size_t)(t + 2) * kstep; const char* b2 = last ? nB : cB + (size_t)(t + 2) * kstep;
            const char* a3 = a2 + kstep; const char* b3 = b2 + kstep;
            if (last) E.prefetch(cur, lds, wid, lane);
            if (last && has_next) S.a_ready(nxt);
            if (t == 2) S.flush();
            if constexpr (SP2) {
            PG8_LDB(B0, 0, 0); PG8_LDB(B1, 0, 1); PG8_SCHED; PG8_LDA(At, 0, 0); PG8_STAGEA(PG8_SA(1, 1), a1 + hstep, voffA);
            PG8_WAIT_V(8); PG8_WAIT_L(0); PG8_BAR; PG8_MMA(0, 0, At, B0); PG8_MMA(0, 1, At, B1); PG8_BAR; PG8_SCHED;
            PG8_LDA(At, 0, 1); PG8_STAGE(PG8_SB(0, 0), b2, voffB); PG8_STAGE(PG8_SB(0, 1), b2 + hstep, voffB); PG8_STAGEA(PG8_SA(0, 0), a2, voffA);
            PG8_WAIT_V(8); PG8_WAIT_L(0); PG8_BAR; PG8_MMA(1, 0, At, B0); PG8_MMA(1, 1, At, B1); PG8_BAR; PG8_SCHED;
            PG8_LDB(B0, 1, 0); PG8_LDB(B1, 1, 1); PG8_SCHED; PG8_LDA(At, 1, 0); PG8_STAGEA(PG8_SA(0, 1), a2 + hstep, voffA);
            PG8_WAIT_V(8); PG8_WAIT_L(0); PG8_BAR; PG8_MMA(0, 0, At, B0); PG8_MMA(0, 1, At, B1); PG8_BAR; PG8_SCHED;
            PG8_LDA(At, 1, 1); PG8_STAGE(PG8_SB(1, 0), b3, voffB); PG8_STAGE(PG8_SB(1, 1), b3 + hstep, voffB); PG8_STAGEA(PG8_SA(1, 0), a3, voffA);
            PG8_WAIT_V(8); PG8_WAIT_L(0); PG8_BAR; PG8_MMA(1, 0, At, B0); PG8_MMA(1, 1, At, B1); PG8_BAR; PG8_SCHED;
            } else {
            PG8_LDB(B0, 0, 0); PG8_SCHED; PG8_LDA(At, 0, 0); PG8_STAGEA(PG8_SA(1, 1), a1 + hstep, voffA);
            PG8_WAIT_L(8); PG8_BAR; PG8_WAIT_L(0); PG8_MMA(0, 0, At, B0); PG8_BAR; PG8_SCHED;
            PG8_LDB(B1, 0, 1); PG8_STAGE(PG8_SB(0, 0), b2, voffB);
            PG8_BAR; PG8_WAIT_L(0); PG8_MMA(0, 1, At, B1); PG8_BAR;
            PG8_LDA(At, 0, 1); PG8_STAGEA(PG8_SA(0, 0), a2, voffA);
            PG8_BAR; PG8_WAIT_L(0); PG8_MMA(1, 0, At, B0); PG8_BAR; PG8_SCHED;
            PG8_STAGE(PG8_SB(0, 1), b2 + hstep, voffB);
            PG8_WAIT_V(6); PG8_BAR; PG8_MMA(1, 1, At, B1); PG8_BAR;
            PG8_LDB(B0, 1, 0); PG8_SCHED; PG8_LDA(At, 1, 0); PG8_STAGEA(PG8_SA(0, 1), a2 + hstep, voffA);
            PG8_WAIT_L(8); PG8_BAR; PG8_WAIT_L(0); PG8_MMA(0, 0, At, B0); PG8_BAR; PG8_SCHED;
            PG8_LDB(B1, 1, 1); PG8_STAGE(PG8_SB(1, 0), b3, voffB);
            PG8_BAR; PG8_WAIT_L(0); PG8_MMA(0, 1, At, B1); PG8_BAR;
            PG8_LDA(At, 1, 1); PG8_STAGEA(PG8_SA(1, 0), a3, voffA);
            PG8_BAR; PG8_WAIT_L(0); PG8_MMA(1, 0, At, B0); PG8_BAR; PG8_SCHED;
            PG8_STAGE(PG8_SB(1, 1), b3 + hstep, voffB);
            PG8_WAIT_V(6); PG8_BAR; PG8_MMA(1, 1, At, B1); PG8_BAR;
            }
        }
        if constexpr (ALIGN_EPI) { if (wr == 0) PG8_BAR; }
        if constexpr (!Epi::AFTER_DRAIN) { E(acc, cur, wr, wc, fr, fq); S.done(cur); }
        if (!has_next) break;
#pragma unroll
        for (int a = 0; a < 2; ++a)
#pragma unroll
            for (int b = 0; b < 2; ++b)
#pragma unroll
                for (int m = 0; m < 4; ++m)
#pragma unroll
                    for (int n = 0; n < 2; ++n) { typedef double d2v_ __attribute__((ext_vector_type(2))); double z0_, z1_;
                        asm volatile("v_mov_b64 %0, 0\n\tv_mov_b64 %1, 0" : "=v"(z0_), "=v"(z1_));
                        acc[a][b][m][n] = __builtin_bit_cast(f32x4, (d2v_){z0_, z1_}); }
        cur = nxt; cA = nA; cB = nB; ++ui;
        if constexpr (ALIGN_EPI) { if (wr == 1) PG8_BAR; }
    }
    PG8_WAIT_V(0);
    S.flush();
    if constexpr (!ALIGN_EPI) { if (wr == 0) PG8_BAR; }
    PG8_BAR;
    if constexpr (Epi::AFTER_DRAIN) { E.fused(acc, cur, wr, wc, fr, fq, lds, wid, lane); S.done(cur); }
#undef PG8_SA
#undef PG8_SB
#undef PG8_STAGE
#undef PG8_STAGEA
#undef PG8_LDA
#undef PG8_LDB
#undef PG8_MMA
#undef PG8_WAIT_V
#undef PG8_WAIT_L
#undef PG8_BAR
#undef PG8_SCHED
}
}
#define GAS __attribute__((address_space(1)))
#define LAS __attribute__((address_space(3)))
typedef unsigned short bf16;
typedef unsigned v4u __attribute__((ext_vector_type(4)));
typedef float f32x4 __attribute__((ext_vector_type(4)));
typedef short bf16x8 __attribute__((ext_vector_type(8)));
typedef GAS unsigned gu32;
typedef GAS unsigned long long gu64;
#define RLX_AGENT __ATOMIC_RELAXED, __HIP_MEMORY_SCOPE_AGENT
#define LDS_WAIT() asm volatile("s_waitcnt lgkmcnt(0)" ::: "memory")
#define VM_WAIT() asm volatile("s_waitcnt vmcnt(0)" ::: "memory")
__device__ __forceinline__ unsigned long long rt() { return __builtin_amdgcn_s_memrealtime(); }
typedef float f32x2_cv __attribute__((ext_vector_type(2))); typedef __bf16 bf16x2_cv __attribute__((ext_vector_type(2)));
__device__ __forceinline__ unsigned pk2(float lo, float hi) { f32x2_cv v = {lo, hi}; bf16x2_cv b = __builtin_convertvector(v, bf16x2_cv); return __builtin_bit_cast(unsigned, b); }
__device__ __forceinline__ unsigned f2bf(float f) { return pk2(f, 0.f) & 0xffffu; }

#define XB_TMO      128
#define XB_XCNT(j)  (256  + 64 * (j))
#define XB_XSUB(j)  (1280 + 64 * (j))
#define XB_XGEN(j)  (2304 + 64 * (j))
#define XB_TOP      3328
#define XB_TOPGEN   3392
#define XCD_BAR_WORDS 3456
#define XB_SPIN_CAP (1u << 18)

__device__ __forceinline__ unsigned xb_ld(unsigned* p)              { return __hip_atomic_load(p, __ATOMIC_RELAXED, __HIP_MEMORY_SCOPE_AGENT); }
__device__ __forceinline__ unsigned xb_add(unsigned* p, unsigned v) { return __hip_atomic_fetch_add(p, v, __ATOMIC_RELAXED, __HIP_MEMORY_SCOPE_AGENT); }
__device__ __forceinline__ unsigned xb_xcc_id() { return (unsigned)__builtin_amdgcn_s_getreg((3 << 11) | 20) & 0xFu; }
#define XB_SPIN(cond, bar) do { unsigned _sp = 0; while (cond) { __builtin_amdgcn_s_sleep(1); \
    if ((++_sp & 255u) == 0u) { if (xb_ld(&(bar)[XB_TMO])) break; if (_sp > XB_SPIN_CAP) { atomicAdd(&(bar)[XB_TMO], 1u); break; } } } } while (0)

struct XcdBarrier {
    unsigned* bar; unsigned x;
    volatile LAS unsigned* st;
};

__device__ __forceinline__ XcdBarrier xcd_barrier_post(unsigned* bar, volatile LAS unsigned* st) {
    XcdBarrier b; b.bar = bar; b.x = xb_xcc_id(); b.st = st;
    if (threadIdx.x == 0) (void)xb_add(&bar[XB_XCNT(b.x)], 1u);
    return b;
}
__device__ __forceinline__ void xcd_barrier_complete(unsigned* bar, unsigned x, unsigned& nloc, unsigned& nx) {
    const unsigned G = gridDim.x * gridDim.y * gridDim.z;
    unsigned sum, cnt, mine, sp = 0u;
    for (;;) {
        sum = 0u; cnt = 0u; mine = 0u;
#pragma unroll
        for (unsigned j = 0; j < 16; ++j) { const unsigned c = xb_ld(&bar[XB_XCNT(j)]); sum += c; cnt += (c > 0u) ? 1u : 0u; mine = (j == x) ? c : mine; }
        if (sum == G) break;
        __builtin_amdgcn_s_sleep(1);
        if ((++sp & 255u) == 0u) { if (xb_ld(&bar[XB_TMO])) break; if (sp > XB_SPIN_CAP) { atomicAdd(&bar[XB_TMO], 1u); break; } }
    }
    nloc = mine > 0u ? mine : 1u; nx = cnt > 0u ? cnt : 1u;
}

__device__ __forceinline__ void xcd_barrier(const XcdBarrier& b) {
    asm volatile("s_waitcnt vmcnt(0)" ::: "memory");
    __syncthreads();
    if (threadIdx.x == 0) {
        unsigned* bar = b.bar;
        __builtin_amdgcn_s_waitcnt(0);
        unsigned nloc = b.st[0], nx = b.st[1];
        if (nloc == 0u) { xcd_barrier_complete(bar, b.x, nloc, nx); b.st[0] = nloc; b.st[1] = nx; }
        const unsigned old = xb_add(&bar[XB_XSUB(b.x)], 1u);
        const unsigned gen = old / nloc;
        if (old + 1u == (gen + 1u) * nloc) {
            __builtin_amdgcn_fence(__ATOMIC_RELEASE, "agent");
            asm volatile("s_waitcnt vmcnt(0)" ::: "memory");
            const unsigned og = xb_add(&bar[XB_TOP], 1u);
            const unsigned tg = og / nx;
            if (og + 1u == (tg + 1u) * nx) xb_add(&bar[XB_TOPGEN], 1u);
            else XB_SPIN(xb_ld(&bar[XB_TOPGEN]) == tg, bar);
            __builtin_amdgcn_fence(__ATOMIC_ACQUIRE, "agent");
            xb_add(&bar[XB_XGEN(b.x)], 1u);
            asm volatile("s_waitcnt vmcnt(0)" ::: "memory");
        } else {
            XB_SPIN(xb_ld(&bar[XB_XGEN(b.x)]) == gen, bar);
            __builtin_amdgcn_fence(__ATOMIC_ACQUIRE, "agent");
            asm volatile("s_waitcnt vmcnt(0)" ::: "memory");
        }
    }
    __syncthreads();
}

__device__ __forceinline__ void xcd_barrier_local(const XcdBarrier& b) {
    asm volatile("s_waitcnt vmcnt(0)" ::: "memory");
    __syncthreads();
    if (threadIdx.x == 0) {
        unsigned* bar = b.bar;
        __builtin_amdgcn_s_waitcnt(0);
        const unsigned nloc = b.st[0];
        const unsigned old = xb_add(&bar[XB_XSUB(b.x)], 1u);
        const unsigned gen = old / nloc;
        if (old + 1u == (gen + 1u) * nloc) xb_add(&bar[XB_XGEN(b.x)], 1u);
        else XB_SPIN(xb_ld(&bar[XB_XGEN(b.x)]) == gen, bar);
        __builtin_amdgcn_fence(__ATOMIC_ACQUIRE, "agent");
        asm volatile("s_waitcnt vmcnt(0)" ::: "memory");
    }
    __syncthreads();
}

namespace pg8 {
constexpr int CH_STRIDE = 32;
__device__ __forceinline__ int ch_word(int stage, int pm) { return CH_STRIDE * (128 * stage + pm); }
__device__ __forceinline__ bool ch_lane0() { return __builtin_amdgcn_mbcnt_hi(~0u, __builtin_amdgcn_mbcnt_lo(~0u, 0u)) == 0u; }
__device__ __forceinline__ void ch_wait(unsigned* w, unsigned need, unsigned* tmo) {
    unsigned sp = 0;
    while ((unsigned)__builtin_amdgcn_readfirstlane(__hip_atomic_load(w, __ATOMIC_RELAXED, __HIP_MEMORY_SCOPE_AGENT)) < need) {
        __builtin_amdgcn_s_sleep(1);
        if ((++sp & 255u) == 0u) { if (__builtin_amdgcn_readfirstlane(__hip_atomic_load(tmo, __ATOMIC_RELAXED, __HIP_MEMORY_SCOPE_AGENT)) != 0u) break; if (sp > XB_SPIN_CAP) { if (ch_lane0()) atomicAdd(tmo, 1u); break; } }
    }
}
constexpr int CH_LDS_ARRIVE = 163840 - 256 + 48;
__device__ __forceinline__ void ch_arrive(unsigned* w, bool colo) {
    if (colo) { if (ch_lane0()) (void)__hip_atomic_fetch_add(w, 1u, __ATOMIC_RELAXED, __HIP_MEMORY_SCOPE_AGENT); }
    else {
        unsigned old = 0u;
        if (ch_lane0()) old = __hip_atomic_fetch_add((LAS unsigned*)CH_LDS_ARRIVE, 1u, __ATOMIC_RELAXED, __HIP_MEMORY_SCOPE_WORKGROUP);
        old = (unsigned)__builtin_amdgcn_readfirstlane(old);
        if ((old & 7u) == 7u) { __builtin_amdgcn_fence(__ATOMIC_RELEASE, "agent"); asm volatile("s_waitcnt vmcnt(0)" ::: "memory");
            if (ch_lane0()) (void)__hip_atomic_fetch_add(w, 8u, __ATOMIC_RELAXED, __HIP_MEMORY_SCOPE_AGENT); }
    }
}
__device__ __forceinline__ void ch_publish_now(unsigned* w, bool colo) {
    asm volatile("s_waitcnt vmcnt(0)" ::: "memory");
    ch_arrive(w, colo);
}
struct ChainHooks {
    static constexpr int A_AUX = 0;
    unsigned* chn; unsigned* tmo; bool colo; int wave;
    int wait_k0, wait_k1, pub_k0, pub_k1; unsigned need0, need1;
    mutable int pend, acq;
    __device__ __forceinline__ void hooks_init(unsigned* chn_, unsigned* tmo_, bool colo_, int wave_) { chn = chn_; tmo = tmo_; colo = colo_; wave = wave_; pend = -1; acq = -1; }
    __device__ __forceinline__ void a_ready(const Unit& u) const {
        const int k = u.ph ? wait_k1 : wait_k0; if (k < 0) return;
        const int w = ch_word(k, u.pm); if (w == acq) return;
        acq = w;
        if (wave == 0) {
            ch_wait(chn + w, u.ph ? need1 : need0, tmo);
            if (!colo) { __builtin_amdgcn_fence(__ATOMIC_ACQUIRE, "agent"); asm volatile("s_waitcnt vmcnt(0)" ::: "memory"); }
        }
        asm volatile("" ::: "memory"); __builtin_amdgcn_s_barrier(); asm volatile("" ::: "memory");
    }
    __device__ __forceinline__ void done(const Unit& u) const {
        const int k = u.ph ? pub_k1 : pub_k0; if (k < 0) return;
        const int w = ch_word(k, u.pm);
        if (colo) pend = w; else ch_publish_now(chn + w, false);
    }
    __device__ __forceinline__ void flush() const {
        if (pend >= 0) { if (ch_lane0()) (void)__hip_atomic_fetch_add(chn + pend, 1u, __ATOMIC_RELAXED, __HIP_MEMORY_SCOPE_AGENT); pend = -1; }
    }
};
template <class O0, class O1> struct StreamOrder : ChainHooks {
    O0 o0; O1 o1; int n0; const bf16_t* A1; const bf16_t* B1;
    __device__ __forceinline__ void count0() { n0 = 0; Unit t; while (o0.next(n0, t)) ++n0; }
    __device__ __forceinline__ bool next(int i, Unit& u) const { if (i < n0) { u.ph = 0; return o0.next(i, u); } u.ph = 1; return o1.next(i - n0, u); }
    __device__ __forceinline__ const char* pa(const Gemm& g, const Unit& u, size_t tstep) const { return (const char*)(u.ph ? A1 : g.A) + (size_t)u.pm * tstep; }
    __device__ __forceinline__ const char* pb(const Gemm& g, const Unit& u, size_t tstep) const { return (const char*)(u.ph ? B1 : g.Bt) + (size_t)u.pn * tstep; }
};
struct ChainOrder : ChainHooks {
    StaticOrder so;
    __device__ __forceinline__ bool next(int i, Unit& u) const { u.ph = 0; return so.next(i, u); }
    __device__ __forceinline__ const char* pa(const Gemm& g, const Unit& u, size_t tstep) const { return (const char*)g.A + (size_t)u.pm * tstep; }
    __device__ __forceinline__ const char* pb(const Gemm& g, const Unit& u, size_t tstep) const { return (const char*)g.Bt + (size_t)u.pn * tstep; }
};
template <int N> __device__ __forceinline__ void ch_wait_n(unsigned* w0, int stride, unsigned need, unsigned* tmo, bool colo) {
    unsigned v[N];
#pragma unroll
    for (int k = 0; k < N; ++k) v[k] = __hip_atomic_load(w0 + stride * k, __ATOMIC_RELAXED, __HIP_MEMORY_SCOPE_AGENT);
    bool ok = true;
#pragma unroll
    for (int k = 0; k < N; ++k) ok = ok && ((unsigned)__builtin_amdgcn_readfirstlane(v[k]) >= need);
    if (!ok) {
#pragma unroll 1
        for (int k = 0; k < N; ++k) ch_wait(w0 + stride * k, need, tmo); }
    if (!colo) { __builtin_amdgcn_fence(__ATOMIC_ACQUIRE, "agent"); asm volatile("s_waitcnt vmcnt(0)" ::: "memory"); }
}
struct Order2C : ChainHooks {
    Order2 o;
    __device__ __forceinline__ bool next(int i, Unit& u) const { u.ph = 0; return o.next(i, u); }
    __device__ __forceinline__ const char* pa(const Gemm& g, const Unit& u, size_t tstep) const { return (const char*)g.A + (size_t)u.pm * tstep; }
    __device__ __forceinline__ const char* pb(const Gemm& g, const Unit& u, size_t tstep) const { return (const char*)g.Bt + (size_t)u.pn * tstep; }
};
template <class E0, class E1> struct EpiPair {
    static constexpr bool PERM = E0::PERM, AFTER_DRAIN = false;
    static_assert(E0::PERM == E1::PERM && !E0::AFTER_DRAIN && !E1::AFTER_DRAIN, "EpiPair");
    E0 e0; E1 e1;
    __device__ __forceinline__ void prefetch(const Unit& u, PG8_LAS unsigned char* l, int wid, int lane) const { if (u.ph == 0) e0.prefetch(u, l, wid, lane); else e1.prefetch(u, l, wid, lane); }
    __device__ __forceinline__ void operator()(const f32x4 (&acc)[2][2][4][2], const Unit& u, int wr, int wc, int fr, int fq) const {
        if (u.ph == 0) e0(acc, u, wr, wc, fr, fq); else e1(acc, u, wr, wc, fr, fq);
    }
};
}

namespace pg8 {
struct EpiResNorm {
    static constexpr bool PERM = true, AFTER_DRAIN = false;
    __device__ __forceinline__ void prefetch(const Unit&, PG8_LAS unsigned char*, int, int) const {}
    const bf16_t* base; float* out; float* ssq; const float* gain; float eps;
    unsigned* chn; unsigned* tmo; bool colo, ychk;
    __device__ __forceinline__ void operator()(const f32x4 (&acc)[2][2][4][2], const Unit& u, int wr, int wc, int fr, int fq) const {
        const int row0 = u.pm * BM + wr * 64 + fr, col0 = u.pn * BM + wc * 32 + 8 * fq;
        u32x4 bb[2][4][2];
#pragma unroll
        for (int ai = 0; ai < 2; ++ai)
#pragma unroll
            for (int m = 0; m < 4; ++m) { const int row = row0 + ai * HALF + m * 16;
#pragma unroll
                for (int bj = 0; bj < 2; ++bj) bb[ai][m][bj] = *(const u32x4*)(base + (size_t)row * 1024 + col0 + bj * HALF); }
        __builtin_amdgcn_sched_barrier(0);
        f32x4 v[2][4][2][2];
#pragma unroll
        for (int ai = 0; ai < 2; ++ai)
#pragma unroll
            for (int m = 0; m < 4; ++m) { const int row = row0 + ai * HALF + m * 16; float ss = 0.f;
#pragma unroll
                for (int bj = 0; bj < 2; ++bj) { const u32x4 b4 = bb[ai][m][bj];
                    const f32x4 b0 = (f32x4){__builtin_bit_cast(float, b4.x << 16), __builtin_bit_cast(float, b4.x & 0xffff0000u), __builtin_bit_cast(float, b4.y << 16), __builtin_bit_cast(float, b4.y & 0xffff0000u)};
                    const f32x4 b1 = (f32x4){__builtin_bit_cast(float, b4.z << 16), __builtin_bit_cast(float, b4.z & 0xffff0000u), __builtin_bit_cast(float, b4.w << 16), __builtin_bit_cast(float, b4.w & 0xffff0000u)};
                    const f32x4 v0 = acc[ai][bj][m][0] + b0, v1 = acc[ai][bj][m][1] + b1;
                    ss += (v0[0] * v0[0] + v0[1] * v0[1]) + (v0[2] * v0[2] + v0[3] * v0[3]) + (v1[0] * v1[0] + v1[1] * v1[1]) + (v1[2] * v1[2] + v1[3] * v1[3]);
                    v[ai][m][bj][0] = v0; v[ai][m][bj][1] = v1; }
                ss += __shfl_xor(ss, 16); ss += __shfl_xor(ss, 32);
                if (fq == 0) ssq[(size_t)row * 16 + u.pn * 4 + wc] = ss; }
        unsigned* w = chn + ch_word(4, u.pm);
        ch_publish_now(w, colo);
        ch_wait(w, 32u, tmo);
        if (ychk && u.pm < 64) ch_wait(chn + ch_word(5, u.pm >> 3), 32u, tmo);
        if (u.pm >= 64) { ch_wait(chn + ch_word(2, 2 * (u.pm - 64)), 32u, tmo); ch_wait(chn + ch_word(2, 2 * (u.pm - 64) + 1), 32u, tmo); }
        if (!colo) { __builtin_amdgcn_fence(__ATOMIC_ACQUIRE, "agent"); asm volatile("s_waitcnt vmcnt(0)" ::: "memory"); }
        float rs8[2][4]; rows_rstd(ssq, row0, fq, eps, rs8);
        f32x4 gv[2][2];
#pragma unroll
        for (int bj = 0; bj < 2; ++bj) { gv[bj][0] = *(const f32x4*)(gain + col0 + bj * HALF); gv[bj][1] = *(const f32x4*)(gain + col0 + bj * HALF + 4); }
#pragma unroll
        for (int ai = 0; ai < 2; ++ai)
#pragma unroll
            for (int m = 0; m < 4; ++m) { const int row = row0 + ai * HALF + m * 16; float* o = out + (size_t)row * 1024 + col0; const float rs = rs8[ai][m];
#pragma unroll
                for (int bj = 0; bj < 2; ++bj) { *(f32x4*)(o + bj * HALF) = v[ai][m][bj][0] * rs * gv[bj][0]; *(f32x4*)(o + bj * HALF + 4) = v[ai][m][bj][1] * rs * gv[bj][1]; } }
    }
};
}

__device__ __forceinline__ void wsplit_arrive(const XcdBarrier& b, unsigned* wb) {
    asm volatile("s_waitcnt vmcnt(0)" ::: "memory");
    __syncthreads();
    if (threadIdx.x == 0) {
        const unsigned nloc = b.st[0];
        const unsigned old = xb_add(&wb[64 * b.x], 1u);
        if (old + 1u == nloc) { __builtin_amdgcn_fence(__ATOMIC_RELEASE, "agent"); asm volatile("s_waitcnt vmcnt(0)" ::: "memory"); xb_add(&wb[64 * 16], 1u); }
    }
}
__device__ __forceinline__ void wsplit_wait(const XcdBarrier& b, unsigned* wb) {
    if (threadIdx.x == 0) {
        const unsigned nx = b.st[1];
        XB_SPIN(xb_ld(&wb[64 * 16]) < nx, b.bar);
        __builtin_amdgcn_fence(__ATOMIC_ACQUIRE, "agent"); asm volatile("s_waitcnt vmcnt(0)" ::: "memory");
    }
    __syncthreads();
}

typedef float f32x2 __attribute__((ext_vector_type(2)));
typedef unsigned u32x2v __attribute__((ext_vector_type(2)));
constexpr int NWAVES = 8;
constexpr int BATCH = 16, SEQ = 2048, DM = 1024, M = BATCH * SEQ;
constexpr int MEMT = 256, MM = BATCH * MEMT;
constexpr int DIN = 3848, NZM = 2048, NZR = 1792, NZ = NZM + NZR;
constexpr int DFF = 2816;
constexpr float EPS = 1e-6f, RWKV_LN_EPS = 64e-5f;
constexpr float LOG2E = 1.4426950408889634f;

constexpr size_t MiB = 1u << 20;
constexpr size_t WS_CTL = 0, CTL_ZERO_BYTES = 320 * 1024;
constexpr size_t WS_ZG = 1 * MiB;
constexpr size_t WS_SSQ1 = 2 * MiB, WS_SSQ2 = 4 * MiB, WS_SSQ3 = 6 * MiB;
constexpr size_t WS_RMS = 43 * MiB + 512 * 1024;
constexpr size_t WS_WIN = 8 * MiB;
constexpr size_t WS_WKV = WS_WIN + (size_t)NZ * DM * 2;
constexpr size_t WS_WMIX = 20 * MiB, WS_WQ = 22 * MiB, WS_WO = 24 * MiB, WS_WGU = 26 * MiB  , WS_WD = 37 * MiB  ;
constexpr size_t WS_LORA = 43 * MiB;
constexpr size_t WS_KV = 44 * MiB;
constexpr size_t WS_XN = 60 * MiB;
constexpr size_t WS_MN = WS_XN + (size_t)M * DM * 2;
constexpr size_t WS_ZM = 132 * MiB;
constexpr size_t WS_ZR = 260 * MiB;
constexpr size_t WS_H1B = WS_XN;
constexpr size_t OUT_QO = 64 * MiB;
constexpr size_t WS_OB = WS_ZR + 64 * MiB;
constexpr size_t WS_H2B = WS_XN;
constexpr size_t WS_H3B = WS_XN;
constexpr size_t WS_ACT = WS_ZR + 64 * MiB;
constexpr size_t WS_E = 372 * MiB, WS_AL = 436 * MiB, WS_GG = 468 * MiB;
constexpr size_t WS_END = 500 * MiB;
static_assert(WS_WKV + (size_t)2048 * DM * 2 <= WS_WMIX && WS_WD + (size_t)DM * DFF * 2 <= WS_LORA && WS_MN + (size_t)MM * DM * 2 <= WS_ZM && WS_ZR + (size_t)M * NZR * 2 <= WS_END && WS_ACT + (size_t)M * DFF * 2 <= WS_END, "d_ws map");
constexpr int CW_BAR = 1024;
constexpr int CW_CHN = 16384;
constexpr int CW_WSP = 9216;
constexpr int CW_GRP = 8192;

constexpr int LDS_BYTES = 163840;
constexpr int MISC_OFF = LDS_BYTES - 256; static_assert(pg8::CH_LDS_ARRIVE == LDS_BYTES - 256 + 48, "p3_chain's LDS arrival word is MISC[12]");
constexpr int MISC_OFF_ = MISC_OFF;

__device__ __forceinline__ float bf2f(unsigned short h) { return __builtin_bit_cast(float, (unsigned)h << 16); }
__device__ __forceinline__ float bflo(unsigned w) { return __builtin_bit_cast(float, w << 16); }
__device__ __forceinline__ float bfhi(unsigned w) { return __builtin_bit_cast(float, w & 0xffff0000u); }
__device__ __forceinline__ float sigmoidf_(float x) { return __builtin_amdgcn_rcpf(1.0f + __builtin_amdgcn_exp2f(-LOG2E * x)); }
__device__ __forceinline__ float expf_(float x) { return __builtin_amdgcn_exp2f(LOG2E * x); }
__device__ __forceinline__ float wave_sum(float v) {
#pragma unroll
    for (int o = 1; o < 64; o <<= 1) v += __shfl_xor(v, o);
    return v;
}
template <int CTRL> __device__ __forceinline__ float dpp_f(float v) { return __builtin_bit_cast(float, __builtin_amdgcn_update_dpp(0, __builtin_bit_cast(int, v), CTRL, 0xF, 0xF, false)); }
__device__ __forceinline__ float row16_sum(float v) { v += dpp_f<0xB1>(v); v += dpp_f<0x4E>(v); v += dpp_f<0x141>(v); v += dpp_f<0x140>(v); return v; }
__device__ __forceinline__ float row8_sum(float v) { v += dpp_f<0xB1>(v); v += dpp_f<0x4E>(v); v += dpp_f<0x141>(v); return v; }

struct InPtrs {
    const float* const __attribute__((address_space(4)))* p;
    __device__ __forceinline__ const float* operator[](int i) const { const float* const __attribute__((address_space(4)))* q = p; asm volatile("" : "+s"(q)); return q[i]; }
};
struct Frame {
    LAS unsigned char* lds;
    int tid, lane, wave, vcu, G; bool colo;
    InPtrs in; float* out; unsigned char* ws;
};

__device__ __forceinline__ void transpose_item(const float* W, int ldw, int src_col0, bf16* WT, int K, int dst_row0, const float* kscale, int k0, LAS float* scr, int lane) {
    float v[32], sc[32];
    const float* wp = W + (size_t)(k0 + (lane >> 5)) * ldw + src_col0 + (lane & 31);
#pragma unroll
    for (int i = 0; i < 32; ++i) v[i] = wp[(size_t)(2 * i) * ldw];
    if (kscale) {
#pragma unroll
        for (int i = 0; i < 32; ++i) sc[i] = kscale[k0 + 2 * i + (lane >> 5)];
#pragma unroll
        for (int i = 0; i < 32; ++i) v[i] *= sc[i]; }
#pragma unroll
    for (int i = 0; i < 32; ++i) scr[(2 * i + (lane >> 5)) * 33 + (lane & 31)] = v[i];
    LDS_WAIT(); asm volatile("" ::: "memory");
    const int c = lane & 7;
#pragma unroll
    for (int j = 0; j < 4; ++j) { const int n = (lane >> 3) + 8 * j; const LAS float* s = scr + (8 * c) * 33 + n;
        v4u o; o.x = pk2(s[0 * 33], s[1 * 33]); o.y = pk2(s[2 * 33], s[3 * 33]); o.z = pk2(s[4 * 33], s[5 * 33]); o.w = pk2(s[6 * 33], s[7 * 33]);
        *(GAS v4u*)(WT + (size_t)(dst_row0 + n) * K + k0 + 8 * c) = o; }
    LDS_WAIT(); asm volatile("" ::: "memory");
}

constexpr int I_WIN = 120 * 16, I_WKV = 64 * 16, I_L64 = 16, I_L128 = 32, I_SQ = 32 * 16, I_WGU = 176 * 16, I_WD = 32 * 44;
constexpr int W_EARLY = I_WIN + I_WKV + 2 * I_L64 + I_L128, W_ALL = W_EARLY + 3 * I_SQ + I_WGU + I_WD;
__device__ __forceinline__ void weight_item(Frame& F, int it, LAS float* scr) {
    unsigned char* ws = F.ws; int r = it;
    if (r < I_WIN) { const int seg = r >> 4, kb = r & 15, n0 = seg * 32; transpose_item(F.in[3], DIN, n0 < 2048 ? n0 : n0 + 8, (bf16*)(ws + WS_WIN), 1024, n0, F.in[2], kb * 64, scr, F.lane); return; } r -= I_WIN;
    if (r < I_WKV) { const int seg = r >> 4, kb = r & 15; transpose_item(F.in[23], 2048, seg * 32, (bf16*)(ws + WS_WKV), 1024, seg * 32, F.in[21], kb * 64, scr, F.lane); return; } r -= I_WKV;
    if (r < I_L64) { transpose_item(F.in[10], 512, r * 32, (bf16*)(ws + WS_LORA), 64, r * 32, nullptr, 0, scr, F.lane); return; } r -= I_L64;
    if (r < I_L64) { transpose_item(F.in[12], 512, r * 32, (bf16*)(ws + WS_LORA) + 512 * 64, 64, r * 32, nullptr, 0, scr, F.lane); return; } r -= I_L64;
    if (r < I_L128) { const int seg = r >> 1, kb = r & 1; transpose_item(F.in[13], 512, seg * 32, (bf16*)(ws + WS_LORA) + 2 * 512 * 64, 128, seg * 32, nullptr, kb * 64, scr, F.lane); return; } r -= I_L128;
    if (r < I_SQ) { const int seg = r >> 4, kb = r & 15; transpose_item(F.in[19], 1024, seg * 32, (bf16*)(ws + WS_WMIX), 1024, seg * 32, nullptr, kb * 64, scr, F.lane); return; } r -= I_SQ;
    if (r < I_SQ) { const int seg = r >> 4, kb = r & 15; transpose_item(F.in[22], 1024, seg * 32, (bf16*)(ws + WS_WQ), 1024, seg * 32, F.in[20], kb * 64, scr, F.lane); return; } r -= I_SQ;
    if (r < I_SQ) { const int seg = r >> 4, kb = r & 15; transpose_item(F.in[24], 1024, seg * 32, (bf16*)(ws + WS_WO), 1024, seg * 32, nullptr, kb * 64, scr, F.lane); return; } r -= I_SQ;
    if (r < I_WGU) { const int seg = r >> 4, kb = r & 15, r0 = seg * 32, blk = r0 >> 8, within = r0 & 255;
        transpose_item(within < 128 ? F.in[26] : F.in[27], DFF, blk * 128 + (within & 127), (bf16*)(ws + WS_WGU), 1024, r0, F.in[25], kb * 64, scr, F.lane); return; } r -= I_WGU;
    { const int seg = r / 44, kb = r % 44; transpose_item(F.in[28], 1024, seg * 32, (bf16*)(ws + WS_WD), DFF, seg * 32, nullptr, kb * 64, scr, F.lane); }
}
__device__ __forceinline__ void late_weights(Frame& F, int wg, int nwg) {
    LAS float* scr = (LAS float*)(F.lds + F.wave * 8704);
    for (int it = W_EARLY + wg * NWAVES + F.wave; it < W_ALL; it += nwg * NWAVES) weight_item(F, it, scr);
}
__device__ __forceinline__ void p0_row(Frame& F, LAS float* GW, unsigned char* ws, int m, bool is_x, f32x4 (&v)[4], float s) {
        const float rms = sqrtf(wave_sum(s) * (1.f / DM) + EPS), rstd = 1.f / rms;
        if (is_x && F.lane == 0) ((float*)(ws + WS_RMS))[m] = rms;
#pragma unroll
        for (int j = 0; j < 4; ++j) v[j] = v[j] * rstd;
        GAS unsigned long long* o8 = (GAS unsigned long long*)((bf16*)(ws + WS_XN) + (size_t)m * DM) + F.lane;
#pragma unroll
        for (int j = 0; j < 4; ++j) o8[64 * j] = (unsigned long long)pk2(v[j].x, v[j].y) | ((unsigned long long)pk2(v[j].z, v[j].w) << 32);
        if (is_x) {
            float g8[8];
#pragma unroll
            for (int q = 0; q < 8; ++q) { float a = 0.f;
#pragma unroll
                for (int j = 0; j < 4; ++j) { const f32x4 w = *(const LAS f32x4*)(GW + q * 1024 + 256 * j + 4 * F.lane); a += (v[j].x * w.x + v[j].y * w.y) + (v[j].z * w.z + v[j].w * w.w); }
                g8[q] = a; }
#pragma unroll
            for (int q = 0; q < 4; ++q) { const bool up = F.lane & 32; const float keep = up ? g8[q + 4] : g8[q], send = up ? g8[q] : g8[q + 4]; g8[q] = keep + __shfl_xor(send, 32); }
#pragma unroll
            for (int q = 0; q < 2; ++q) { const bool up = F.lane & 16; const float keep = up ? g8[q + 2] : g8[q], send = up ? g8[q] : g8[q + 2]; g8[q] = keep + __shfl_xor(send, 16); }
            { const bool up = F.lane & 8; const float keep = up ? g8[1] : g8[0], send = up ? g8[0] : g8[1]; g8[0] = keep + __shfl_xor(send, 8); }
            g8[0] = row8_sum(g8[0]);
            if ((F.lane & 7) == 0) { const int q = ((F.lane >> 5) & 1) * 4 + ((F.lane >> 4) & 1) * 2 + ((F.lane >> 3) & 1); ((float*)(ws + WS_ZG))[(size_t)m * 8 + q] = g8[0]; }
        }
}
__device__ __forceinline__ void p0_prologue(Frame& F) {
    LAS float* scr = (LAS float*)(F.lds + F.wave * 8704);
    LAS float* GW = (LAS float*)(F.lds + 98304);
    const float* w_in = F.in[3]; const float* g_in = F.in[2]; const float* x_in = F.in[0]; const float* m_in = F.in[1];
    { float wv[16], gvv[16];
#pragma unroll
      for (int i = 0; i < 16; ++i) { const int idx = F.tid + i * NWAVES * 64, q = idx >> 10, k = idx & 1023; wv[i] = w_in[(size_t)k * DIN + 2048 + q]; gvv[i] = g_in[k]; }
      __builtin_amdgcn_sched_barrier(0);
#pragma unroll
      for (int i = 0; i < 16; ++i) GW[F.tid + i * NWAVES * 64] = gvv[i] * wv[i]; }
    __syncthreads();
    const int gw = F.vcu * NWAVES + F.wave, NGW = F.G * NWAVES;
    unsigned char* ws = F.ws;
    for (int it = gw; it < W_EARLY; it += NGW) weight_item(F, it, scr);
#define P0_LOAD(dst, mm) do { const int mm_ = (mm); if (mm_ < M + MM) { const float* xrow_ = mm_ < M ? x_in + (size_t)mm_ * DM : m_in + (size_t)(mm_ - M) * DM; const GAS f32x4* xr_ = (const GAS f32x4*)xrow_ + F.lane; \
        _Pragma("unroll") for (int j_ = 0; j_ < 4; ++j_) dst[j_] = xr_[64 * j_]; } } while (0)
    f32x4 ra[4], rb[4], rc[4];
    P0_LOAD(ra, gw); P0_LOAD(rb, gw + NGW); P0_LOAD(rc, gw + 2 * NGW);
#define P0_ROW(buf, mm) do { const int m = (mm); if (m < M + MM) { const bool is_x = m < M; \
        f32x4 v[4]; float s = 0.f; \
        _Pragma("unroll") for (int j = 0; j < 4; ++j) { v[j] = buf[j]; s += (v[j].x * v[j].x + v[j].y * v[j].y) + (v[j].z * v[j].z + v[j].w * v[j].w); } \
        P0_LOAD(buf, m + 3 * NGW); \
        p0_row(F, GW, ws, m, is_x, v, s); } } while (0)
    for (int m0 = gw; m0 < M + MM; m0 += 3 * NGW) { P0_ROW(ra, m0); P0_ROW(rb, m0 + NGW); P0_ROW(rc, m0 + 2 * NGW); }
#undef P0_ROW
#undef P0_LOAD
}

__device__ __forceinline__ void final_norm(Frame& F) {
    const bool blk = (F.G == 256);
    const int gw = blk ? F.vcu * 128 + F.wave : F.vcu * NWAVES + F.wave, NGW = blk ? NWAVES : F.G * NWAVES, MEND = blk ? F.vcu * 128 + 128 : M;
    const float* ssq = (const float*)(F.ws + WS_SSQ3); const float* g = F.in[29];
    const bf16* h3 = (const bf16*)(F.ws + WS_H3B);
    f32x4 gv[4];
#pragma unroll
    for (int j = 0; j < 4; ++j) gv[j] = *(const f32x4*)(g + 4 * F.lane + 256 * j);
    float rs_l = 0.f;
    { const int mk = gw + F.lane * NGW; if (mk < MEND) rs_l = pg8::row_rstd16(ssq, mk, EPS); }
    u32x2v nx[4];
    if (gw < MEND) {
#pragma unroll
        for (int j = 0; j < 4; ++j) nx[j] = *(const u32x2v*)(h3 + (size_t)gw * DM + 4 * F.lane + 256 * j); }
    int k = 0;
    for (int m = gw; m < MEND; m += NGW, ++k) {
        u32x2v c[4];
#pragma unroll
        for (int j = 0; j < 4; ++j) c[j] = nx[j];
        const int mn = m + NGW;
        if (mn < MEND) {
#pragma unroll
            for (int j = 0; j < 4; ++j) nx[j] = *(const u32x2v*)(h3 + (size_t)mn * DM + 4 * F.lane + 256 * j); }
        const float rs = (k < 64) ? __shfl(rs_l, k) : pg8::row_rstd16(ssq, m, EPS);
        float* o = F.out + (size_t)m * DM + 4 * F.lane;
#pragma unroll
        for (int j = 0; j < 4; ++j) *(f32x4*)(o + 256 * j) = (f32x4){bflo(c[j].x), bfhi(c[j].x), bflo(c[j].y), bfhi(c[j].y)} * rs * gv[j];
    }
}

typedef short v4i16_t __attribute__((ext_vector_type(4)));
typedef short s16x4 __attribute__((ext_vector_type(4)));
__device__ __forceinline__ s16x4 lds_tr16(const LAS unsigned char* p) { return __builtin_bit_cast(s16x4, __builtin_amdgcn_ds_read_tr16_b64_v4i16((LAS v4i16_t*)p)); }
__device__ __forceinline__ bf16x8 cat8(s16x4 lo, s16x4 hi) { return (bf16x8){lo[0], lo[1], lo[2], lo[3], hi[0], hi[1], hi[2], hi[3]}; }

constexpr int ML_ROWB = 272;
constexpr int ML_Q = 0, ML_K = 34816, ML_V = 69632, ML_C = 104448, ML_F = 139264;
template <bool OUTP> __device__ __forceinline__ void mlstm_chunk(Frame& F, int b, int h, int c, f32x4 (&Cacc)[8], float& m_prev, const float ib, const float fb, const float* normw) {
    LAS unsigned char* L = F.lds;
    LAS unsigned char *Qs = L + ML_Q, *Ks = L + ML_K, *Vs = L + ML_V, *Cs = L + ML_C;
    LAS float* fl = (LAS float*)(L + ML_F);
    LAS float *dS = fl, *Mrow = fl + 128, *sint = fl + 256, *eden = fl + 384, *wgt = fl + 512, *nvec = fl + 640, *npart = fl + 768, *scal = fl + 1280, *tmp = fl + 1296;
    LAS float* cwL = fl + 1552;
    const int tid = F.tid, lane0 = F.lane, w = F.wave;
    const bf16* zm = (const bf16*)(F.ws + WS_ZM);
    const float* zg = (const float*)(F.ws + WS_ZG);
    bf16* Y = (bf16*)F.out;
    unsigned craw[35]; float graw[2] = {0.f, 0.f};
#define ML_ISSUE(cn) do { const int m0_ = b * SEQ + (cn) * 128; const int ts0_ = (cn) * 128 + 32 * tq; const char* zb_ = (const char*)(zm + (size_t)m0_ * NZM); \
        if (isk || outp) { craw[0] = (ts0_ >= 3) ? *(const unsigned*)(zb_ - 3 * NZM * 2 + cvoff) : 0u; craw[1] = (ts0_ >= 2) ? *(const unsigned*)(zb_ - 2 * NZM * 2 + cvoff) : 0u; craw[2] = (ts0_ >= 1) ? *(const unsigned*)(zb_ - 1 * NZM * 2 + cvoff) : 0u; \
        _Pragma("unroll") for (int i_ = 0; i_ < 32; ++i_) craw[3 + i_] = *(const unsigned*)(zb_ + (size_t)i_ * NZM * 2 + cvoff); } \
        if (tidv < 128) { const float* zr_ = zg + (size_t)(m0_ + tidv) * 8; graw[0] = zr_[h]; graw[1] = zr_[4 + h]; } } while (0)
        const int m0 = b * SEQ + c * 128; constexpr bool outp = OUTP;
        int lane = lane0, tidv = tid; asm volatile("" : "+v"(lane), "+v"(tidv));
        const int fr = lane & 15, G = lane >> 4;
        const int cp = tidv & 127, tq = tidv >> 7; const bool isk = cp >= 64; const int e2 = 2 * (cp & 63); const float kscale = isk ? 0.08838834764831845f : 1.0f;
        const unsigned cvoff = (unsigned)((32 * (tidv >> 7)) * NZM + (((tidv & 127) >= 64) ? 512 : 0) + 128 * h + 2 * (tidv & 63)) * 2u;
        ML_ISSUE(c);
        v4u vraw[4];
#pragma unroll
        for (int i = 0; i < 4; ++i) vraw[i] = *(const v4u*)((const char*)(zm + (size_t)(m0 + 32 * i) * NZM + 1024 + 128 * h) + (unsigned)((tidv >> 4) * NZM + 8 * (tidv & 15)) * 2u);
        float lf = 0.f, igv = 0.f;
        if (tidv < 128) { igv = graw[0] + ib; const float fv = graw[1] + fb; lf = fminf(fv, 0.f) - log1pf(__expf(-fabsf(fv))); }
        float bc = lf;
#pragma unroll
        for (int o = 1; o < 64; o <<= 1) { const float t = __shfl_up(bc, o); if (lane >= o) bc += t; }
        if (w == 0 && lane == 63) tmp[0] = bc;
        __syncthreads();
        if (w == 1) bc += tmp[0];
        const float dl = igv - bc;
        float pm = dl;
#pragma unroll
        for (int o = 1; o < 64; o <<= 1) { const float t = __shfl_up(pm, o); if (lane >= o) pm = fmaxf(pm, t); }
        if (w == 0 && lane == 63) tmp[1] = pm;
        __syncthreads();
        if (w == 1) pm = fmaxf(pm, tmp[1]);
        if (tidv == 127) { scal[0] = bc; scal[3] = pm; }
        __syncthreads();
        const float g = scal[0], m_loc = g + scal[3], m_new = fmaxf(g + m_prev, m_loc), s_old = __expf(g + m_prev - m_new);
        if (tidv < 128) { const float Ml = fmaxf(m_prev, pm); dS[tidv] = dl; Mrow[tidv] = Ml; sint[tidv] = __expf(m_prev - Ml); eden[tidv] = __expf(-bc - Ml); wgt[tidv] = __expf(g + dl - m_new); }
        {
            const int tl0 = 32 * tq;
            float cw[4][2];
            { const f32x4 c0 = *(const LAS f32x4*)(cwL + cp * 8), c1 = *(const LAS f32x4*)(cwL + cp * 8 + 4); cw[0][0] = c0[0]; cw[0][1] = c0[1]; cw[1][0] = c0[2]; cw[1][1] = c0[3]; cw[2][0] = c1[0]; cw[2][1] = c1[1]; cw[3][0] = c1[2]; cw[3][1] = c1[3]; }
            LAS unsigned char* dst = (isk ? Ks : Qs) + tl0 * ML_ROWB + e2 * 2;
            if (isk || outp)
#pragma unroll
            for (int i = 0; i < 32; ++i) {
                typedef float f2 __attribute__((ext_vector_type(2)));
                const f2 xa = {bflo(craw[i]), bfhi(craw[i])}, xb = {bflo(craw[i + 1]), bfhi(craw[i + 1])}, xc = {bflo(craw[i + 2]), bfhi(craw[i + 2])}, xd = {bflo(craw[i + 3]), bfhi(craw[i + 3])};
                const f2 w0 = {cw[0][0], cw[0][1]}, w1 = {cw[1][0], cw[1][1]}, w2 = {cw[2][0], cw[2][1]}, w3 = {cw[3][0], cw[3][1]};
                const f2 a = w0 * xa + (w1 * xb + (w2 * xc + w3 * xd));
                const f2 t = a * (f2){-LOG2E, -LOG2E}; f2 e; e.x = __builtin_amdgcn_exp2f(t.x); e.y = __builtin_amdgcn_exp2f(t.y);
                const f2 d = e + (f2){1.0f, 1.0f}; f2 r; r.x = __builtin_amdgcn_rcpf(d.x); r.y = __builtin_amdgcn_rcpf(d.y);
                const f2 o2 = (a * (f2){kscale, kscale}) * r;
                *(LAS unsigned*)(dst + i * ML_ROWB) = pk2(o2.x, o2.y);
            }
#pragma unroll
            for (int i = 0; i < 4; ++i) { const int p = tidv + 512 * i, row = p >> 4, ch = p & 15; *(LAS v4u*)(Vs + row * ML_ROWB + ch * 16) = vraw[i]; }
        }
        if (outp)
#pragma unroll
        for (int et = 0; et < 8; ++et)
#pragma unroll
            for (int r = 0; r < 4; ++r) *(LAS unsigned short*)(Cs + (16 * w + 4 * G + r) * ML_ROWB + (16 * et + fr) * 2) = (unsigned short)f2bf(Cacc[et][r]);
        __syncthreads();
        if (outp) {
            int lrow = 16 * w + fr; asm volatile("" : "+v"(lrow));
            bf16x8 qf[4];
#pragma unroll
            for (int ks = 0; ks < 4; ++ks) qf[ks] = *(const LAS bf16x8*)(Qs + lrow * ML_ROWB + (32 * ks + 8 * G) * 2);
            float nq = 0.f;
#pragma unroll
            for (int ks = 0; ks < 4; ++ks)
#pragma unroll
                for (int j = 0; j < 8; ++j) nq += bf2f((unsigned short)qf[ks][j]) * nvec[32 * ks + 8 * G + j];
            nq += __shfl_xor(nq, 16); nq += __shfl_xor(nq, 32);
            const float Ml = Mrow[lrow], si = sint[lrow], ed = eden[lrow];
            f32x4 acc[8];
#pragma unroll
            for (int dt = 0; dt < 8; ++dt) { acc[dt] = (f32x4){0.f, 0.f, 0.f, 0.f};
#pragma unroll
                for (int ks = 0; ks < 4; ++ks) { const bf16x8 a = *(const LAS bf16x8*)(Cs + (16 * dt + fr) * ML_ROWB + (32 * ks + 8 * G) * 2); acc[dt] = __builtin_amdgcn_mfma_f32_16x16x32_bf16(a, qf[ks], acc[dt], 0, 0, 0); }
                acc[dt] = acc[dt] * si; __builtin_amdgcn_sched_barrier(0); }
            float den = 0.f;
#pragma unroll
            for (int kp = 0; kp < 4; ++kp) {
                if (2 * kp <= w) {
                    s16x4 vlo[8], vhi[8];
                    { const LAS unsigned char* vb = Vs + (32 * kp + 4 * G + ((lane >> 2) & 3)) * ML_ROWB + (4 * (lane & 3)) * 2;
#pragma unroll
                      for (int dt = 0; dt < 8; ++dt) { vlo[dt] = lds_tr16(vb + dt * 32); vhi[dt] = lds_tr16(vb + 16 * ML_ROWB + dt * 32); } }
                    __builtin_amdgcn_sched_barrier(0);
                    float pv[8];
#pragma unroll
                    for (int hh = 0; hh < 2; ++hh) { const int st = 2 * kp + hh;
                        f32x4 s4 = (f32x4){0.f, 0.f, 0.f, 0.f};
                        if (st <= w) {
#pragma unroll
                            for (int ks = 0; ks < 4; ++ks) { const bf16x8 a = *(const LAS bf16x8*)(Ks + (16 * st + fr) * ML_ROWB + (32 * ks + 8 * G) * 2); s4 = __builtin_amdgcn_mfma_f32_16x16x32_bf16(a, qf[ks], s4, 0, 0, 0); }
                        }
                        const f32x4 d4 = *(const LAS f32x4*)(dS + 16 * st + 4 * G);
#pragma unroll
                        for (int r = 0; r < 4; ++r) { const int s = 16 * st + 4 * G + r; const float p = (s <= lrow) ? s4[r] * __expf(d4[r] - Ml) : 0.f; den += p; pv[hh * 4 + r] = p; } }
                    bf16x8 pf; { const unsigned a0 = pk2(pv[0], pv[1]), a1 = pk2(pv[2], pv[3]), a2 = pk2(pv[4], pv[5]), a3 = pk2(pv[6], pv[7]); pf = __builtin_bit_cast(bf16x8, (v4u){a0, a1, a2, a3}); }
#pragma unroll
                    for (int dt = 0; dt < 8; ++dt) acc[dt] = __builtin_amdgcn_mfma_f32_16x16x32_bf16(cat8(vlo[dt], vhi[dt]), pf, acc[dt], 0, 0, 0);
                    __builtin_amdgcn_sched_barrier(0);
                }
            }
            den += __shfl_xor(den, 16); den += __shfl_xor(den, 32);
            den += si * nq;
            const float inv = 1.0f / fmaxf(fabsf(den), ed);
            float ss = 0.f;
#pragma unroll
            for (int dt = 0; dt < 8; ++dt) { acc[dt] = acc[dt] * inv; ss += (acc[dt][0] * acc[dt][0] + acc[dt][1] * acc[dt][1]) + (acc[dt][2] * acc[dt][2] + acc[dt][3] * acc[dt][3]); }
            ss += __shfl_xor(ss, 16); ss += __shfl_xor(ss, 32);
            const float rs = 1.0f / sqrtf(ss * (1.0f / 128.0f) + EPS);
            const size_t mrow = (size_t)(m0 + lrow);
#pragma unroll
            for (int dt = 0; dt < 8; ++dt) { const int d0 = 16 * dt + 4 * G;
                const uint2 ov = *(const uint2*)(zm + mrow * NZM + 1536 + 128 * h + d0);
                const f32x4 nw = *(const f32x4*)(normw + 128 * h + d0);
                const float y0 = acc[dt][0] * rs * nw[0] * sigmoidf_(bflo(ov.x)), y1 = acc[dt][1] * rs * nw[1] * sigmoidf_(bfhi(ov.x));
                const float y2 = acc[dt][2] * rs * nw[2] * sigmoidf_(bflo(ov.y)), y3 = acc[dt][3] * rs * nw[3] * sigmoidf_(bfhi(ov.y));
                uint2 o; o.x = pk2(y0, y1); o.y = pk2(y2, y3); *(uint2*)(Y + mrow * DM + 128 * h + d0) = o; }
        }
#pragma unroll
        for (int et = 0; et < 8; ++et) Cacc[et] = Cacc[et] * s_old;
        { s16x4 blo[2][8], bhi[2][8], alo[2], ahi[2];
          const int rq = 4 * G + ((lane >> 2) & 3), cb = 4 * (lane & 3);
#define ML_LD7(buf, kp_) do { const int rb_ = 32 * (kp_) + rq; alo[buf] = lds_tr16(Vs + rb_ * ML_ROWB + (16 * w + cb) * 2); ahi[buf] = lds_tr16(Vs + (rb_ + 16) * ML_ROWB + (16 * w + cb) * 2); \
            _Pragma("unroll") for (int et = 0; et < 8; ++et) { blo[buf][et] = lds_tr16(Ks + rb_ * ML_ROWB + (16 * et + cb) * 2); bhi[buf][et] = lds_tr16(Ks + (rb_ + 16) * ML_ROWB + (16 * et + cb) * 2); } } while (0)
          ML_LD7(0, 0);
#pragma unroll
          for (int kp = 0; kp < 4; ++kp) {
            __builtin_amdgcn_sched_barrier(0);
            if (kp + 1 < 4) ML_LD7((kp + 1) & 1, kp + 1);
            __builtin_amdgcn_sched_barrier(0);
            const f32x4 wl = *(const LAS f32x4*)(wgt + 32 * kp + 4 * G), wh = *(const LAS f32x4*)(wgt + 32 * kp + 16 + 4 * G);
            const s16x4 a_lo = alo[kp & 1], a_hi = ahi[kp & 1];
            bf16x8 af; { const unsigned a0 = pk2(bf2f((unsigned short)a_lo[0]) * wl[0], bf2f((unsigned short)a_lo[1]) * wl[1]), a1 = pk2(bf2f((unsigned short)a_lo[2]) * wl[2], bf2f((unsigned short)a_lo[3]) * wl[3]),
                                          a2 = pk2(bf2f((unsigned short)a_hi[0]) * wh[0], bf2f((unsigned short)a_hi[1]) * wh[1]), a3 = pk2(bf2f((unsigned short)a_hi[2]) * wh[2], bf2f((unsigned short)a_hi[3]) * wh[3]);
                af = __builtin_bit_cast(bf16x8, (v4u){a0, a1, a2, a3}); }
#pragma unroll
            for (int et = 0; et < 8; ++et) Cacc[et] = __builtin_amdgcn_mfma_f32_16x16x32_bf16(af, cat8(blo[kp & 1][et], bhi[kp & 1][et]), Cacc[et], 0, 0, 0);
          }
#undef ML_LD7
        }
        { const int e = tidv & 127, sq = tidv >> 7; float p = 0.f;
#pragma unroll 8
            for (int i = 0; i < 32; ++i) { const int s = 32 * sq + i; p += wgt[s] * bf2f(*(const LAS unsigned short*)(Ks + s * ML_ROWB + e * 2)); }
            npart[sq * 128 + e] = p; }
        __syncthreads();
        if (tidv < 128) nvec[tidv] = s_old * nvec[tidv] + ((npart[tidv] + npart[128 + tidv]) + (npart[256 + tidv] + npart[384 + tidv]));
        m_prev = m_new;
        __syncthreads();
#undef ML_ISSUE
}
__device__ __forceinline__ void mlstm_unit(Frame& F, int b, int h, int c_end, int c_out0) {
    pg8::ch_wait_n<8>((unsigned*)(F.ws + WS_CTL) + CW_CHN + pg8::ch_word(11, 8 * b), pg8::CH_STRIDE, 120u, (unsigned*)(F.ws + WS_CTL) + CW_BAR + XB_TMO, F.colo);
    LAS float* fl = (LAS float*)(F.lds + ML_F);
    LAS float *nvec = fl + 640, *cwL = fl + 1552;
    const float* convw = F.in[4];
    f32x4 Cacc[8];
#pragma unroll
    for (int et = 0; et < 8; ++et) Cacc[et] = (f32x4){0.f, 0.f, 0.f, 0.f};
    float m_prev = 0.f;
    { const int tp = F.tid;
      if (tp < 128) { nvec[tp] = 0.f; const int zc0 = ((tp >= 64) ? 512 : 0) + 128 * h + 2 * (tp & 63);
#pragma unroll
        for (int j = 0; j < 4; ++j) { cwL[tp * 8 + 2 * j] = convw[j * 1024 + zc0]; cwL[tp * 8 + 2 * j + 1] = convw[j * 1024 + zc0 + 1]; } } }
    __syncthreads();
    const int c_mid = c_out0 < c_end ? c_out0 : c_end;
    const float ib = F.in[5][h], fb = F.in[6][h]; const float* normw = F.in[7];
    for (int c = 0; c < c_mid; ++c) mlstm_chunk<false>(F, b, h, c, Cacc, m_prev, ib, fb, normw);
    unsigned* const ycnt = (unsigned*)(F.ws + WS_CTL) + CW_CHN + pg8::ch_word(10, 8 * b);
    for (int c = c_mid; c < c_end; ++c) { mlstm_chunk<true>(F, b, h, c, Cacc, m_prev, ib, fb, normw); if (c & 1) pg8::ch_publish_now(ycnt + pg8::CH_STRIDE * (c >> 1), F.colo); }
}

constexpr int LO_TW = 0, LO_XA = 9216, LO_SG = 18432, LO_ST = 36864, LO_STW = 9216;
__device__ __forceinline__ void lora_unit(Frame& F, int b, int tb) {
    LAS unsigned char* L = F.lds;
    const int tid = F.tid, lane = F.lane, w = F.wave, fr = lane & 15, G = lane >> 4;
    const bf16* zr = (const bf16*)(F.ws + WS_ZR);
    const size_t m0 = (size_t)b * SEQ + 64 * tb;
    {
        unsigned* pc = (unsigned*)(F.ws + WS_CTL) + CW_CHN + pg8::ch_word(11, 8 * b + (tb >> 2)); unsigned* tm = (unsigned*)(F.ws + WS_CTL) + CW_BAR + XB_TMO;
        if ((tb & 3) == 0 && tb > 0) pg8::ch_wait_n<2>(pc - pg8::CH_STRIDE, pg8::CH_STRIDE, 120u, tm, F.colo); else pg8::ch_wait_n<1>(pc, pg8::CH_STRIDE, 120u, tm, F.colo); }
    { const int grp = tid & 31, run = tid >> 5; const int zc = 1536 + 8 * grp;
        float mu8[8]; const float* mu_in = F.in[8];
#pragma unroll
        for (int i = 0; i < 8; ++i) mu8[i] = mu_in[zc + i];
        const bf16* p = zr + (m0 + 4 * run) * NZR + zc;
        v4u raw[5];
        raw[0] = (64 * tb + 4 * run > 0) ? *(const v4u*)(p - NZR) : (v4u){0u, 0u, 0u, 0u};
#pragma unroll
        for (int i = 0; i < 4; ++i) raw[1 + i] = *(const v4u*)(p + (size_t)i * NZR);
        const int kind = grp < 8 ? 1 : (grp < 16 ? 0 : 2); const float asc = kind == 1 ? 2.0f : 1.0f;
        LAS unsigned char* dst = grp < 8 ? L + LO_TW + (4 * run) * 144 + (8 * grp) * 2 : (grp < 16 ? L + LO_XA + (4 * run) * 144 + (8 * (grp - 8)) * 2 : L + LO_SG + (4 * run) * 272 + (8 * (grp - 16)) * 2);
        const int dstride = grp < 16 ? 144 : 272;
#pragma unroll
        for (int i = 0; i < 4; ++i) { const v4u uc = raw[1 + i], up = raw[i]; float v[8];
#pragma unroll
            for (int q = 0; q < 4; ++q) { const float c0 = bflo(uc[q]), c1 = bfhi(uc[q]), p0 = bflo(up[q]), p1 = bfhi(up[q]);
                v[2 * q] = c0 + (p0 - c0) * mu8[2 * q]; v[2 * q + 1] = c1 + (p1 - c1) * mu8[2 * q + 1]; }
            if (kind != 0) {
#pragma unroll
                for (int q = 0; q < 8; ++q) { const float g = sigmoidf_(v[q] * asc); v[q] = kind == 1 ? 2.0f * g - 1.0f : g; } }
            v4u o; o.x = pk2(v[0], v[1]); o.y = pk2(v[2], v[3]); o.z = pk2(v[4], v[5]); o.w = pk2(v[6], v[7]);
            *(LAS v4u*)(dst + i * dstride) = o; }
    }
    __syncthreads();
    const bf16* wup_t = (const bf16*)(F.ws + WS_LORA); const bf16* aup_t = wup_t + 512 * 64; const bf16* gup_t = wup_t + 2 * 512 * 64;
    LAS unsigned char* stg = L + LO_ST + w * LO_STW;
    LAS unsigned char* est = stg; LAS unsigned char* ast = stg + 2304; LAS unsigned char* gst = stg + 4608;
    bf16* Eo = (bf16*)(F.ws + WS_E); bf16* ALo = (bf16*)(F.ws + WS_AL); bf16* GGo = (bf16*)(F.ws + WS_GG);
    const float* w0_in = F.in[9]; const float* a0_in = F.in[11];
    bf16x8 wf[4][8];
#pragma unroll
    for (int c4 = 0; c4 < 4; ++c4) { const int ch = 64 * w + 16 * c4 + fr;
#pragma unroll
        for (int ks = 0; ks < 2; ++ks) { wf[c4][ks] = *(const bf16x8*)(wup_t + (size_t)ch * 64 + 32 * ks + 8 * G); wf[c4][2 + ks] = *(const bf16x8*)(aup_t + (size_t)ch * 64 + 32 * ks + 8 * G); }
#pragma unroll
        for (int ks = 0; ks < 4; ++ks) wf[c4][4 + ks] = *(const bf16x8*)(gup_t + (size_t)ch * 128 + 32 * ks + 8 * G); }
#pragma unroll 1
    for (int tt = 0; tt < 4; ++tt) {
        bf16x8 fw[2], fa[2], fg[4];
#pragma unroll
        for (int ks = 0; ks < 2; ++ks) { fw[ks] = *(const LAS bf16x8*)(L + LO_TW + (16 * tt + fr) * 144 + (32 * ks + 8 * G) * 2); fa[ks] = *(const LAS bf16x8*)(L + LO_XA + (16 * tt + fr) * 144 + (32 * ks + 8 * G) * 2); }
#pragma unroll
        for (int ks = 0; ks < 4; ++ks) fg[ks] = *(const LAS bf16x8*)(L + LO_SG + (16 * tt + fr) * 272 + (32 * ks + 8 * G) * 2);
#pragma unroll
        for (int c4 = 0; c4 < 4; ++c4) {
            f32x4 dw = (f32x4){0.f, 0.f, 0.f, 0.f}, da = dw, dg = dw;
#pragma unroll
            for (int ks = 0; ks < 2; ++ks) { dw = __builtin_amdgcn_mfma_f32_16x16x32_bf16(wf[c4][ks], fw[ks], dw, 0, 0, 0); da = __builtin_amdgcn_mfma_f32_16x16x32_bf16(wf[c4][2 + ks], fa[ks], da, 0, 0, 0); }
#pragma unroll
            for (int ks = 0; ks < 4; ++ks) dg = __builtin_amdgcn_mfma_f32_16x16x32_bf16(wf[c4][4 + ks], fg[ks], dg, 0, 0, 0);
            const f32x4 w0 = *(const f32x4*)(w0_in + 64 * w + 16 * c4 + 4 * G), a0 = *(const f32x4*)(a0_in + 64 * w + 16 * c4 + 4 * G);
            f32x4 ev, av;
#pragma unroll
            for (int r = 0; r < 4; ++r) { ev[r] = 0.6065306597126334f * sigmoidf_(dw[r] + w0[r]); av[r] = sigmoidf_(da[r] + a0[r]); }
            u32x2v oe, oa, og; oe.x = pk2(ev[0], ev[1]); oe.y = pk2(ev[2], ev[3]); *(LAS u32x2v*)(est + fr * 144 + (16 * c4 + 4 * G) * 2) = oe;
            oa.x = pk2(av[0], av[1]); oa.y = pk2(av[2], av[3]); og.x = pk2(dg[0], dg[1]); og.y = pk2(dg[2], dg[3]);
            *(LAS u32x2v*)(ast + fr * 144 + (16 * c4 + 4 * G) * 2) = oa; *(LAS u32x2v*)(gst + fr * 144 + (16 * c4 + 4 * G) * 2) = og; }
        asm volatile("s_waitcnt lgkmcnt(0)" ::: "memory");
        const size_t mr = m0 + 16 * tt;
#pragma unroll
        for (int i = 0; i < 2; ++i) { const int tok = 8 * i + (lane >> 3), pc = lane & 7;
            *(v4u*)(Eo + (mr + tok) * 512 + 64 * w + 8 * pc) = *(const LAS v4u*)(est + tok * 144 + pc * 16); *(v4u*)(ALo + (mr + tok) * 512 + 64 * w + 8 * pc) = *(const LAS v4u*)(ast + tok * 144 + pc * 16); *(v4u*)(GGo + (mr + tok) * 512 + 64 * w + 8 * pc) = *(const LAS v4u*)(gst + tok * 144 + pc * 16); }
        asm volatile("s_waitcnt lgkmcnt(0)" ::: "memory");
    }
    __syncthreads();
    pg8::ch_publish_now((unsigned*)(F.ws + WS_CTL) + CW_CHN + pg8::ch_word(6, 32 * b + tb), F.colo);
}

constexpr int RW_FS = 68;
constexpr int RW_RF = 0, RW_KF = 17408, RW_EF = 34816, RW_AL = 52224;
constexpr int RW_OPS = 144;
constexpr int RW_AT = 0, RW_RT = 9216, RW_BT = 18432, RW_KT = 27648, RW_BH = 36864, RW_KH = 46080, RW_VI = 55296;
constexpr int RW_VF = 69632;
constexpr int RW_TW = 87040, RW_XA = 96256, RW_SG = 105472;
constexpr int RW_GAB = 87040, RW_GAK = 96256, RW_GBR = 105472, RW_GKR = 114688;
constexpr int RW_G = 123904;
constexpr int RW_YT = 132096;
constexpr int RW_DIAG = 149504;
constexpr int RW_DB = 153600;
constexpr int RW_WC = 158720, RW_BON = 158976, RW_ESEG = 159232, RW_PAR = 161280, RW_END = 162560;
static_assert(RW_END <= MISC_OFF, "rwkv LDS map");
__device__ __forceinline__ int rw_pos(int k) { return (k & 32) + 8 * ((k >> 2) & 3) + 4 * ((k >> 4) & 1) + (k & 3); }
__device__ __forceinline__ bf16x8 pack8(const f32x4& lo, const f32x4& hi) { const unsigned a0 = pk2(lo[0], lo[1]), a1 = pk2(lo[2], lo[3]), a2 = pk2(hi[0], hi[1]), a3 = pk2(hi[2], hi[3]); return __builtin_bit_cast(bf16x8, (v4u){a0, a1, a2, a3}); }
__device__ __forceinline__ bf16x8 pack4z(const f32x4& lo) { const unsigned a0 = pk2(lo[0], lo[1]), a1 = pk2(lo[2], lo[3]); return __builtin_bit_cast(bf16x8, (v4u){a0, a1, 0u, 0u}); }
#define RW_MFMA(a, b, c) __builtin_amdgcn_mfma_f32_16x16x32_bf16((a), (b), (c), 0, 0, 0)
#define RW_LDA(base, row, ks) (*(const LAS bf16x8*)(L + (base) + (row) * RW_OPS + (32 * (ks) + 8 * G) * 2))
#define RW_LDT(base, c16, ks) cat8(lds_tr16(L + (base) + (32 * (ks) + 4 * G + ((lane >> 2) & 3)) * RW_OPS + (16 * (c16) + 4 * (lane & 3)) * 2), lds_tr16(L + (base) + (32 * (ks) + 16 + 4 * G + ((lane >> 2) & 3)) * RW_OPS + (16 * (c16) + 4 * (lane & 3)) * 2))
__device__ __forceinline__ void rwkv_unit(Frame& F, int b, int h) {
    LAS unsigned char* L = F.lds;
    LAS float *Rf = (LAS float*)(L + RW_RF), *Kf = (LAS float*)(L + RW_KF), *Ef = (LAS float*)(L + RW_EF), *ALf = (LAS float*)(L + RW_AL), *Vf = (LAS float*)(L + RW_VF);
    LAS float *YT = (LAS float*)(L + RW_YT), *DIAG = (LAS float*)(L + RW_DIAG), *WC = (LAS float*)(L + RW_WC), *BON = (LAS float*)(L + RW_BON), *ESEG = (LAS float*)(L + RW_ESEG);
    LAS unsigned char *TW = L + RW_TW, *XA = L + RW_XA, *SG = L + RW_SG; LAS unsigned short* Gs = (LAS unsigned short*)(L + RW_G);
    const int tid = F.tid, lane0 = F.lane, w = F.wave, fr0 = lane0 & 15, G0 = lane0 >> 4;
    const bf16* zr = (const bf16*)(F.ws + WS_ZR);
    const float* mu = F.in[8];
    const bf16* wup_t = (const bf16*)(F.ws + WS_LORA); const bf16* aup_t = wup_t + 512 * 64; const bf16* gup_t = wup_t + 2 * 512 * 64;
    bf16* Y = (bf16*)F.out;
    const int hc0 = 64 * h;
    f32x4 ST[4];
#pragma unroll
    for (int jt = 0; jt < 4; ++jt) ST[jt] = (f32x4){0.f, 0.f, 0.f, 0.f};
    for (int i = tid; i < 4 * 16 * 20; i += NWAVES * 64) ((LAS unsigned*)(L + RW_DB))[i] = 0u;
    LAS float* PAR = (LAS float*)(L + RW_PAR);
    if (tid < 320) { const int a = tid >> 6, c = tid & 63; const float* src = a == 0 ? F.in[14] : (a == 1 ? F.in[15] : (a == 2 ? F.in[16] : (a == 3 ? F.in[17] : F.in[18]))); PAR[tid] = src[hc0 + c]; }
    const bool ld_on = tid < 384; const int grp = ld_on ? tid % 24 : 0, run4 = ld_on ? tid / 24 : 0;
    const int zc = 512 * (grp >> 3) + hc0 + 8 * (grp & 7);
    float mu8[8];
#pragma unroll
    for (int i = 0; i < 8; ++i) mu8[i] = mu[zc + i];
    LAS unsigned char* const adst = L + (grp < 8 ? RW_RF : (grp < 16 ? RW_KF : RW_VF)) + (4 * run4) * 272 + (8 * (grp & 7)) * 4;
    const bf16* Eg = (const bf16*)(F.ws + WS_E); const bf16* ALg = (const bf16*)(F.ws + WS_AL); const bf16* GGg = (const bf16*)(F.ws + WS_GG);
    v4u raw[5]; v4u eraw, alraw, graw;
    const unsigned rvoff = (unsigned)((4 * run4) * NZR + zc) * 2u;
    const unsigned agoff = (unsigned)((tid >> 3) * 512 + hc0 + 8 * (tid & 7)) * 2u;
#define RW_ISSUE(tbn) do { const size_t mb_ = (size_t)b * SEQ + (tbn) * 64; \
        if (ld_on) { const char* zb_ = (const char*)(zr + mb_ * NZR); \
            raw[0] = ((tbn) * 64 + 4 * run4 > 0) ? *(const v4u*)(zb_ - NZR * 2 + rvoff) : (v4u){0u, 0u, 0u, 0u}; \
            _Pragma("unroll") for (int i_ = 0; i_ < 4; ++i_) raw[1 + i_] = *(const v4u*)(zb_ + (size_t)i_ * NZR * 2 + rvoff); } \
        eraw = *(const v4u*)((const char*)(Eg + mb_ * 512) + agoff); \
        alraw = *(const v4u*)((const char*)(ALg + mb_ * 512) + agoff); graw = *(const v4u*)((const char*)(GGg + mb_ * 512) + agoff); } while (0)
    unsigned* const lctr = (unsigned*)(F.ws + WS_CTL) + CW_CHN + pg8::ch_word(6, 32 * b); unsigned* const ltmo = (unsigned*)(F.ws + WS_CTL) + CW_BAR + XB_TMO;
    unsigned* const ycnt = (unsigned*)(F.ws + WS_CTL) + CW_CHN + pg8::ch_word(10, 8 * b);
    pg8::ch_wait_n<8>((unsigned*)(F.ws + WS_CTL) + CW_CHN + pg8::ch_word(11, 8 * b), pg8::CH_STRIDE, 120u, ltmo, F.colo);
    pg8::ch_wait(lctr, 8u, ltmo);
    if (!F.colo) { __builtin_amdgcn_fence(__ATOMIC_ACQUIRE, "agent"); asm volatile("s_waitcnt vmcnt(0)" ::: "memory"); }
    RW_ISSUE(0);
    __syncthreads();
    for (int tb = 0; tb < 32; ++tb) {
        unsigned lpv = 8u; if (tb + 1 < 32) lpv = __hip_atomic_load(lctr + pg8::CH_STRIDE * (tb + 1), __ATOMIC_RELAXED, __HIP_MEMORY_SCOPE_AGENT);
        const size_t m0 = (size_t)b * SEQ + tb * 64;
        int lane = lane0, fr = fr0, G = G0, ct = tid >> 3, cg = tid & 7;
        asm volatile("" : "+v"(lane), "+v"(fr), "+v"(G), "+v"(ct), "+v"(cg));
        if (ld_on) {
            LAS unsigned char* ap = adst; asm volatile("" : "+v"(ap));
#pragma unroll
            for (int i = 0; i < 4; ++i) { const v4u uc = raw[1 + i], up = raw[i]; float v[8];
#pragma unroll
                for (int q = 0; q < 4; ++q) { const float c0 = bflo(uc[q]), c1 = bfhi(uc[q]), p0 = bflo(up[q]), p1 = bfhi(up[q]);
                    v[2 * q] = c0 + (p0 - c0) * mu8[2 * q]; v[2 * q + 1] = c1 + (p1 - c1) * mu8[2 * q + 1]; }
                *(LAS f32x4*)ap = (f32x4){v[0], v[1], v[2], v[3]}; *(LAS f32x4*)(ap + 16) = (f32x4){v[4], v[5], v[6], v[7]};
                ap += 272; asm volatile("" : "+v"(ap)); }
        }
        { LAS float* ep_ = Ef + ct * RW_FS + 8 * cg; *(LAS f32x4*)ep_ = (f32x4){bflo(eraw.x), bfhi(eraw.x), bflo(eraw.y), bfhi(eraw.y)}; *(LAS f32x4*)(ep_ + 4) = (f32x4){bflo(eraw.z), bfhi(eraw.z), bflo(eraw.w), bfhi(eraw.w)}; }
        const v4u gpk = graw;
        __syncthreads();
        if (tb >= 5 && ((tb - 5) & 3) == 0) {
            if (F.colo) pg8::ch_arrive(ycnt + pg8::CH_STRIDE * ((tb - 5) >> 2), true); else pg8::ch_publish_now(ycnt + pg8::CH_STRIDE * ((tb - 5) >> 2), false); }
        { float c8[8]; float run_ = 0.f;
#pragma unroll
            for (int q = 0; q < 8; ++q) { run_ += Ef[(8 * w + q) * RW_FS + lane]; c8[q] = run_; }
            ESEG[w * 64 + lane] = run_;
            __syncthreads();
            float off = 0.f;
#pragma unroll
            for (int q = 0; q < 7; ++q) off += (q < w) ? ESEG[q * 64 + lane] : 0.f;
#pragma unroll
            for (int q = 0; q < 8; ++q) Ef[(8 * w + q) * RW_FS + lane] = c8[q] + off;
            if (w == 7) WC[lane] = __expf(-(c8[7] + off)); }
        __syncthreads();
        float o_at[8], o_rt[8], o_bt[8], o_kt[8], o_bh[8], o_kh[8], o_v[8];
        { float kr[8], rr[8], ec[8], ep[8], eC[8], al[8]; float ssq = 0.f, bon = 0.f;
#pragma unroll
            for (int q = 0; q < 4; ++q) { al[2 * q] = bflo(alraw[q]); al[2 * q + 1] = bfhi(alraw[q]); }
#pragma unroll
            for (int q = 0; q < 2; ++q) { const f32x4 a = *(const LAS f32x4*)(Kf + ct * RW_FS + 8 * cg + 4 * q), bq = *(const LAS f32x4*)(Rf + ct * RW_FS + 8 * cg + 4 * q),
                    d = *(const LAS f32x4*)(Ef + ct * RW_FS + 8 * cg + 4 * q), e2 = *(const LAS f32x4*)(Ef + 63 * RW_FS + 8 * cg + 4 * q), vv = *(const LAS f32x4*)(Vf + ct * RW_FS + 8 * cg + 4 * q);
                f32x4 p = (f32x4){0.f, 0.f, 0.f, 0.f}; if (ct > 0) p = *(const LAS f32x4*)(Ef + (ct - 1) * RW_FS + 8 * cg + 4 * q);
#pragma unroll
                for (int i = 0; i < 4; ++i) { kr[4 * q + i] = a[i]; rr[4 * q + i] = bq[i]; ec[4 * q + i] = d[i]; eC[4 * q + i] = e2[i]; ep[4 * q + i] = p[i]; o_v[4 * q + i] = vv[i]; } }
            typedef float f2 __attribute__((ext_vector_type(2)));
            f2 pk_[4], pa_[4], pr_[4];
#pragma unroll
            for (int q = 0; q < 2; ++q) { const f32x4 a = *(const LAS f32x4*)(PAR + 8 * cg + 4 * q), b2 = *(const LAS f32x4*)(PAR + 64 + 8 * cg + 4 * q), c2 = *(const LAS f32x4*)(PAR + 128 + 8 * cg + 4 * q);
                pk_[2 * q] = (f2){a[0], a[1]}; pk_[2 * q + 1] = (f2){a[2], a[3]}; pa_[2 * q] = (f2){b2[0], b2[1]}; pa_[2 * q + 1] = (f2){b2[2], b2[3]}; pr_[2 * q] = (f2){c2[0], c2[1]}; pr_[2 * q + 1] = (f2){c2[2], c2[3]}; }
            f2 kk2[4], ss2 = {0.f, 0.f};
#pragma unroll
            for (int p = 0; p < 4; ++p) { const f2 kr2 = {kr[2 * p], kr[2 * p + 1]}; kk2[p] = kr2 * pk_[p]; ss2 = kk2[p] * kk2[p] + ss2; }
            ssq = row8_sum(ss2.x + ss2.y);
            const float inv = 1.0f / fmaxf(sqrtf(ssq), 1e-12f);
            const f2 inv2 = {inv, inv}, one2 = {1.0f, 1.0f}, L2 = {LOG2E, LOG2E}; f2 bon2 = {0.f, 0.f};
#pragma unroll
            for (int p = 0; p < 4; ++p) { const f2 kr2 = {kr[2 * p], kr[2 * p + 1]}, al2 = {al[2 * p], al[2 * p + 1]}, rr2 = {rr[2 * p], rr[2 * p + 1]};
                const f2 kn = kk2[p] * inv2, k2 = kr2 * ((al2 - one2) * pa_[p] + one2), bb = kn * al2;
                const f2 te = (f2){ec[2 * p], ec[2 * p + 1]} * L2, tp = (f2){ep[2 * p], ep[2 * p + 1]} * L2, tr = te - (f2){eC[2 * p], eC[2 * p + 1]} * L2;
                f2 Wt, iWt, Wp, rat;
                Wt.x = __builtin_amdgcn_exp2f(-te.x); Wt.y = __builtin_amdgcn_exp2f(-te.y); iWt.x = __builtin_amdgcn_exp2f(te.x); iWt.y = __builtin_amdgcn_exp2f(te.y);
                Wp.x = __builtin_amdgcn_exp2f(-tp.x); Wp.y = __builtin_amdgcn_exp2f(-tp.y); rat.x = __builtin_amdgcn_exp2f(tr.x); rat.y = __builtin_amdgcn_exp2f(tr.y);
                const f2 oat = -(kn * Wp), ort = rr2 * Wt, obt = bb * iWt, okt = k2 * iWt, obh = bb * rat, okh = k2 * rat;
                o_at[2 * p] = oat.x; o_at[2 * p + 1] = oat.y; o_rt[2 * p] = ort.x; o_rt[2 * p + 1] = ort.y; o_bt[2 * p] = obt.x; o_bt[2 * p + 1] = obt.y;
                o_kt[2 * p] = okt.x; o_kt[2 * p + 1] = okt.y; o_bh[2 * p] = obh.x; o_bh[2 * p + 1] = obh.y; o_kh[2 * p] = okh.x; o_kh[2 * p + 1] = okh.y;
                bon2 = (rr2 * k2) * pr_[p] + bon2; }
            bon = bon2.x + bon2.y;
            bon = row8_sum(bon);
            if (cg == 0) BON[ct] = bon; }
        __syncthreads();
        { const int p0 = 32 * (cg >> 2) + 8 * ((2 * cg) & 3) + 4 * ((cg >> 1) & 1), p1 = 32 * (cg >> 2) + 8 * ((2 * cg + 1) & 3) + 4 * ((cg >> 1) & 1);
#define RW_ST4(base, arr) do { u32x2v lo_, hi_; lo_.x = pk2(arr[0], arr[1]); lo_.y = pk2(arr[2], arr[3]); hi_.x = pk2(arr[4], arr[5]); hi_.y = pk2(arr[6], arr[7]); \
            *(LAS u32x2v*)(L + (base) + ct * RW_OPS + p0 * 2) = lo_; *(LAS u32x2v*)(L + (base) + ct * RW_OPS + p1 * 2) = hi_; } while (0)
            RW_ST4(RW_AT, o_at); RW_ST4(RW_RT, o_rt); RW_ST4(RW_BT, o_bt); RW_ST4(RW_KT, o_kt);
#undef RW_ST4
#define RW_ST4N(base, arr) do { u32x2v lo_, hi_; lo_.x = pk2(arr[0], arr[1]); lo_.y = pk2(arr[2], arr[3]); hi_.x = pk2(arr[4], arr[5]); hi_.y = pk2(arr[6], arr[7]); \
            *(LAS u32x2v*)(L + (base) + ct * RW_OPS + (8 * cg) * 2) = lo_; *(LAS u32x2v*)(L + (base) + ct * RW_OPS + (8 * cg + 4) * 2) = hi_; } while (0)
            RW_ST4N(RW_BH, o_bh); RW_ST4N(RW_KH, o_kh); RW_ST4N(RW_VI, o_v);
#undef RW_ST4N
        }
        __syncthreads();
        if (tb + 1 < 32) {
            if ((unsigned)__builtin_amdgcn_readfirstlane(lpv) < 8u) pg8::ch_wait(lctr + pg8::CH_STRIDE * (tb + 1), 8u, ltmo);
            if (!F.colo) { __builtin_amdgcn_fence(__ATOMIC_ACQUIRE, "agent"); asm volatile("s_waitcnt vmcnt(0)" ::: "memory"); }
            RW_ISSUE(tb + 1); }
        bf16x8 dfa[2][2], dfr[2][2], dfb[2][2], dfk[2][2];
#pragma unroll
        for (int qq = 0; qq < 2; ++qq) { const int q = 2 * w + qq, tq = q >> 2, sq = q & 3;
#pragma unroll
            for (int ks = 0; ks < 2; ++ks) { dfa[qq][ks] = RW_LDA(RW_AT, 16 * tq + fr, ks); dfr[qq][ks] = RW_LDA(RW_RT, 16 * tq + fr, ks); dfb[qq][ks] = RW_LDA(RW_BT, 16 * sq + fr, ks); dfk[qq][ks] = RW_LDA(RW_KT, 16 * sq + fr, ks); } }
        __builtin_amdgcn_sched_barrier(0);
#pragma unroll
        for (int qq = 0; qq < 2; ++qq) { const int q = 2 * w + qq, tq = q >> 2, sq = q & 3;
            f32x4 gab = (f32x4){0.f, 0.f, 0.f, 0.f}, gak = gab, gbr = gab, gkr = gab;
            if (sq <= tq) {
#pragma unroll
                for (int ks = 0; ks < 2; ++ks) { gab = RW_MFMA(dfb[qq][ks], dfa[qq][ks], gab); gak = RW_MFMA(dfk[qq][ks], dfa[qq][ks], gak); gbr = RW_MFMA(dfb[qq][ks], dfr[qq][ks], gbr); gkr = RW_MFMA(dfk[qq][ks], dfr[qq][ks], gkr); } }
            const int t = 16 * tq + fr, s0 = 16 * sq + 4 * G, ps = rw_pos(s0);
            if (sq == tq) {
#pragma unroll
                for (int r = 0; r < 4; ++r) { const bool lt = (4 * G + r) < fr, le = (4 * G + r) <= fr; gab[r] = lt ? gab[r] : 0.f; gak[r] = lt ? gak[r] : 0.f; gbr[r] = le ? gbr[r] : 0.f; gkr[r] = le ? gkr[r] : 0.f; }
                *(LAS f32x4*)(DIAG + tq * 256 + fr * 16 + 4 * G) = gab;
                gab = (f32x4){0.f, 0.f, 0.f, 0.f}; }
            u32x2v o;
            o.x = pk2(gab[0], gab[1]); o.y = pk2(gab[2], gab[3]); *(LAS u32x2v*)(L + RW_GAB + t * RW_OPS + ps * 2) = o;
            o.x = pk2(gak[0], gak[1]); o.y = pk2(gak[2], gak[3]); *(LAS u32x2v*)(L + RW_GAK + t * RW_OPS + ps * 2) = o;
            o.x = pk2(gbr[0], gbr[1]); o.y = pk2(gbr[2], gbr[3]); *(LAS u32x2v*)(L + RW_GBR + t * RW_OPS + ps * 2) = o;
            o.x = pk2(gkr[0], gkr[1]); o.y = pk2(gkr[2], gkr[3]); *(LAS u32x2v*)(L + RW_GKR + t * RW_OPS + ps * 2) = o; }
        __syncthreads();
        if (w == 7) { const int blk = lane >> 4; int c = lane & 15; asm volatile("" : "+v"(c)); float z[16];
            f32x4 Lr[16][4];
#define RW_ELOAD(t0_, t1_) _Pragma("unroll") for (int t = (t0_); t < (t1_); ++t) _Pragma("unroll") for (int q = 0; q < 4; ++q) if (4 * q < t) Lr[t][q] = *(const LAS f32x4*)(DIAG + blk * 256 + t * 16 + 4 * q);
#define RW_ESTEP(t0_, t1_) _Pragma("unroll") for (int t = (t0_); t < (t1_); ++t) { float p4[4] = {(t == c) ? 1.0f : 0.0f, 0.f, 0.f, 0.f}; \
                _Pragma("unroll") for (int q = 0; q < 4; ++q) if (4 * q < t) { _Pragma("unroll") for (int e = 0; e < 4; ++e) if (4 * q + e < t) p4[q] += Lr[t][q][e] * z[4 * q + e]; } \
                z[t] = (p4[0] + p4[1]) + (p4[2] + p4[3]); }
            RW_ELOAD(1, 11)
            asm volatile("s_waitcnt lgkmcnt(0)" ::: "memory"); __builtin_amdgcn_sched_barrier(0);
            RW_ESTEP(0, 7)
            __builtin_amdgcn_sched_barrier(0);
            RW_ELOAD(11, 16)
            __builtin_amdgcn_sched_barrier(0);
            RW_ESTEP(7, 11)
            asm volatile("s_waitcnt lgkmcnt(0)" ::: "memory"); __builtin_amdgcn_sched_barrier(0);
            RW_ESTEP(11, 16)
#undef RW_ELOAD
#undef RW_ESTEP
            const int slot = 8 * (c >> 2) + (c & 3);
#pragma unroll
            for (int t = 0; t < 16; ++t) *(LAS unsigned short*)(L + RW_DB + blk * 1280 + t * 80 + slot * 2) = (unsigned short)f2bf(z[t]); }
        const f32x4 z4 = (f32x4){0.f, 0.f, 0.f, 0.f};
        bf16x8 sb[2], vf[2], ub[2];
        f32x4 XT[4];
        if (w < 4) {
            bf16x8 fa[4][2], fk[4][2];
            vf[0] = RW_LDT(RW_VI, w, 0); vf[1] = RW_LDT(RW_VI, w, 1);
#pragma unroll
            for (int t4 = 0; t4 < 4; ++t4) { fa[t4][0] = RW_LDA(RW_AT, 16 * t4 + fr, 0); fa[t4][1] = RW_LDA(RW_AT, 16 * t4 + fr, 1); fk[t4][0] = RW_LDA(RW_GAK, 16 * t4 + fr, 0); if (t4 >= 2) fk[t4][1] = RW_LDA(RW_GAK, 16 * t4 + fr, 1); }
            __builtin_amdgcn_sched_barrier(0);
            sb[0] = pack8(ST[0], ST[1]); sb[1] = pack8(ST[2], ST[3]);
#pragma unroll
            for (int t4 = 0; t4 < 4; ++t4) { f32x4 acc = z4;
                acc = RW_MFMA(fa[t4][0], sb[0], acc); acc = RW_MFMA(fa[t4][1], sb[1], acc);
                acc = RW_MFMA(fk[t4][0], vf[0], acc); if (t4 >= 2) acc = RW_MFMA(fk[t4][1], vf[1], acc);
                XT[t4] = acc; }
        }
        __syncthreads();
        if (w < 4) {
#define RW_DBF(blk) (*(const LAS bf16x8*)(L + RW_DB + (blk) * 1280 + fr * 80 + (8 * G) * 2))
            bf16x8 fd[4], fg[4];
#pragma unroll
            for (int q = 0; q < 4; ++q) fd[q] = RW_DBF(q);
            fg[0] = RW_LDA(RW_GAB, 16 + fr, 0); fg[1] = RW_LDA(RW_GAB, 32 + fr, 0); fg[2] = RW_LDA(RW_GAB, 48 + fr, 0); fg[3] = RW_LDA(RW_GAB, 48 + fr, 1);
            __builtin_amdgcn_sched_barrier(0);
            const f32x4 U0 = RW_MFMA(fd[0], pack4z(XT[0]), z4);
            ub[0] = pack4z(U0);
            const f32x4 Z1 = RW_MFMA(fg[0], ub[0], XT[1]);
            const f32x4 U1 = RW_MFMA(fd[1], pack4z(Z1), z4);
            ub[0] = pack8(U0, U1);
            const f32x4 Z2 = RW_MFMA(fg[1], ub[0], XT[2]);
            const f32x4 U2 = RW_MFMA(fd[2], pack4z(Z2), z4);
            ub[1] = pack4z(U2);
            f32x4 Z3 = RW_MFMA(fg[2], ub[0], XT[3]); Z3 = RW_MFMA(fg[3], ub[1], Z3);
            const f32x4 U3 = RW_MFMA(fd[3], pack4z(Z3), z4);
            ub[1] = pack8(U2, U3);
#undef RW_DBF
            __builtin_amdgcn_sched_barrier(0);
            bf16x8 fy[4][2], fbr[4][2], fkr[4][2];
#pragma unroll
            for (int t4 = 0; t4 < 4; ++t4) { fy[t4][0] = RW_LDA(RW_RT, 16 * t4 + fr, 0); fy[t4][1] = RW_LDA(RW_RT, 16 * t4 + fr, 1); fbr[t4][0] = RW_LDA(RW_GBR, 16 * t4 + fr, 0); fkr[t4][0] = RW_LDA(RW_GKR, 16 * t4 + fr, 0);
                if (t4 >= 2) { fbr[t4][1] = RW_LDA(RW_GBR, 16 * t4 + fr, 1); fkr[t4][1] = RW_LDA(RW_GKR, 16 * t4 + fr, 1); } }
            __builtin_amdgcn_sched_barrier(0);
#pragma unroll
            for (int t4 = 0; t4 < 4; ++t4) { f32x4 acc = z4;
                acc = RW_MFMA(fy[t4][0], sb[0], acc); acc = RW_MFMA(fy[t4][1], sb[1], acc);
                acc = RW_MFMA(fbr[t4][0], ub[0], acc); acc = RW_MFMA(fkr[t4][0], vf[0], acc);
                if (t4 >= 2) { acc = RW_MFMA(fbr[t4][1], ub[1], acc); acc = RW_MFMA(fkr[t4][1], vf[1], acc); }
#pragma unroll
                for (int r = 0; r < 4; ++r) YT[(16 * t4 + 4 * G + r) * RW_FS + 16 * w + fr] = acc[r]; }
            __builtin_amdgcn_sched_barrier(0);
            bf16x8 fbh[4][2], fkh[4][2];
#pragma unroll
            for (int jt = 0; jt < 4; ++jt) { fbh[jt][0] = RW_LDT(RW_BH, jt, 0); fbh[jt][1] = RW_LDT(RW_BH, jt, 1); fkh[jt][0] = RW_LDT(RW_KH, jt, 0); fkh[jt][1] = RW_LDT(RW_KH, jt, 1); }
            __builtin_amdgcn_sched_barrier(0);
#pragma unroll
            for (int jt = 0; jt < 4; ++jt) { const f32x4 wc4 = *(const LAS f32x4*)(WC + 16 * jt + 4 * G); f32x4 acc = ST[jt] * wc4;
                acc = RW_MFMA(fbh[jt][0], ub[0], acc); acc = RW_MFMA(fbh[jt][1], ub[1], acc);
                acc = RW_MFMA(fkh[jt][0], vf[0], acc); acc = RW_MFMA(fkh[jt][1], vf[1], acc);
                ST[jt] = acc; }
        }
        __syncthreads();
        { float y[8]; float s = 0.f;
#pragma unroll
            for (int q = 0; q < 2; ++q) { const f32x4 a = *(const LAS f32x4*)(YT + ct * RW_FS + 8 * cg + 4 * q); y[4 * q] = a[0]; y[4 * q + 1] = a[1]; y[4 * q + 2] = a[2]; y[4 * q + 3] = a[3]; s += (a[0] + a[1]) + (a[2] + a[3]); }
            const float mean = row8_sum(s) * (1.0f / 64.0f); float qv = 0.f;
#pragma unroll
            for (int i = 0; i < 8; ++i) { y[i] -= mean; qv += y[i] * y[i]; }
            const float rstd = 1.0f / sqrtf(row8_sum(qv) * (1.0f / 64.0f) + RWKV_LN_EPS); const float bon = BON[ct];
            float o[8]; const v4u vpk = *(const LAS v4u*)(L + RW_VI + ct * RW_OPS + (8 * cg) * 2);
#pragma unroll
            for (int i = 0; i < 8; ++i) { const int ch = 8 * cg + i; const float vv = (i & 1) ? bfhi(vpk[i >> 1]) : bflo(vpk[i >> 1]); const float yn = y[i] * rstd * PAR[192 + ch] + PAR[256 + ch] + bon * vv; o[i] = yn * ((i & 1) ? bfhi(gpk[i >> 1]) : bflo(gpk[i >> 1])); }
            v4u ov; ov.x = pk2(o[0], o[1]); ov.y = pk2(o[2], o[3]); ov.z = pk2(o[4], o[5]); ov.w = pk2(o[6], o[7]);
            *(v4u*)(Y + (m0 + ct) * DM + 512 + hc0 + 8 * cg) = ov; }
        __syncthreads();
    }
    pg8::ch_publish_now(ycnt + pg8::CH_STRIDE * 7, F.colo);
#undef RW_ISSUE
}
#undef RW_MFMA
#undef RW_LDA
#undef RW_LDT

typedef float f32x16 __attribute__((ext_vector_type(16)));
constexpr int AT_ROWB = 528;
__device__ __forceinline__ void attn_load_tile(Frame& F, const bf16* src  ) {
    const unsigned voff = (unsigned)(F.tid >> 5) * 4096u + (unsigned)(F.tid & 31) * 16u;
    LAS unsigned char* dst = F.lds + (F.tid >> 5) * AT_ROWB + (F.tid & 31) * 16;
#pragma unroll
    for (int hh = 0; hh < 2; ++hh) { v4u r[8];
#pragma unroll
        for (int i = 0; i < 8; ++i) r[i] = *(const v4u*)((const char*)src + (size_t)(8 * hh + i) * 65536 + voff);
#pragma unroll
        for (int i = 0; i < 8; ++i) *(LAS v4u*)(dst + (8 * hh + i) * 16 * AT_ROWB) = r[i]; }
}
__device__ __forceinline__ void attn_unit(Frame& F, int b, int hd, int qt) {
    const int lane = F.lane, w = F.wave, r32 = lane & 31, hi = lane >> 5;
    const bf16* kv = (const bf16*)(F.ws + WS_KV) + (size_t)b * MEMT * 2048 + 256 * hd;
    bf16* QO = (bf16*)((unsigned char*)F.out + OUT_QO);
    const size_t qrow = (size_t)b * SEQ + 256 * qt + 32 * w + r32;
    attn_load_tile(F, kv);
    bf16x8 qf[16];
#pragma unroll
    for (int ks = 0; ks < 16; ++ks) qf[ks] = *(const bf16x8*)((const char*)(QO + ((size_t)b * SEQ + 256 * qt + 32 * w) * DM + 256 * hd + 16 * ks) + (unsigned)(r32 * 2048 + hi * 16));
    __syncthreads();
    float mxh[2], smh[2];
    bf16x8 pf[16];
#pragma unroll
    for (int half = 0; half < 2; ++half) {
        f32x16 s[4];
#pragma unroll
        for (int k4 = 0; k4 < 4; ++k4)
#pragma unroll
            for (int r = 0; r < 16; ++r) s[k4][r] = 0.f;
        bf16x8 fa[2][4];
#define AT_LDB(buf, hb) _Pragma("unroll") for (int j_ = 0; j_ < 4; ++j_) fa[buf][j_] = *(const LAS bf16x8*)(F.lds + (32 * (4 * half + ((hb) >> 2)) + r32) * AT_ROWB + (16 * (4 * ((hb) & 3) + j_) + 8 * hi) * 2);
        AT_LDB(0, 0)
#pragma unroll
        for (int hb = 0; hb < 16; ++hb) {
            __builtin_amdgcn_sched_barrier(0);
            if (hb + 1 < 16) { AT_LDB((hb + 1) & 1, hb + 1) }
            __builtin_amdgcn_sched_barrier(0);
#pragma unroll
            for (int j = 0; j < 4; ++j) s[hb >> 2] = __builtin_amdgcn_mfma_f32_32x32x16_bf16(fa[hb & 1][j], qf[4 * (hb & 3) + j], s[hb >> 2], 0, 0, 0);
        }
#undef AT_LDB
        float mx = -INFINITY;
#pragma unroll
        for (int k4 = 0; k4 < 4; ++k4)
#pragma unroll
            for (int r = 0; r < 16; ++r) mx = fmaxf(mx, s[k4][r]);
        mx = fmaxf(mx, __shfl_xor(mx, 32));
        float sum = 0.f;
#pragma unroll
        for (int k4 = 0; k4 < 4; ++k4) {
#pragma unroll
            for (int r = 0; r < 16; ++r) { s[k4][r] = __builtin_amdgcn_exp2f(s[k4][r] - mx); sum += s[k4][r]; }
#pragma unroll
            for (int ss = 0; ss < 2; ++ss) { const unsigned a0 = pk2(s[k4][8 * ss + 0], s[k4][8 * ss + 1]), a1 = pk2(s[k4][8 * ss + 2], s[k4][8 * ss + 3]), a2 = pk2(s[k4][8 * ss + 4], s[k4][8 * ss + 5]), a3 = pk2(s[k4][8 * ss + 6], s[k4][8 * ss + 7]);
                pf[8 * half + 2 * k4 + ss] = __builtin_bit_cast(bf16x8, (v4u){a0, a1, a2, a3}); }
        }
        sum += __shfl_xor(sum, 32);
        mxh[half] = mx; smh[half] = sum;
    }
    __syncthreads();
    attn_load_tile(F, kv + 1024);
    const float mxa = fmaxf(mxh[0], mxh[1]);
    float f0 = __builtin_amdgcn_exp2f(mxh[0] - mxa), f1 = __builtin_amdgcn_exp2f(mxh[1] - mxa);
    const float inv = 1.0f / (f0 * smh[0] + f1 * smh[1]);
    f0 *= inv; f1 *= inv;
    __syncthreads();
    const int G4 = lane >> 4;
    const LAS unsigned char* vb = F.lds + (4 * (G4 >> 1) + ((lane >> 2) & 3)) * AT_ROWB + (16 * (G4 & 1) + 4 * (lane & 3)) * 2;
#pragma unroll 1
    for (int dt = 0; dt < 8; ++dt) {
        f32x16 oa, ob;
#pragma unroll
        for (int r = 0; r < 16; ++r) { oa[r] = 0.f; ob[r] = 0.f; }
#pragma unroll
        for (int kk = 0; kk < 8; ++kk) { const s16x4 lo = lds_tr16(vb + (16 * kk) * AT_ROWB + dt * 64), hi4 = lds_tr16(vb + (16 * kk + 8) * AT_ROWB + dt * 64);
            oa = __builtin_amdgcn_mfma_f32_32x32x16_bf16(cat8(lo, hi4), pf[kk], oa, 0, 0, 0);
            const s16x4 lo2 = lds_tr16(vb + (16 * kk + 128) * AT_ROWB + dt * 64), hi42 = lds_tr16(vb + (16 * kk + 136) * AT_ROWB + dt * 64);
            ob = __builtin_amdgcn_mfma_f32_32x32x16_bf16(cat8(lo2, hi42), pf[kk + 8], ob, 0, 0, 0); }
#pragma unroll
        for (int rg = 0; rg < 4; ++rg) { uint2 ov; ov.x = pk2(oa[4 * rg + 0] * f0 + ob[4 * rg + 0] * f1, oa[4 * rg + 1] * f0 + ob[4 * rg + 1] * f1); ov.y = pk2(oa[4 * rg + 2] * f0 + ob[4 * rg + 2] * f1, oa[4 * rg + 3] * f0 + ob[4 * rg + 3] * f1);
            *(uint2*)(QO + qrow * DM + 256 * hd + 32 * dt + 8 * rg + 4 * hi) = ov; }
    }
    __syncthreads();
}

#ifndef MK_N_LAUNCHES
#define MK_N_LAUNCHES 1
#endif
constexpr int N_PHASES = 10;
struct Args { const float* in[30]; float* out; unsigned char* ws; int ph_lo, ph_hi; };
__global__ void __launch_bounds__(NWAVES * 64, 2) mega_fwd(Args args) {
    extern __shared__ __attribute__((aligned(16))) unsigned char lds[];
    Frame F;
    F.lds = (LAS unsigned char*)lds;
    F.tid = threadIdx.x; F.lane = F.tid & 63; F.wave = __builtin_amdgcn_readfirstlane(F.tid >> 6);
    F.G = gridDim.x; { const int bx = blockIdx.x; F.vcu = (F.G % 8 == 0) ? (bx % 8) * (F.G / 8) + bx / 8 : bx; }
    F.in.p = (const float* const __attribute__((address_space(4)))*)__builtin_amdgcn_kernarg_segment_ptr();
    F.out = args.out; F.ws = args.ws;
    unsigned char* ws = args.ws;
    volatile LAS unsigned* MISC = (volatile LAS unsigned*)(F.lds + MISC_OFF);
    if (F.tid < 64) MISC[F.tid] = 0u;
    __syncthreads();
    const int lo = args.ph_lo, hi = args.ph_hi;
    const bool multi = (hi - lo) > 1;
    XcdBarrier bar; bar.bar = (unsigned*)(ws + WS_CTL) + CW_BAR; bar.x = 0; bar.st = nullptr;
    if (multi) { bar = xcd_barrier_post((unsigned*)(ws + WS_CTL) + CW_BAR, MISC + 8);
        if (F.tid == 0) (void)__hip_atomic_fetch_or((unsigned*)(ws + WS_CTL) + CW_GRP + 64 * (blockIdx.x & 7), 1u << bar.x, __ATOMIC_RELAXED, __HIP_MEMORY_SCOPE_AGENT); }
    bool colo = false;
#ifndef PHASE_MASK
#define PHASE_MASK 0x3ff
#endif
#define IN(k) (((PHASE_MASK >> (k)) & 1) && lo <= (k) && (k) < hi)
#ifndef REP2_MASK
#define REP2_MASK 0
#endif
#define REPS(k) (((REP2_MASK >> (k)) & 1) ? 2 : 1)
#define SEAM(k) do { if (IN(k) && IN((k) + 1)) xcd_barrier(bar); } while (0)
#define LSEAM(k) do { if (IN(k) && IN((k) + 1)) { if (colo) xcd_barrier_local(bar); else xcd_barrier(bar); } } while (0)
    typedef pg8::bf16_t b16;
    if (IN(0)) { for (int rp = 0; rp < REPS(0); ++rp) { p0_prologue(F); __syncthreads(); } }
    SEAM(0);
    if (multi) {
        if (F.tid == 0) { unsigned ok = (F.G == 256) ? 1u : 0u;
#pragma unroll
            for (int j = 0; j < 8; ++j) { const unsigned m = xb_ld((unsigned*)(ws + WS_CTL) + CW_GRP + 64 * j); ok &= (m != 0u && (m & (m - 1u)) == 0u) ? 1u : 0u; }
            MISC[10] = ok; }
        __syncthreads();
        colo = __builtin_amdgcn_readfirstlane(MISC[10]) != 0u;
    }
    F.colo = colo;
    unsigned* chn = (unsigned*)(ws + WS_CTL) + CW_CHN; unsigned* tmo = (unsigned*)(ws + WS_CTL) + CW_BAR + XB_TMO;
    if (IN(1)) for (int rp = 0; rp < REPS(1); ++rp) {
        pg8::Gemm g{(const b16*)(ws + WS_XN), (const b16*)(ws + WS_WIN), M + MM, NZ + 2048, DM};
        pg8::Order2C S; S.o.init(F.G, (int)blockIdx.x);
        S.hooks_init(chn, tmo, colo, F.wave); S.wait_k0 = -1; S.need0 = 0u; S.pub_k0 = 11; S.wait_k1 = -1; S.need1 = 0u; S.pub_k1 = -1;
        pg8::EpiZ E{(b16*)(ws + WS_ZM), (b16*)(ws + WS_ZR), (b16*)(ws + WS_KV)};
        pg8::gemm_phase<pg8::EpiZ, pg8::Order2C, true, true>(F.lds, g, S, E);
    }
    if (IN(2)) {
#ifndef REP_LO
#define REP_LO 1
#endif
        const int gq = (int)(blockIdx.x & 7), jq = (int)(blockIdx.x >> 3), vq = jq - 16;
        const int pu = (F.G != 256) ? F.vcu : (jq < 16 ? 16 * gq + jq : 128 + 64 * (vq & 1) + 8 * gq + 4 * (vq >> 3) + ((vq >> 1) & 3));
        if (F.G != 256) late_weights(F, F.vcu, F.G); else if (pu >= 128) late_weights(F, pu - 128, 128);
        wsplit_arrive(bar, (unsigned*)(ws + WS_CTL) + CW_WSP);
        { const int nl = (F.G != 256) ? (512 - F.vcu + F.G - 1) / F.G : (jq < 16 ? 1 : 3);
          for (int s3 = 0; s3 < nl; ++s3) { int lb, ltb;
            if (F.G != 256) { const int u = F.vcu + F.G * s3; lb = u >> 5; ltb = u & 31; }
            else if (jq < 16) { lb = 2 * gq + (jq >> 3); ltb = jq & 7; }
            else { const int n = 16 * s3 + vq; lb = 2 * gq + (n & 1); ltb = 8 + (n >> 1); }
            lora_unit(F, lb, ltb); } }
#ifndef ML_SPLIT
#define ML_SPLIT 10
#endif
#ifndef REP_RW
#define REP_RW 1
#endif
#ifndef REP_ML
#define REP_ML 1
#endif
        for (int rep = 0; rep < REP_RW; ++rep) for (int u = pu; u < 128; u += F.G) rwkv_unit(F, u >> 3, u & 7);
        for (int rep = 0; rep < REP_ML; ++rep) for (int u = pu; u < 256; u += F.G) if (u >= 128) { const int v = (u - 128) & 63; mlstm_unit(F, v >> 2, v & 3, u < 192 ? ML_SPLIT : 16, u < 192 ? 0 : ML_SPLIT); }
    }
    if (IN(2)) { __syncthreads(); if (F.tid == 0) (void)__hip_atomic_fetch_add((unsigned*)(ws + WS_CTL) + CW_CHN + pg8::ch_word(5, 8), 1u, __ATOMIC_RELAXED, __HIP_MEMORY_SCOPE_AGENT); }
    if (IN(3)) {
        wsplit_wait(bar, (unsigned*)(ws + WS_CTL) + CW_WSP);
        pg8::Gemm g{(const b16*)F.out, (const b16*)(ws + WS_WMIX), M, DM, DM};
        typedef pg8::StreamOrder<pg8::OrderQ, pg8::OrderQ> Ord; typedef pg8::EpiPair<pg8::EpiRes, pg8::EpiQ> Epi;
        Ord S; S.o0.init(F.G, F.vcu); S.o1.init(F.G, F.vcu); S.count0(); S.A1 = (const b16*)(ws + WS_H1B); S.B1 = (const b16*)(ws + WS_WQ);
        S.hooks_init(chn, tmo, colo, F.wave); S.wait_k0 = 10; S.need0 = 96u; S.pub_k0 = 0; S.wait_k1 = 0; S.need1 = 32u; S.pub_k1 = -1;
        Epi E{pg8::EpiRes{(const b16*)(ws + WS_XN), (b16*)(ws + WS_H1B), (float*)(ws + WS_SSQ1), (const float*)(ws + WS_RMS)},
              pg8::EpiQ{(b16*)((unsigned char*)F.out + OUT_QO), (const float*)(ws + WS_SSQ1), EPS, LOG2E * 0.0625f, F.lds}};
        pg8::gemm_phase<Epi, Ord, true, true>(F.lds, g, S, E);
        if (F.tid == 0) (void)__hip_atomic_fetch_add(chn + pg8::ch_word(5, (int)(blockIdx.x & 7)), 1u, __ATOMIC_RELAXED, __HIP_MEMORY_SCOPE_AGENT);
    }
    if (IN(5)) {
        pg8::OrderQ S; S.init(F.G, F.vcu); pg8::Unit u;
        for (int i = 0; S.next(i, u); ++i) { pg8::ch_wait_n<1>(chn + pg8::ch_word(11, 128 + (u.pm >> 3)), pg8::CH_STRIDE, 64u, tmo, colo);
            attn_unit(F, u.pm >> 3, u.pn, u.pm & 7); pg8::ch_publish_now(chn + pg8::ch_word(1, u.pm), colo); }
        if (F.wave == 0) asm volatile("buffer_inv sc1" ::: "memory");
    }
    if (IN(6)) {
        if (F.wave == 0) pg8::ch_wait(chn + pg8::ch_word(5, 8), (unsigned)F.G, tmo);
        __syncthreads();
        pg8::Gemm g{(const b16*)((unsigned char*)F.out + OUT_QO), (const b16*)(ws + WS_WO), M, DM, DM};
        typedef pg8::StreamOrder<pg8::StaticOrder, pg8::StaticOrder> Ord; typedef pg8::EpiPair<pg8::EpiRes, pg8::EpiGlu> Epi;
        Ord S; S.o0.init(M, DM, F.G, (int)blockIdx.x); S.o1.init(M, 2 * DFF, F.G, (int)blockIdx.x); S.count0(); S.A1 = (const b16*)(ws + WS_H2B); S.B1 = (const b16*)(ws + WS_WGU);
        S.hooks_init(chn, tmo, colo, F.wave); S.wait_k0 = 1; S.need0 = 32u; S.pub_k0 = 2; S.wait_k1 = 2; S.need1 = 32u; S.pub_k1 = 3;
        Epi E{pg8::EpiRes{(const b16*)(ws + WS_H1B), (b16*)(ws + WS_H2B), (float*)(ws + WS_SSQ2), nullptr},
              pg8::EpiGlu{(b16*)(ws + WS_ACT), (const float*)(ws + WS_SSQ2), EPS, F.lds}};
        pg8::gemm_phase<Epi, Ord, true, true>(F.lds, g, S, E);
    }
    if (IN(8)) {
        if (F.G != 256) xcd_barrier(bar);
        pg8::Gemm g{(const b16*)(ws + WS_ACT), (const b16*)(ws + WS_WD), M, DM, DFF};
        pg8::ChainOrder S; S.so.init(M, DM, F.G, (int)blockIdx.x);
        S.hooks_init(chn, tmo, colo, F.wave); S.wait_k0 = 3; S.need0 = 176u; S.pub_k0 = -1; S.wait_k1 = -1; S.need1 = 0u; S.pub_k1 = -1;
        pg8::EpiResNorm E{(const b16*)(ws + WS_H2B), F.out, (float*)(ws + WS_SSQ3), F.in[29], EPS, chn, tmo, colo, F.G == 256};
        pg8::gemm_phase<pg8::EpiResNorm, pg8::ChainOrder, true, true>(F.lds, g, S, E);
        if (xb_ld(tmo) != 0u) F.out[(size_t)F.vcu * 128 * DM + F.tid] = __builtin_nanf("");
    }
#undef IN
#undef SEAM
#undef LSEAM
}

extern "C" void kernel_launch(void* const* d_in, const int* in_sizes, int n_in, void* d_out, int out_size, void* d_ws, size_t ws_size, hipStream_t stream) {
    static int grid = 0;
    if (grid == 0) {
        if (n_in != 30 || in_sizes[0] != M * DM || out_size != M * DM || ws_size < WS_END) { fprintf(stderr, "kernel_launch: unexpected problem: n_in %d in0 %d out %d ws %zu (need %zu); nothing launched\n", n_in, n_in > 0 ? in_sizes[0] : -1, out_size, ws_size, (size_t)WS_END); grid = -1; return; }
        int dev = 0, cus = 0, per_cu = 0;
        if (hipGetDevice(&dev) != hipSuccess || hipDeviceGetAttribute(&cus, hipDeviceAttributeMultiprocessorCount, dev) != hipSuccess) { grid = -1; return; }
        if (hipFuncSetAttribute((const void*)mega_fwd, hipFuncAttributeMaxDynamicSharedMemorySize, LDS_BYTES) != hipSuccess) { fprintf(stderr, "kernel_launch: hipFuncSetAttribute(%d B LDS) failed\n", LDS_BYTES); grid = -1; return; }
        if (hipOccupancyMaxActiveBlocksPerMultiprocessor(&per_cu, (const void*)mega_fwd, NWAVES * 64, LDS_BYTES) != hipSuccess || per_cu < 1) { fprintf(stderr, "kernel_launch: occupancy query says %d blocks per CU\n", per_cu); }
        (void)hipGetLastError();
        grid = cus;
    }
    if (grid < 0) return;
    (void)hipMemsetAsync((char*)d_ws + WS_CTL, 0, CTL_ZERO_BYTES, stream);
    Args a{};
    for (int i = 0; i < 30; ++i) a.in[i] = (const float*)d_in[i];
    a.out = (float*)d_out; a.ws = (unsigned char*)d_ws;
#if MK_N_LAUNCHES == 1
    static_assert(MK_N_LAUNCHES == 1 && (ML_SPLIT & 1) == 0, "one launch (counter hand-offs); the mLSTM split must not cut a 256-token row panel");
    a.ph_lo = 0; a.ph_hi = N_PHASES;
    hipLaunchKernelGGL(mega_fwd, dim3(grid), dim3(NWAVES * 64), LDS_BYTES, stream, a);
#else
    for (int p = 0; p < N_PHASES; ++p) { a.ph_lo = p; a.ph_hi = p + 1; hipLaunchKernelGGL(mega_fwd, dim3(grid), dim3(NWAVES * 64), LDS_BYTES, stream, a); }
#endif
}
```

```cpp
#include <hip/hip_runtime.h>
#include <hip/hip_bf16.h>
#include <cstdio>
#include <cstdint>
namespace pg8 {
#define PG8_LAS __attribute__((address_space(3)))
typedef unsigned short bf16_t;
typedef short bf16x8 __attribute__((ext_vector_type(8)));
typedef float f32x4 __attribute__((ext_vector_type(4)));
typedef unsigned u32x4 __attribute__((ext_vector_type(4)));
constexpr int BM = 256, BK = 64, HALF = 128, HTB = HALF * BK * 2  , STAGE_BYTES = 8 * HTB, NXCD = 8, WGM = 4;

__host__ __device__ __forceinline__ int lds_byte(int r, int c) { const int st = (r >> 4) * 2 + (c >> 5), rr = r & 15, cc = c & 31, ob = rr * 64 + cc * 2; return st * 1024 + (ob ^ (((ob >> 9) & 1) << 5)); }
__host__ __device__ __forceinline__ void stage_rc(int b, int& R, int& C) { const int st = b / 1024, sb = b % 1024, swz = sb ^ (((sb >> 9) & 1) << 5); R = (st >> 1) * 16 + swz / 64; C = (st & 1) * 32 + (swz % 64) / 2; }
__host__ __device__ __forceinline__ int perm32(int rho) { const int n = rho >> 4, i = rho & 15; return 8 * (i >> 2) + 4 * n + (i & 3); }

struct Unit { int pm, pn, ph; };
struct Gemm { const bf16_t* A; const bf16_t* Bt; int M, N, K; };

struct NoChain {
    static constexpr int A_AUX = 0;
    __device__ __forceinline__ const char* pa(const Gemm& g, const Unit& u, size_t tstep) const { return (const char*)g.A + (size_t)u.pm * tstep; }
    __device__ __forceinline__ const char* pb(const Gemm& g, const Unit& u, size_t tstep) const { return (const char*)g.Bt + (size_t)u.pn * tstep; }
    __device__ __forceinline__ void a_ready(const Unit&) const {}
    __device__ __forceinline__ void done(const Unit&) const {}
    __device__ __forceinline__ void flush() const {}
};
struct StaticOrder : NoChain {
    int nM, nN, nwg, G, c;
    __host__ __device__ void init(int M, int N, int G_, int c_) { nM = M / BM; nN = N / BM; nwg = nM * nN; G = G_; c = c_; }
    __host__ __device__ bool next(int i, Unit& u) const {
        const long L = (long)i * G + c; if (L >= nwg) return false;
        int wgid = (int)L; { const int q = nwg / NXCD, r = nwg % NXCD, xcd = wgid % NXCD, off = wgid / NXCD; wgid = (xcd < r ? xcd * (q + 1) : r * (q + 1) + (xcd - r) * q) + off; }
        const int nig = WGM * nN, gid = wgid / nig, fm = gid * WGM, gsz = (nM - fm) < WGM ? (nM - fm) : WGM;
        u.pm = fm + ((wgid % nig) % gsz); u.pn = (wgid % nig) / gsz; return true;
    }
};

__device__ __forceinline__ unsigned cvt_pk_bf16(float lo, float hi) { unsigned r; asm volatile("v_cvt_pk_bf16_f32 %0, %1, %2" : "=v"(r) : "v"(lo), "v"(hi)); return r; }
typedef float f32x2 __attribute__((ext_vector_type(2)));

struct Order2 : NoChain {
    StaticOrder so; int G, c;
    __device__ void init(int G_, int c_) { so.init(32768, 3840, G_, c_); G = G_; c = c_; }
    __device__ bool next(int i, Unit& u) const {
        const long L = (long)i * G + c;
        if (L < 1920) return so.next(i, u);
        const int Lp = (int)(L - 1920); if (Lp >= 128) return false;
        const int xcd = Lp & 7, off = Lp >> 3;
        u.pm = 128 + xcd * 2 + (off & 1); u.pn = 15 + (off >> 1); return true;
    }
};

struct OrderQ : NoChain {
    int G, vcu;
    __device__ void init(int G_, int vcu_) { G = G_; vcu = vcu_; }
    __device__ bool next(int i, Unit& u) const {
        const int U = vcu + G * i; if (U >= 512) return false;
        const int idx = (U % 256) * 2 + U / 256;
        u.pm = 8 * (idx >> 5) + (idx & 7); u.pn = (idx >> 3) & 3; return true;
    }
};


struct EpiZ {
    static constexpr bool PERM = true, AFTER_DRAIN = false;
    __device__ __forceinline__ void prefetch(const Unit&, PG8_LAS unsigned char*, int, int) const {}
    bf16_t* zm; bf16_t* zr; bf16_t* kv;
    __device__ __forceinline__ void operator()(const f32x4 (&acc)[2][2][4][2], const Unit& u, int wr, int wc, int fr, int fq) const {
        bf16_t* base; int ldc; int row0 = u.pm * BM + wr * 64 + fr; int colt;
        if (u.pm < 128) { if (u.pn < 8) { base = zm; ldc = 2048; colt = u.pn * BM; } else { base = zr; ldc = 1792; colt = (u.pn - 8) * BM; } }
        else { base = kv; ldc = 2048; colt = (u.pn - 15) * BM; row0 -= 32768; }
        const int col0 = colt + wc * 32 + 8 * fq;
#pragma unroll
        for (int ai = 0; ai < 2; ++ai)
#pragma unroll
            for (int m = 0; m < 4; ++m) { bf16_t* rowp = base + (size_t)(row0 + ai * HALF + m * 16) * ldc + col0;
#pragma unroll
                for (int bj = 0; bj < 2; ++bj) { const f32x4 v0 = acc[ai][bj][m][0], v1 = acc[ai][bj][m][1];
                    u32x4 w; w.x = cvt_pk_bf16(v0[0], v0[1]); w.y = cvt_pk_bf16(v0[2], v0[3]); w.z = cvt_pk_bf16(v1[0], v1[1]); w.w = cvt_pk_bf16(v1[2], v1[3]);
                    *(u32x4*)(rowp + bj * HALF) = w; } }
    }
};

__device__ __forceinline__ float row_rstd16(const float* ssq, int row, float eps) {
    const f32x4* p = (const f32x4*)(ssq + (size_t)row * 16);
    const f32x4 a = p[0], b = p[1], c = p[2], d = p[3];
    const float s = ((a[0] + a[1]) + (a[2] + a[3])) + ((b[0] + b[1]) + (b[2] + b[3])) + ((c[0] + c[1]) + (c[2] + c[3])) + ((d[0] + d[1]) + (d[2] + d[3]));
    return 1.0f / sqrtf(s * (1.0f / 1024.0f) + eps);
}
__device__ __forceinline__ void rows_rstd(const float* ssq, int row0, int fq, float eps, float (&rs)[2][4]) {
    f32x4 pp[2][4];
#pragma unroll
    for (int ai = 0; ai < 2; ++ai)
#pragma unroll
        for (int m = 0; m < 4; ++m) pp[ai][m] = *(const f32x4*)(ssq + (size_t)(row0 + ai * HALF + m * 16) * 16 + 4 * fq);
#pragma unroll
    for (int ai = 0; ai < 2; ++ai)
#pragma unroll
        for (int m = 0; m < 4; ++m) { float t = (pp[ai][m][0] + pp[ai][m][1]) + (pp[ai][m][2] + pp[ai][m][3]); t += __shfl_xor(t, 16); t += __shfl_xor(t, 32); rs[ai][m] = 1.0f / sqrtf(t * (1.0f / 1024.0f) + eps); }
}

constexpr int SSQ_LDS = 131072;
__device__ __forceinline__ void ssq_prefetch(const float* ssq, int pm, PG8_LAS unsigned char* lds, int wid, int lane) {
    const char* g = (const char*)(ssq + ((size_t)pm * BM + 32 * wid) * 16) + lane * 16;
#pragma unroll
    for (int i = 0; i < 2; ++i) __builtin_amdgcn_global_load_lds((const unsigned*)(g + i * 1024), (PG8_LAS unsigned*)(lds + SSQ_LDS + wid * 2048 + i * 1024), 16, 0, 0);
}
__device__ __forceinline__ void rows_rstd_lds(const PG8_LAS unsigned char* lds, int rt0  , int fq, float eps, float (&rs)[2][4]) {
    f32x4 pp[2][4];
#pragma unroll
    for (int ai = 0; ai < 2; ++ai)
#pragma unroll
        for (int m = 0; m < 4; ++m) pp[ai][m] = *(const PG8_LAS f32x4*)(lds + SSQ_LDS + (rt0 + ai * HALF + m * 16) * 64 + 16 * fq);
#pragma unroll
    for (int ai = 0; ai < 2; ++ai)
#pragma unroll
        for (int m = 0; m < 4; ++m) { float t = (pp[ai][m][0] + pp[ai][m][1]) + (pp[ai][m][2] + pp[ai][m][3]); t += __shfl_xor(t, 16); t += __shfl_xor(t, 32); rs[ai][m] = 1.0f / sqrtf(t * (1.0f / 1024.0f) + eps); }
}

struct EpiRes {
    static constexpr bool PERM = true, AFTER_DRAIN = false;
    __device__ __forceinline__ void prefetch(const Unit&, PG8_LAS unsigned char*, int, int) const {}
    const bf16_t* base; bf16_t* hb; float* ssq; const float* rscale;
    __device__ __forceinline__ void operator()(const f32x4 (&acc)[2][2][4][2], const Unit& u, int wr, int wc, int fr, int fq) const {
        const int row0 = u.pm * BM + wr * 64 + fr, col0 = u.pn * BM + wc * 32 + 8 * fq;
        u32x4 bb[2][4][2];
#pragma unroll
        for (int ai = 0; ai < 2; ++ai)
#pragma unroll
            for (int m = 0; m < 4; ++m) { const int row = row0 + ai * HALF + m * 16;
#pragma unroll
                for (int bj = 0; bj < 2; ++bj) bb[ai][m][bj] = *(const u32x4*)(base + (size_t)row * 1024 + col0 + bj * HALF); }
        __builtin_amdgcn_sched_barrier(0);
#pragma unroll
        for (int ai = 0; ai < 2; ++ai)
#pragma unroll
            for (int m = 0; m < 4; ++m) { const int row = row0 + ai * HALF + m * 16; const size_t off = (size_t)row * 1024 + col0; float ss = 0.f; const float r_ = rscale ? rscale[row] : 1.0f;
#pragma unroll
                for (int bj = 0; bj < 2; ++bj) { const u32x4 b4 = bb[ai][m][bj];
                    const f32x4 b0 = (f32x4){__builtin_bit_cast(float, b4.x << 16), __builtin_bit_cast(float, b4.x & 0xffff0000u), __builtin_bit_cast(float, b4.y << 16), __builtin_bit_cast(float, b4.y & 0xffff0000u)};
                    const f32x4 b1 = (f32x4){__builtin_bit_cast(float, b4.z << 16), __builtin_bit_cast(float, b4.z & 0xffff0000u), __builtin_bit_cast(float, b4.w << 16), __builtin_bit_cast(float, b4.w & 0xffff0000u)};
                    const f32x4 v0 = acc[ai][bj][m][0] + b0 * r_, v1 = acc[ai][bj][m][1] + b1 * r_;
                    ss += (v0[0] * v0[0] + v0[1] * v0[1]) + (v0[2] * v0[2] + v0[3] * v0[3]) + (v1[0] * v1[0] + v1[1] * v1[1]) + (v1[2] * v1[2] + v1[3] * v1[3]);
                    u32x4 w; w.x = cvt_pk_bf16(v0[0], v0[1]); w.y = cvt_pk_bf16(v0[2], v0[3]); w.z = cvt_pk_bf16(v1[0], v1[1]); w.w = cvt_pk_bf16(v1[2], v1[3]);
                    *(u32x4*)(hb + off + bj * HALF) = w; }
                ss += __shfl_xor(ss, 16); ss += __shfl_xor(ss, 32);
                if (fq == 0) ssq[(size_t)row * 16 + u.pn * 4 + wc] = ss; }
    }
};

struct EpiResF32 {
    static constexpr bool PERM = true, AFTER_DRAIN = false;
    __device__ __forceinline__ void prefetch(const Unit&, PG8_LAS unsigned char*, int, int) const {}
    const float* base; bf16_t* hb; float* ssq;
    __device__ __forceinline__ void operator()(const f32x4 (&acc)[2][2][4][2], const Unit& u, int wr, int wc, int fr, int fq) const {
        const int row0 = u.pm * BM + wr * 64 + fr, col0 = u.pn * BM + wc * 32 + 8 * fq;
#pragma unroll
        for (int ai = 0; ai < 2; ++ai) {
            f32x4 bb[4][2][2];
#pragma unroll
            for (int m = 0; m < 4; ++m) { const size_t off = (size_t)(row0 + ai * HALF + m * 16) * 1024 + col0;
#pragma unroll
                for (int bj = 0; bj < 2; ++bj) { bb[m][bj][0] = *(const f32x4*)(base + off + bj * HALF); bb[m][bj][1] = *(const f32x4*)(base + off + bj * HALF + 4); } }
            __builtin_amdgcn_sched_barrier(0);
#pragma unroll
            for (int m = 0; m < 4; ++m) { const int row = row0 + ai * HALF + m * 16; const size_t off = (size_t)row * 1024 + col0; float ss = 0.f;
#pragma unroll
                for (int bj = 0; bj < 2; ++bj) { const f32x4 v0 = acc[ai][bj][m][0] + bb[m][bj][0], v1 = acc[ai][bj][m][1] + bb[m][bj][1];
                    ss += (v0[0] * v0[0] + v0[1] * v0[1]) + (v0[2] * v0[2] + v0[3] * v0[3]) + (v1[0] * v1[0] + v1[1] * v1[1]) + (v1[2] * v1[2] + v1[3] * v1[3]);
                    u32x4 w; w.x = cvt_pk_bf16(v0[0], v0[1]); w.y = cvt_pk_bf16(v0[2], v0[3]); w.z = cvt_pk_bf16(v1[0], v1[1]); w.w = cvt_pk_bf16(v1[2], v1[3]);
                    *(u32x4*)(hb + off + bj * HALF) = w; }
                ss += __shfl_xor(ss, 16); ss += __shfl_xor(ss, 32);
                if (fq == 0) ssq[(size_t)row * 16 + u.pn * 4 + wc] = ss; }
            __builtin_amdgcn_sched_barrier(0);
        }
    }
};

struct EpiQ {
    static constexpr bool PERM = true, AFTER_DRAIN = false;
    bf16_t* q; const float* ssq; float eps, scale; PG8_LAS unsigned char* lds;
    __device__ __forceinline__ void prefetch(const Unit& u, PG8_LAS unsigned char* l, int wid, int lane) const { ssq_prefetch(ssq, u.pm, l, wid, lane); }
    __device__ __forceinline__ void operator()(const f32x4 (&acc)[2][2][4][2], const Unit& u, int wr, int wc, int fr, int fq) const {
        const int row0 = u.pm * BM + wr * 64 + fr, col0 = u.pn * BM + wc * 32 + 8 * fq;
        float rs8[2][4]; rows_rstd_lds(lds, wr * 64 + fr, fq, eps, rs8);
#pragma unroll
        for (int ai = 0; ai < 2; ++ai)
#pragma unroll
            for (int m = 0; m < 4; ++m) { const int row = row0 + ai * HALF + m * 16; const float rs = rs8[ai][m] * scale; bf16_t* rowp = q + (size_t)row * 1024 + col0;
#pragma unroll
                for (int bj = 0; bj < 2; ++bj) { const f32x4 v0 = acc[ai][bj][m][0] * rs, v1 = acc[ai][bj][m][1] * rs;
                    u32x4 w; w.x = cvt_pk_bf16(v0[0], v0[1]); w.y = cvt_pk_bf16(v0[2], v0[3]); w.z = cvt_pk_bf16(v1[0], v1[1]); w.w = cvt_pk_bf16(v1[2], v1[3]);
                    *(u32x4*)(rowp + bj * HALF) = w; } }
    }
};

typedef float f32x2cv_ __attribute__((ext_vector_type(2))); typedef __bf16 bf16x2cv_ __attribute__((ext_vector_type(2)));
__device__ __forceinline__ unsigned pk2f(float lo, float hi) { f32x2cv_ v = {lo, hi}; bf16x2cv_ b = __builtin_convertvector(v, bf16x2cv_); return __builtin_bit_cast(unsigned, b); }
typedef float f32x2e __attribute__((ext_vector_type(2)));
struct EpiGlu {
    static constexpr bool PERM = true, AFTER_DRAIN = false;
    bf16_t* act; const float* ssq; float eps; PG8_LAS unsigned char* lds;
    __device__ __forceinline__ void prefetch(const Unit& u, PG8_LAS unsigned char* l, int wid, int lane) const { ssq_prefetch(ssq, u.pm, l, wid, lane); }
    __device__ __forceinline__ void operator()(const f32x4 (&acc)[2][2][4][2], const Unit& u, int wr, int wc, int fr, int fq) const {
        const int row0 = u.pm * BM + wr * 64 + fr, col0 = u.pn * HALF + wc * 32 + 8 * fq;
        float rs8[2][4]; rows_rstd_lds(lds, wr * 64 + fr, fq, eps, rs8);
#pragma unroll
        for (int ai = 0; ai < 2; ++ai)
#pragma unroll
            for (int m = 0; m < 4; ++m) { const int row = row0 + ai * HALF + m * 16; const float rs = rs8[ai][m];
                const f32x2e c1 = {-1.4426950408889634f * rs, -1.4426950408889634f * rs}, c2 = {rs * rs, rs * rs}, one = {1.0f, 1.0f};
                unsigned wv[4];
#pragma unroll
                for (int n = 0; n < 2; ++n)
#pragma unroll
                    for (int hp = 0; hp < 2; ++hp) { const f32x2e g2 = {acc[ai][0][m][n][2 * hp], acc[ai][0][m][n][2 * hp + 1]}, u2 = {acc[ai][1][m][n][2 * hp], acc[ai][1][m][n][2 * hp + 1]};
                        const f32x2e t2 = g2 * c1; f32x2e e2; e2.x = __builtin_amdgcn_exp2f(t2.x); e2.y = __builtin_amdgcn_exp2f(t2.y);
                        const f32x2e d2 = e2 + one; f32x2e r2; r2.x = __builtin_amdgcn_rcpf(d2.x); r2.y = __builtin_amdgcn_rcpf(d2.y);
                        const f32x2e o2 = ((g2 * u2) * c2) * r2;
                        wv[2 * n + hp] = pk2f(o2.x, o2.y); }
                u32x4 w; w.x = wv[0]; w.y = wv[1]; w.z = wv[2]; w.w = wv[3];
                *(u32x4*)(act + (size_t)row * 2816 + col0) = w; }
    }
};
template <class Epi, class Sched, bool ALIGN_EPI = false, bool SP2 = false>
__device__ __forceinline__ void gemm_phase(PG8_LAS unsigned char* lds, const Gemm g, const Sched& S, const Epi& E) {
    const int tid = threadIdx.x, wid = __builtin_amdgcn_readfirstlane(tid >> 6), lane = tid & 63, wr = wid >> 2, wc = wid & 3, fr = lane & 15, fq = lane >> 4;
    const int K = g.K, nt = K / BK;
    unsigned voffA[2], voffB[2];
#pragma unroll
    for (int i = 0; i < 2; ++i) { int R, C; stage_rc(tid * 16 + i * 8192, R, C); const int Rb = Epi::PERM ? ((R & ~31) + perm32(R & 31)) : R;
        voffA[i] = (unsigned)(R * K + C) * 2u; voffB[i] = (unsigned)(Rb * K + C) * 2u; }
    const size_t kstep = (size_t)(BK * 2);
    const size_t hstep = (size_t)HALF * K * 2;
    const size_t tstep = 2 * hstep;
    const unsigned ldsw = (unsigned)wid * 1024u;
    const int aoff = lds_byte(wr * 64 + fr, fq * 8), boff = lds_byte(wc * 32 + fr, fq * 8);
#define PG8_SA(b, h) (((b) * 2 + (h)) * HTB)
#define PG8_SB(b, h) ((4 + (b) * 2 + (h)) * HTB)
#define PG8_STAGE(bufoff, gbase, voff) do { _Pragma("unroll") for (int _i = 0; _i < 2; ++_i) \
        __builtin_amdgcn_global_load_lds((const unsigned*)((const char*)(gbase) + (voff)[_i]), (PG8_LAS unsigned*)(lds + (bufoff) + ldsw + _i * 8192), 16, 0, 0); } while (0)
#define PG8_STAGEA(bufoff, gbase, voff) do { _Pragma("unroll") for (int _i = 0; _i < 2; ++_i) \
        __builtin_amdgcn_global_load_lds((const unsigned*)((const char*)(gbase) + (voff)[_i]), (PG8_LAS unsigned*)(lds + (bufoff) + ldsw + _i * 8192), 16, 0, Sched::A_AUX); } while (0)
#define PG8_LDA(dst, b, h) do { _Pragma("unroll") for (int m = 0; m < 4; ++m) _Pragma("unroll") for (int k = 0; k < 2; ++k) dst[m][k] = *(const PG8_LAS bf16x8*)(lds + PG8_SA(b, h) + aoff + m * 2048 + k * 1024); } while (0)
#define PG8_LDB(dst, b, h) do { _Pragma("unroll") for (int n = 0; n < 2; ++n) _Pragma("unroll") for (int k = 0; k < 2; ++k) dst[n][k] = *(const PG8_LAS bf16x8*)(lds + PG8_SB(b, h) + boff + n * 2048 + k * 1024); } while (0)
#define PG8_MMA(ai, bj, At, Bt) do { __builtin_amdgcn_s_setprio(1); _Pragma("unroll") for (int m = 0; m < 4; ++m) _Pragma("unroll") for (int n = 0; n < 2; ++n) _Pragma("unroll") for (int k = 0; k < 2; ++k) \
        acc[ai][bj][m][n] = __builtin_amdgcn_mfma_f32_16x16x32_bf16(Bt[n][k], At[m][k], acc[ai][bj][m][n], 0, 0, 0); __builtin_amdgcn_s_setprio(0); } while (0)
#define PG8_WAIT_V(n) asm volatile("s_waitcnt vmcnt(" #n ")" ::: "memory")
#define PG8_WAIT_L(n) asm volatile("s_waitcnt lgkmcnt(" #n ")" ::: "memory")
#define PG8_BAR __builtin_amdgcn_s_barrier()
#define PG8_SCHED __builtin_amdgcn_sched_barrier(0)
    Unit cur, nxt; int ui = 0;
    if (!S.next(0, cur)) return;
    f32x4 acc[2][2][4][2];
#pragma unroll
    for (int a = 0; a < 2; ++a)
#pragma unroll
        for (int b = 0; b < 2; ++b)
#pragma unroll
            for (int m = 0; m < 4; ++m)
#pragma unroll
                for (int n = 0; n < 2; ++n) acc[a][b][m][n] = (f32x4){0.f, 0.f, 0.f, 0.f};
    bf16x8 At[4][2], B0[2][2], B1[2][2];
    const char* cA = S.pa(g, cur, tstep); const char* cB = S.pb(g, cur, tstep);
    S.a_ready(cur);
    if constexpr (SP2) {
        PG8_STAGE(PG8_SB(0, 0), cB, voffB); PG8_STAGE(PG8_SB(0, 1), cB + hstep, voffB); PG8_STAGEA(PG8_SA(0, 0), cA, voffA); PG8_STAGEA(PG8_SA(0, 1), cA + hstep, voffA);
        if (wr == 1) PG8_BAR;
        PG8_WAIT_V(2); PG8_BAR;
        PG8_STAGE(PG8_SB(1, 0), cB + kstep, voffB); PG8_STAGEA(PG8_SA(1, 0), cA + kstep, voffA); PG8_STAGE(PG8_SB(1, 1), cB + hstep + kstep, voffB);
        PG8_WAIT_V(6); PG8_BAR;
    } else {
        PG8_STAGE(PG8_SB(0, 0), cB, voffB); PG8_STAGEA(PG8_SA(0, 0), cA, voffA); PG8_STAGE(PG8_SB(0, 1), cB + hstep, voffB); PG8_STAGEA(PG8_SA(0, 1), cA + hstep, voffA);
        if (wr == 1) PG8_BAR;
        PG8_WAIT_V(4); PG8_BAR;
        PG8_STAGE(PG8_SB(1, 0), cB + kstep, voffB); PG8_STAGEA(PG8_SA(1, 0), cA + kstep, voffA); PG8_STAGE(PG8_SB(1, 1), cB + hstep + kstep, voffB);
        PG8_WAIT_V(6); PG8_BAR;
    }
    for (;;) {
        const bool has_next = S.next(ui + 1, nxt);
        const char* nA = has_next ? S.pa(g, nxt, tstep) : cA; const char* nB = has_next ? S.pb(g, nxt, tstep) : cB;
        for (int t = 0; t < nt; t += 2) {
            const bool last = (t == nt - 2);
            const char* a1 = cA + (size_t)(t + 1) * kstep;
            const char* a2 = last ? nA : cA + (size_t)(t + 2) * kstep; const char* b2 = last ? nB : cB + (size_t)(t + 2) * kstep;
            const char* a3 = a2 + kstep; const char* b3 = b2 + kstep;
            if (last) E.prefetch(cur, lds, wid, lane);
            if (last && has_next) S.a_ready(nxt);
            if (t == 2) S.flush();
            if constexpr (SP2) {
            PG8_LDB(B0, 0, 0); PG8_LDB(B1, 0, 1); PG8_SCHED; PG8_LDA(At, 0, 0); PG8_STAGEA(PG8_SA(1, 1), a1 + hstep, voffA);
            PG8_WAIT_V(8); PG8_WAIT_L(0); PG8_BAR; PG8_MMA(0, 0, At, B0); PG8_MMA(0, 1, At, B1); PG8_BAR; PG8_SCHED;
            PG8_LDA(At, 0, 1); PG8_STAGE(PG8_SB(0, 0), b2, voffB); PG8_STAGE(PG8_SB(0, 1), b2 + hstep, voffB); PG8_STAGEA(PG8_SA(0, 0), a2, voffA);
            PG8_WAIT_V(8); PG8_WAIT_L(0); PG8_BAR; PG8_MMA(1, 0, At, B0); PG8_MMA(1, 1, At, B1); PG8_BAR; PG8_SCHED;
            PG8_LDB(B0, 1, 0); PG8_LDB(B1, 1, 1); PG8_SCHED; PG8_LDA(At, 1, 0); PG8_STAGEA(PG8_SA(0, 1), a2 + hstep, voffA);
            PG8_WAIT_V(8); PG8_WAIT_L(0); PG8_BAR; PG8_MMA(0, 0, At, B0); PG8_MMA(0, 1, At, B1); PG8_BAR; PG8_SCHED;
            PG8_LDA(At, 1, 1); PG8_STAGE(PG8_SB(1, 0), b3, voffB); PG8_STAGE(PG8_SB(1, 1), b3 + hstep, voffB); PG8_STAGEA(PG8_SA(1, 0), a3, voffA);
            PG8_WAIT_V(8); PG8_WAIT_L(0); PG8_BAR; PG8_MMA(1, 0, At, B0); PG8_MMA(1, 1, At, B1); PG8_BAR; PG8_SCHED;
            } else {
            PG8_LDB(B0, 0, 0); PG8_SCHED; PG8_LDA(At, 0, 0); PG8_STAGEA(PG8_SA(1, 1), a1 + hstep, voffA);
            PG8_WAIT_L(8); PG8_BAR; PG8_WAIT_L(0); PG8_MMA(0, 0, At, B0); PG8_BAR; PG8_SCHED;
            PG8_LDB(B1, 0, 1); PG8_STAGE(PG8_SB(0, 0), b2, voffB);
            PG8_BAR; PG8_WAIT_L(0); PG8_MMA(0, 1, At, B1); PG8_BAR;
            PG8_LDA(At, 0, 1); PG8_STAGEA(PG8_SA(0, 0), a2, voffA);
            PG8_BAR; PG8_WAIT_L(0); PG8_MMA(1, 0, At, B0); PG8_BAR; PG8_SCHED;
            PG8_STAGE(PG8_SB(0, 1), b2 + hstep, voffB);
            PG8_WAIT_V(6); PG8_BAR; PG8_MMA(1, 1, At, B1); PG8_BAR;
            PG8_LDB(B0, 1, 0); PG8_SCHED; PG8_LDA(At, 1, 0); PG8_STAGEA(PG8_SA(0, 1), a2 + hstep, voffA);
            PG8_WAIT_L(8); PG8_BAR; PG8_WAIT_L(0); PG8_MMA(0, 0, At, B0); PG8_BAR; PG8_SCHED;
            PG8_LDB(B1, 1, 1); PG8_STAGE(PG8_SB(1, 0), b3, voffB);
            PG8_BAR; PG8_WAIT_L(0); PG8_MMA(0, 1, At, B1); PG8_BAR;
            PG8_LDA(At, 1, 1); PG8_STAGEA(PG8_SA(1, 0), a3, voffA);
            PG8_BAR; PG8_WAIT_L(0); PG8_MMA(1, 0, At, B0); PG8_BAR; PG8_SCHED;
            PG8_STAGE(PG8_SB(1, 1), b3 + hstep, voffB);
            PG8_WAIT_V(6); PG8_BAR; PG8_MMA(1, 1, At, B1); PG8_BAR;
            }
        }
        if constexpr (ALIGN_EPI) { if (wr == 0) PG8_BAR; }
        if constexpr (!Epi::AFTER_DRAIN) { E(acc, cur, wr, wc, fr, fq); S.done(cur); }
        if (!has_next) break;
#pragma unroll
        for (int a = 0; a < 2; ++a)
#pragma unroll
            for (int b = 0; b < 2; ++b)
#pragma unroll
                for (int m = 0; m < 4; ++m)
#pragma unroll
                    for (int n = 0; n < 2; ++n) { typedef double d2v_ __attribute__((ext_vector_type(2))); double z0_, z1_;
                        asm volatile("v_mov_b64 %0, 0\n\tv_mov_b64 %1, 0" : "=v"(z0_), "=v"(z1_));
                        acc[a][b][m][n] = __builtin_bit_cast(f32x4, (d2v_){z0_, z1_}); }
        cur = nxt; cA = nA; cB = nB; ++ui;
        if constexpr (ALIGN_EPI) { if (wr == 1) PG8_BAR; }
    }
    PG8_WAIT_V(0);
    S.flush();
    if constexpr (!ALIGN_EPI) { if (wr == 0) PG8_BAR; }
    PG8_BAR;
    if constexpr (Epi::AFTER_DRAIN) { E.fused(acc, cur, wr, wc, fr, fq, lds, wid, lane); S.done(cur); }
#undef PG8_SA
#undef PG8_SB
#undef PG8_STAGE
#undef PG8_STAGEA
#undef PG8_LDA
#undef PG8_LDB
#undef PG8_MMA
#undef PG8_WAIT_V
#undef PG8_WAIT_L
#undef PG8_BAR
#undef PG8_SCHED
}
}
#define GAS __attribute__((address_space(1)))
#define LAS __attribute__((address_space(3)))
typedef unsigned short bf16;
typedef unsigned v4u __attribute__((ext_vector_type(4)));
typedef float f32x4 __attribute__((ext_vector_type(4)));
typedef short bf16x8 __attribute__((ext_vector_type(8)));
typedef GAS unsigned gu32;
typedef GAS unsigned long long gu64;
#define RLX_AGENT __ATOMIC_RELAXED, __HIP_MEMORY_SCOPE_AGENT
#define LDS_WAIT() asm volatile("s_waitcnt lgkmcnt(0)" ::: "memory")
#define VM_WAIT() asm volatile("s_waitcnt vmcnt(0)" ::: "memory")
__device__ __forceinline__ unsigned long long rt() { return __builtin_amdgcn_s_memrealtime(); }
typedef float f32x2_cv __attribute__((ext_vector_type(2))); typedef __bf16 bf16x2_cv __attribute__((ext_vector_type(2)));
__device__ __forceinline__ unsigned pk2(float lo, float hi) { f32x2_cv v = {lo, hi}; bf16x2_cv b = __builtin_convertvector(v, bf16x2_cv); return __builtin_bit_cast(unsigned, b); }
__device__ __forceinline__ unsigned f2bf(float f) { return pk2(f, 0.f) & 0xffffu; }

#define XB_TMO      128
#define XB_XCNT(j)  (256  + 64 * (j))
#define XB_XSUB(j)  (1280 + 64 * (j))
#define XB_XGEN(j)  (2304 + 64 * (j))
#define XB_TOP      3328
#define XB_TOPGEN   3392
#define XCD_BAR_WORDS 3456
#define XB_SPIN_CAP (1u << 18)

__device__ __forceinline__ unsigned xb_ld(unsigned* p)              { return __hip_atomic_load(p, __ATOMIC_RELAXED, __HIP_MEMORY_SCOPE_AGENT); }
__device__ __forceinline__ unsigned xb_add(unsigned* p, unsigned v) { return __hip_atomic_fetch_add(p, v, __ATOMIC_RELAXED, __HIP_MEMORY_SCOPE_AGENT); }
__device__ __forceinline__ unsigned xb_xcc_id() { return (unsigned)__builtin_amdgcn_s_getreg((3 << 11) | 20) & 0xFu; }
#define XB_SPIN(cond, bar) do { unsigned _sp = 0; while (cond) { __builtin_amdgcn_s_sleep(1); \
    if ((++_sp & 255u) == 0u) { if (xb_ld(&(bar)[XB_TMO])) break; if (_sp > XB_SPIN_CAP) { atomicAdd(&(bar)[XB_TMO], 1u); break; } } } } while (0)

struct XcdBarrier {
    unsigned* bar; unsigned x;
    volatile LAS unsigned* st;
};

__device__ __forceinline__ XcdBarrier xcd_barrier_post(unsigned* bar, volatile LAS unsigned* st) {
    XcdBarrier b; b.bar = bar; b.x = xb_xcc_id(); b.st = st;
    if (threadIdx.x == 0) (void)xb_add(&bar[XB_XCNT(b.x)], 1u);
    return b;
}
__device__ __forceinline__ void xcd_barrier_complete(unsigned* bar, unsigned x, unsigned& nloc, unsigned& nx) {
    const unsigned G = gridDim.x * gridDim.y * gridDim.z;
    unsigned sum, cnt, mine, sp = 0u;
    for (;;) {
        sum = 0u; cnt = 0u; mine = 0u;
#pragma unroll
        for (unsigned j = 0; j < 16; ++j) { const unsigned c = xb_ld(&bar[XB_XCNT(j)]); sum += c; cnt += (c > 0u) ? 1u : 0u; mine = (j == x) ? c : mine; }
        if (sum == G) break;
        __builtin_amdgcn_s_sleep(1);
        if ((++sp & 255u) == 0u) { if (xb_ld(&bar[XB_TMO])) break; if (sp > XB_SPIN_CAP) { atomicAdd(&bar[XB_TMO], 1u); break; } }
    }
    nloc = mine > 0u ? mine : 1u; nx = cnt > 0u ? cnt : 1u;
}

__device__ __forceinline__ void xcd_barrier(const XcdBarrier& b) {
    asm volatile("s_waitcnt vmcnt(0)" ::: "memory");
    __syncthreads();
    if (threadIdx.x == 0) {
        unsigned* bar = b.bar;
        __builtin_amdgcn_s_waitcnt(0);
        unsigned nloc = b.st[0], nx = b.st[1];
        if (nloc == 0u) { xcd_barrier_complete(bar, b.x, nloc, nx); b.st[0] = nloc; b.st[1] = nx; }
        const unsigned old = xb_add(&bar[XB_XSUB(b.x)], 1u);
        const unsigned gen = old / nloc;
        if (old + 1u == (gen + 1u) * nloc) {
            __builtin_amdgcn_fence(__ATOMIC_RELEASE, "agent");
            asm volatile("s_waitcnt vmcnt(0)" ::: "memory");
            const unsigned og = xb_add(&bar[XB_TOP], 1u);
            const unsigned tg = og / nx;
            if (og + 1u == (tg + 1u) * nx) xb_add(&bar[XB_TOPGEN], 1u);
            else XB_SPIN(xb_ld(&bar[XB_TOPGEN]) == tg, bar);
            __builtin_amdgcn_fence(__ATOMIC_ACQUIRE, "agent");
            xb_add(&bar[XB_XGEN(b.x)], 1u);
            asm volatile("s_waitcnt vmcnt(0)" ::: "memory");
        } else {
            XB_SPIN(xb_ld(&bar[XB_XGEN(b.x)]) == gen, bar);
            __builtin_amdgcn_fence(__ATOMIC_ACQUIRE, "agent");
            asm volatile("s_waitcnt vmcnt(0)" ::: "memory");
        }
    }
    __syncthreads();
}

__device__ __forceinline__ void xcd_barrier_local(const XcdBarrier& b) {
    asm volatile("s_waitcnt vmcnt(0)" ::: "memory");
    __syncthreads();
    if (threadIdx.x == 0) {
        unsigned* bar = b.bar;
        __builtin_amdgcn_s_waitcnt(0);
        const unsigned nloc = b.st[0];
        const unsigned old = xb_add(&bar[XB_XSUB(b.x)], 1u);
        const unsigned gen = old / nloc;
        if (old + 1u == (gen + 1u) * nloc) xb_add(&bar[XB_XGEN(b.x)], 1u);
        else XB_SPIN(xb_ld(&bar[XB_XGEN(b.x)]) == gen, bar);
        __builtin_amdgcn_fence(__ATOMIC_ACQUIRE, "agent");
        asm volatile("s_waitcnt vmcnt(0)" ::: "memory");
    }
    __syncthreads();
}

namespace pg8 {
constexpr int CH_STRIDE = 32;
__device__ __forceinline__ int ch_word(int stage, int pm) { return CH_STRIDE * (128 * stage + pm); }
__device__ __forceinline__ bool ch_lane0() { return __builtin_amdgcn_mbcnt_hi(~0u, __builtin_amdgcn_mbcnt_lo(~0u, 0u)) == 0u; }
__device__ __forceinline__ void ch_wait(unsigned* w, unsigned need, unsigned* tmo) {
    unsigned sp = 0;
    while ((unsigned)__builtin_amdgcn_readfirstlane(__hip_atomic_load(w, __ATOMIC_RELAXED, __HIP_MEMORY_SCOPE_AGENT)) < need) {
        __builtin_amdgcn_s_sleep(1);
        if ((++sp & 255u) == 0u) { if (__builtin_amdgcn_readfirstlane(__hip_atomic_load(tmo, __ATOMIC_RELAXED, __HIP_MEMORY_SCOPE_AGENT)) != 0u) break; if (sp > XB_SPIN_CAP) { if (ch_lane0()) atomicAdd(tmo, 1u); break; } }
    }
}
constexpr int CH_LDS_ARRIVE = 163840 - 256 + 48;
__device__ __forceinline__ void ch_arrive(unsigned* w, bool colo) {
    if (colo) { if (ch_lane0()) (void)__hip_atomic_fetch_add(w, 1u, __ATOMIC_RELAXED, __HIP_MEMORY_SCOPE_AGENT); }
    else {
        unsigned old = 0u;
        if (ch_lane0()) old = __hip_atomic_fetch_add((LAS unsigned*)CH_LDS_ARRIVE, 1u, __ATOMIC_RELAXED, __HIP_MEMORY_SCOPE_WORKGROUP);
        old = (unsigned)__builtin_amdgcn_readfirstlane(old);
        if ((old & 7u) == 7u) { __builtin_amdgcn_fence(__ATOMIC_RELEASE, "agent"); asm volatile("s_waitcnt vmcnt(0)" ::: "memory");
            if (ch_lane0()) (void)__hip_atomic_fetch_add(w, 8u, __ATOMIC_RELAXED, __HIP_MEMORY_SCOPE_AGENT); }
    }
}
__device__ __forceinline__ void ch_publish_now(unsigned* w, bool colo) {
    asm volatile("s_waitcnt vmcnt(0)" ::: "memory");
    ch_arrive(w, colo);
}
struct ChainHooks {
    static constexpr int A_AUX = 0;
    unsigned* chn; unsigned* tmo; bool colo; int wave;
    int wait_k0, wait_k1, pub_k0, pub_k1; unsigned need0, need1;
    mutable int pend, acq;
    __device__ __forceinline__ void hooks_init(unsigned* chn_, unsigned* tmo_, bool colo_, int wave_) { chn = chn_; tmo = tmo_; colo = colo_; wave = wave_; pend = -1; acq = -1; }
    __device__ __forceinline__ void a_ready(const Unit& u) const {
        const int k = u.ph ? wait_k1 : wait_k0; if (k < 0) return;
        const int w = ch_word(k, u.pm); if (w == acq) return;
        acq = w;
        if (wave == 0) {
            ch_wait(chn + w, u.ph ? need1 : need0, tmo);
            if (!colo) { __builtin_amdgcn_fence(__ATOMIC_ACQUIRE, "agent"); asm volatile("s_waitcnt vmcnt(0)" ::: "memory"); }
        }
        asm volatile("" ::: "memory"); __builtin_amdgcn_s_barrier(); asm volatile("" ::: "memory");
    }
    __device__ __forceinline__ void done(const Unit& u) const {
        const int k = u.ph ? pub_k1 : pub_k0; if (k < 0) return;
        const int w = ch_word(k, u.pm);
        if (colo) pend = w; else ch_publish_now(chn + w, false);
    }
    __device__ __forceinline__ void flush() const {
        if (pend >= 0) { if (ch_lane0()) (void)__hip_atomic_fetch_add(chn + pend, 1u, __ATOMIC_RELAXED, __HIP_MEMORY_SCOPE_AGENT); pend = -1; }
    }
};
template <class O0, class O1> struct StreamOrder : ChainHooks {
    O0 o0; O1 o1; int n0; const bf16_t* A1; const bf16_t* B1;
    __device__ __forceinline__ void count0() { n0 = 0; Unit t; while (o0.next(n0, t)) ++n0; }
    __device__ __forceinline__ bool next(int i, Unit& u) const { if (i < n0) { u.ph = 0; return o0.next(i, u); } u.ph = 1; return o1.next(i - n0, u); }
    __device__ __forceinline__ const char* pa(const Gemm& g, const Unit& u, size_t tstep) const { return (const char*)(u.ph ? A1 : g.A) + (size_t)u.pm * tstep; }
    __device__ __forceinline__ const char* pb(const Gemm& g, const Unit& u, size_t tstep) const { return (const char*)(u.ph ? B1 : g.Bt) + (size_t)u.pn * tstep; }
};
struct ChainOrder : ChainHooks {
    StaticOrder so;
    __device__ __forceinline__ bool next(int i, Unit& u) const { u.ph = 0; return so.next(i, u); }
    __device__ __forceinline__ const char* pa(const Gemm& g, const Unit& u, size_t tstep) const { return (const char*)g.A + (size_t)u.pm * tstep; }
    __device__ __forceinline__ const char* pb(const Gemm& g, const Unit& u, size_t tstep) const { return (const char*)g.Bt + (size_t)u.pn * tstep; }
};
template <int N> __device__ __forceinline__ void ch_wait_n(unsigned* w0, int stride, unsigned need, unsigned* tmo, bool colo) {
    unsigned v[N];
#pragma unroll
    for (int k = 0; k < N; ++k) v[k] = __hip_atomic_load(w0 + stride * k, __ATOMIC_RELAXED, __HIP_MEMORY_SCOPE_AGENT);
    bool ok = true;
#pragma unroll
    for (int k = 0; k < N; ++k) ok = ok && ((unsigned)__builtin_amdgcn_readfirstlane(v[k]) >= need);
    if (!ok) {
#pragma unroll 1
        for (int k = 0; k < N; ++k) ch_wait(w0 + stride * k, need, tmo); }
    if (!colo) { __builtin_amdgcn_fence(__ATOMIC_ACQUIRE, "agent"); asm volatile("s_waitcnt vmcnt(0)" ::: "memory"); }
}
struct Order2C : ChainHooks {
    Order2 o;
    __device__ __forceinline__ bool next(int i, Unit& u) const { u.ph = 0; return o.next(i, u); }
    __device__ __forceinline__ const char* pa(const Gemm& g, const Unit& u, size_t tstep) const { return (const char*)g.A + (size_t)u.pm * tstep; }
    __device__ __forceinline__ const char* pb(const Gemm& g, const Unit& u, size_t tstep) const { return (const char*)g.Bt + (size_t)u.pn * tstep; }
};
template <class E0, class E1> struct EpiPair {
    static constexpr bool PERM = E0::PERM, AFTER_DRAIN = false;
    static_assert(E0::PERM == E1::PERM && !E0::AFTER_DRAIN && !E1::AFTER_DRAIN, "EpiPair");
    E0 e0; E1 e1;
    __device__ __forceinline__ void prefetch(const Unit& u, PG8_LAS unsigned char* l, int wid, int lane) const { if (u.ph == 0) e0.prefetch(u, l, wid, lane); else e1.prefetch(u, l, wid, lane); }
    __device__ __forceinline__ void operator()(const f32x4 (&acc)[2][2][4][2], const Unit& u, int wr, int wc, int fr, int fq) const {
        if (u.ph == 0) e0(acc, u, wr, wc, fr, fq); else e1(acc, u, wr, wc, fr, fq);
    }
};
}

namespace pg8 {
struct EpiResNorm {
    static constexpr bool PERM = true, AFTER_DRAIN = false;
    __device__ __forceinline__ void prefetch(const Unit&, PG8_LAS unsigned char*, int, int) const {}
    const bf16_t* base; float* out; float* ssq; const float* gain; float eps;
    unsigned* chn; unsigned* tmo; bool colo, ychk;
    __device__ __forceinline__ void operator()(const f32x4 (&acc)[2][2][4][2], const Unit& u, int wr, int wc, int fr, int fq) const {
        const int row0 = u.pm * BM + wr * 64 + fr, col0 = u.pn * BM + wc * 32 + 8 * fq;
        u32x4 bb[2][4][2];
#pragma unroll
        for (int ai = 0; ai < 2; ++ai)
#pragma unroll
            for (int m = 0; m < 4; ++m) { const int row = row0 + ai * HALF + m * 16;
#pragma unroll
                for (int bj = 0; bj < 2; ++bj) bb[ai][m][bj] = *(const u32x4*)(base + (size_t)row * 1024 + col0 + bj * HALF); }
        __builtin_amdgcn_sched_barrier(0);
        f32x4 v[2][4][2][2];
#pragma unroll
        for (int ai = 0; ai < 2; ++ai)
#pragma unroll
            for (int m = 0; m < 4; ++m) { const int row = row0 + ai * HALF + m * 16; float ss = 0.f;
#pragma unroll
                for (int bj = 0; bj < 2; ++bj) { const u32x4 b4 = bb[ai][m][bj];
                    const f32x4 b0 = (f32x4){__builtin_bit_cast(float, b4.x << 16), __builtin_bit_cast(float, b4.x & 0xffff0000u), __builtin_bit_cast(float, b4.y << 16), __builtin_bit_cast(float, b4.y & 0xffff0000u)};
                    const f32x4 b1 = (f32x4){__builtin_bit_cast(float, b4.z << 16), __builtin_bit_cast(float, b4.z & 0xffff0000u), __builtin_bit_cast(float, b4.w << 16), __builtin_bit_cast(float, b4.w & 0xffff0000u)};
                    const f32x4 v0 = acc[ai][bj][m][0] + b0, v1 = acc[ai][bj][m][1] + b1;
                    ss += (v0[0] * v0[0] + v0[1] * v0[1]) + (v0[2] * v0[2] + v0[3] * v0[3]) + (v1[0] * v1[0] + v1[1] * v1[1]) + (v1[2] * v1[2] + v1[3] * v1[3]);
                    v[ai][m][bj][0] = v0; v[ai][m][bj][1] = v1; }
                ss += __shfl_xor(ss, 16); ss += __shfl_xor(ss, 32);
                if (fq == 0) ssq[(size_t)row * 16 + u.pn * 4 + wc] = ss; }
        unsigned* w = chn + ch_word(4, u.pm);
        ch_publish_now(w, colo);
        ch_wait(w, 32u, tmo);
        if (ychk && u.pm < 64) ch_wait(chn + ch_word(5, u.pm >> 3), 32u, tmo);
        if (u.pm >= 64) { ch_wait(chn + ch_word(2, 2 * (u.pm - 64)), 32u, tmo); ch_wait(chn + ch_word(2, 2 * (u.pm - 64) + 1), 32u, tmo); }
        if (!colo) { __builtin_amdgcn_fence(__ATOMIC_ACQUIRE, "agent"); asm volatile("s_waitcnt vmcnt(0)" ::: "memory"); }
        float rs8[2][4]; rows_rstd(ssq, row0, fq, eps, rs8);
        f32x4 gv[2][2];
#pragma unroll
        for (int bj = 0; bj < 2; ++bj) { gv[bj][0] = *(const f32x4*)(gain + col0 + bj * HALF); gv[bj][1] = *(const f32x4*)(gain + col0 + bj * HALF + 4); }
#pragma unroll
        for (int ai = 0; ai < 2; ++ai)
#pragma unroll
            for (int m = 0; m < 4; ++m) { const int row = row0 + ai * HALF + m * 16; float* o = out + (size_t)row * 1024 + col0; const float rs = rs8[ai][m];
#pragma unroll
                for (int bj = 0; bj < 2; ++bj) { *(f32x4*)(o + bj * HALF) = v[ai][m][bj][0] * rs * gv[bj][0]; *(f32x4*)(o + bj * HALF + 4) = v[ai][m][bj][1] * rs * gv[bj][1]; } }
    }
};
}

__device__ __forceinline__ void wsplit_arrive(const XcdBarrier& b, unsigned* wb) {
    asm volatile("s_waitcnt vmcnt(0)" ::: "memory");
    __syncthreads();
    if (threadIdx.x == 0) {
        const unsigned nloc = b.st[0];
        const unsigned old = xb_add(&wb[64 * b.x], 1u);
        if (old + 1u == nloc) { __builtin_amdgcn_fence(__ATOMIC_RELEASE, "agent"); asm volatile("s_waitcnt vmcnt(0)" ::: "memory"); xb_add(&wb[64 * 16], 1u); }
    }
}
__device__ __forceinline__ void wsplit_wait(const XcdBarrier& b, unsigned* wb) {
    if (threadIdx.x == 0) {
        const unsigned nx = b.st[1];
        XB_SPIN(xb_ld(&wb[64 * 16]) < nx, b.bar);
        __builtin_amdgcn_fence(__ATOMIC_ACQUIRE, "agent"); asm volatile("s_waitcnt vmcnt(0)" ::: "memory");
    }
    __syncthreads();
}

typedef float f32x2 __attribute__((ext_vector_type(2)));
typedef unsigned u32x2v __attribute__((ext_vector_type(2)));
constexpr int NWAVES = 8;
constexpr int BATCH = 16, SEQ = 2048, DM = 1024, M = BATCH * SEQ;
constexpr int MEMT = 256, MM = BATCH * MEMT;
constexpr int DIN = 3848, NZM = 2048, NZR = 1792, NZ = NZM + NZR;
constexpr int DFF = 2816;
constexpr float EPS = 1e-6f, RWKV_LN_EPS = 64e-5f;
constexpr float LOG2E = 1.4426950408889634f;

constexpr size_t MiB = 1u << 20;
constexpr size_t WS_CTL = 0, CTL_ZERO_BYTES = 320 * 1024;
constexpr size_t WS_ZG = 1 * MiB;
constexpr size_t WS_SSQ1 = 2 * MiB, WS_SSQ2 = 4 * MiB, WS_SSQ3 = 6 * MiB;
constexpr size_t WS_RMS = 43 * MiB + 512 * 1024;
constexpr size_t WS_WIN = 8 * MiB;
constexpr size_t WS_WKV = WS_WIN + (size_t)NZ * DM * 2;
constexpr size_t WS_WMIX = 20 * MiB, WS_WQ = 22 * MiB, WS_WO = 24 * MiB, WS_WGU = 26 * MiB  , WS_WD = 37 * MiB  ;
constexpr size_t WS_LORA = 43 * MiB;
constexpr size_t WS_KV = 44 * MiB;
constexpr size_t WS_XN = 60 * MiB;
constexpr size_t WS_MN = WS_XN + (size_t)M * DM * 2;
constexpr size_t WS_ZM = 132 * MiB;
constexpr size_t WS_ZR = 260 * MiB;
constexpr size_t WS_H1B = WS_XN;
constexpr size_t OUT_QO = 64 * MiB;
constexpr size_t WS_OB = WS_ZR + 64 * MiB;
constexpr size_t WS_H2B = WS_XN;
constexpr size_t WS_H3B = WS_XN;
constexpr size_t WS_ACT = WS_ZR + 64 * MiB;
constexpr size_t WS_E = 372 * MiB, WS_AL = 436 * MiB, WS_GG = 468 * MiB;
constexpr size_t WS_END = 500 * MiB;
static_assert(WS_WKV + (size_t)2048 * DM * 2 <= WS_WMIX && WS_WD + (size_t)DM * DFF * 2 <= WS_LORA && WS_MN + (size_t)MM * DM * 2 <= WS_ZM && WS_ZR + (size_t)M * NZR * 2 <= WS_END && WS_ACT + (size_t)M * DFF * 2 <= WS_END, "d_ws map");
constexpr int CW_BAR = 1024;
constexpr int CW_CHN = 16384;
constexpr int CW_WSP = 9216;
constexpr int CW_GRP = 8192;

constexpr int LDS_BYTES = 163840;
constexpr int MISC_OFF = LDS_BYTES - 256; static_assert(pg8::CH_LDS_ARRIVE == LDS_BYTES - 256 + 48, "p3_chain's LDS arrival word is MISC[12]");
constexpr int MISC_OFF_ = MISC_OFF;

__device__ __forceinline__ float bf2f(unsigned short h) { return __builtin_bit_cast(float, (unsigned)h << 16); }
__device__ __forceinline__ float bflo(unsigned w) { return __builtin_bit_cast(float, w << 16); }
__device__ __forceinline__ float bfhi(unsigned w) { return __builtin_bit_cast(float, w & 0xffff0000u); }
__device__ __forceinline__ float sigmoidf_(float x) { return __builtin_amdgcn_rcpf(1.0f + __builtin_amdgcn_exp2f(-LOG2E * x)); }
__device__ __forceinline__ float expf_(float x) { return __builtin_amdgcn_exp2f(LOG2E * x); }
__device__ __forceinline__ float wave_sum(float v) {
#pragma unroll
    for (int o = 1; o < 64; o <<= 1) v += __shfl_xor(v, o);
    return v;
}
template <int CTRL> __device__ __forceinline__ float dpp_f(float v) { return __builtin_bit_cast(float, __builtin_amdgcn_update_dpp(0, __builtin_bit_cast(int, v), CTRL, 0xF, 0xF, false)); }
__device__ __forceinline__ float row16_sum(float v) { v += dpp_f<0xB1>(v); v += dpp_f<0x4E>(v); v += dpp_f<0x141>(v); v += dpp_f<0x140>(v); return v; }
__device__ __forceinline__ float row8_sum(float v) { v += dpp_f<0xB1>(v); v += dpp_f<0x4E>(v); v += dpp_f<0x141>(v); return v; }

struct InPtrs {
    const float* const __attribute__((address_space(4)))* p;
    __device__ __forceinline__ const float* operator[](int i) const { const float* const __attribute__((address_space(4)))* q = p; asm volatile("" : "+s"(q)); return q[i]; }
};
struct Frame {
    LAS unsigned char* lds;
    int tid, lane, wave, vcu, G; bool colo;
    InPtrs in; float* out; unsigned char* ws;
};

__device__ __forceinline__ void transpose_item(const float* W, int ldw, int src_col0, bf16* WT, int K, int dst_row0, const float* kscale, int k0, LAS float* scr, int lane) {
    float v[32], sc[32];
    const float* wp = W + (size_t)(k0 + (lane >> 5)) * ldw + src_col0 + (lane & 31);
#pragma unroll
    for (int i = 0; i < 32; ++i) v[i] = wp[(size_t)(2 * i) * ldw];
    if (kscale) {
#pragma unroll
        for (int i = 0; i < 32; ++i) sc[i] = kscale[k0 + 2 * i + (lane >> 5)];
#pragma unroll
        for (int i = 0; i < 32; ++i) v[i] *= sc[i]; }
#pragma unroll
    for (int i = 0; i < 32; ++i) scr[(2 * i + (lane >> 5)) * 33 + (lane & 31)] = v[i];
    LDS_WAIT(); asm volatile("" ::: "memory");
    const int c = lane & 7;
#pragma unroll
    for (int j = 0; j < 4; ++j) { const int n = (lane >> 3) + 8 * j; const LAS float* s = scr + (8 * c) * 33 + n;
        v4u o; o.x = pk2(s[0 * 33], s[1 * 33]); o.y = pk2(s[2 * 33], s[3 * 33]); o.z = pk2(s[4 * 33], s[5 * 33]); o.w = pk2(s[6 * 33], s[7 * 33]);
        *(GAS v4u*)(WT + (size_t)(dst_row0 + n) * K + k0 + 8 * c) = o; }
    LDS_WAIT(); asm volatile("" ::: "memory");
}

constexpr int I_WIN = 120 * 16, I_WKV = 64 * 16, I_L64 = 16, I_L128 = 32, I_SQ = 32 * 16, I_WGU = 176 * 16, I_WD = 32 * 44;
constexpr int W_EARLY = I_WIN + I_WKV + 2 * I_L64 + I_L128, W_ALL = W_EARLY + 3 * I_SQ + I_WGU + I_WD;
__device__ __forceinline__ void weight_item(Frame& F, int it, LAS float* scr) {
    unsigned char* ws = F.ws; int r = it;
    if (r < I_WIN) { const int seg = r >> 4, kb = r & 15, n0 = seg * 32; transpose_item(F.in[3], DIN, n0 < 2048 ? n0 : n0 + 8, (bf16*)(ws + WS_WIN), 1024, n0, F.in[2], kb * 64, scr, F.lane); return; } r -= I_WIN;
    if (r < I_WKV) { const int seg = r >> 4, kb = r & 15; transpose_item(F.in[23], 2048, seg * 32, (bf16*)(ws + WS_WKV), 1024, seg * 32, F.in[21], kb * 64, scr, F.lane); return; } r -= I_WKV;
    if (r < I_L64) { transpose_item(F.in[10], 512, r * 32, (bf16*)(ws + WS_LORA), 64, r * 32, nullptr, 0, scr, F.lane); return; } r -= I_L64;
    if (r < I_L64) { transpose_item(F.in[12], 512, r * 32, (bf16*)(ws + WS_LORA) + 512 * 64, 64, r * 32, nullptr, 0, scr, F.lane); return; } r -= I_L64;
    if (r < I_L128) { const int seg = r >> 1, kb = r & 1; transpose_item(F.in[13], 512, seg * 32, (bf16*)(ws + WS_LORA) + 2 * 512 * 64, 128, seg * 32, nullptr, kb * 64, scr, F.lane); return; } r -= I_L128;
    if (r < I_SQ) { const int seg = r >> 4, kb = r & 15; transpose_item(F.in[19], 1024, seg * 32, (bf16*)(ws + WS_WMIX), 1024, seg * 32, nullptr, kb * 64, scr, F.lane); return; } r -= I_SQ;
    if (r < I_SQ) { const int seg = r >> 4, kb = r & 15; transpose_item(F.in[22], 1024, seg * 32, (bf16*)(ws + WS_WQ), 1024, seg * 32, F.in[20], kb * 64, scr, F.lane); return; } r -= I_SQ;
    if (r < I_SQ) { const int seg = r >> 4, kb = r & 15; transpose_item(F.in[24], 1024, seg * 32, (bf16*)(ws + WS_WO), 1024, seg * 32, nullptr, kb * 64, scr, F.lane); return; } r -= I_SQ;
    if (r < I_WGU) { const int seg = r >> 4, kb = r & 15, r0 = seg * 32, blk = r0 >> 8, within = r0 & 255;
        transpose_item(within < 128 ? F.in[26] : F.in[27], DFF, blk * 128 + (within & 127), (bf16*)(ws + WS_WGU), 1024, r0, F.in[25], kb * 64, scr, F.lane); return; } r -= I_WGU;
    { const int seg = r / 44, kb = r % 44; transpose_item(F.in[28], 1024, seg * 32, (bf16*)(ws + WS_WD), DFF, seg * 32, nullptr, kb * 64, scr, F.lane); }
}
__device__ __forceinline__ void late_weights(Frame& F, int wg, int nwg) {
    LAS float* scr = (LAS float*)(F.lds + F.wave * 8704);
    for (int it = W_EARLY + wg * NWAVES + F.wave; it < W_ALL; it += nwg * NWAVES) weight_item(F, it, scr);
}
__device__ __forceinline__ void p0_row(Frame& F, LAS float* GW, unsigned char* ws, int m, bool is_x, f32x4 (&v)[4], float s) {
        const float rms = sqrtf(wave_sum(s) * (1.f / DM) + EPS), rstd = 1.f / rms;
        if (is_x && F.lane == 0) ((float*)(ws + WS_RMS))[m] = rms;
#pragma unroll
        for (int j = 0; j < 4; ++j) v[j] = v[j] * rstd;
        GAS unsigned long long* o8 = (GAS unsigned long long*)((bf16*)(ws + WS_XN) + (size_t)m * DM) + F.lane;
#pragma unroll
        for (int j = 0; j < 4; ++j) o8[64 * j] = (unsigned long long)pk2(v[j].x, v[j].y) | ((unsigned long long)pk2(v[j].z, v[j].w) << 32);
        if (is_x) {
            float g8[8];
#pragma unroll
            for (int q = 0; q < 8; ++q) { float a = 0.f;
#pragma unroll
                for (int j = 0; j < 4; ++j) { const f32x4 w = *(const LAS f32x4*)(GW + q * 1024 + 256 * j + 4 * F.lane); a += (v[j].x * w.x + v[j].y * w.y) + (v[j].z * w.z + v[j].w * w.w); }
                g8[q] = a; }
#pragma unroll
            for (int q = 0; q < 4; ++q) { const bool up = F.lane & 32; const float keep = up ? g8[q + 4] : g8[q], send = up ? g8[q] : g8[q + 4]; g8[q] = keep + __shfl_xor(send, 32); }
#pragma unroll
            for (int q = 0; q < 2; ++q) { const bool up = F.lane & 16; const float keep = up ? g8[q + 2] : g8[q], send = up ? g8[q] : g8[q + 2]; g8[q] = keep + __shfl_xor(send, 16); }
            { const bool up = F.lane & 8; const float keep = up ? g8[1] : g8[0], send = up ? g8[0] : g8[1]; g8[0] = keep + __shfl_xor(send, 8); }
            g8[0] = row8_sum(g8[0]);
            if ((F.lane & 7) == 0) { const int q = ((F.lane >> 5) & 1) * 4 + ((F.lane >> 4) & 1) * 2 + ((F.lane >> 3) & 1); ((float*)(ws + WS_ZG))[(size_t)m * 8 + q] = g8[0]; }
        }
}
__device__ __forceinline__ void p0_prologue(Frame& F) {
    LAS float* scr = (LAS float*)(F.lds + F.wave * 8704);
    LAS float* GW = (LAS float*)(F.lds + 98304);
    const float* w_in = F.in[3]; const float* g_in = F.in[2]; const float* x_in = F.in[0]; const float* m_in = F.in[1];
    { float wv[16], gvv[16];
#pragma unroll
      for (int i = 0; i < 16; ++i) { const int idx = F.tid + i * NWAVES * 64, q = idx >> 10, k = idx & 1023; wv[i] = w_in[(size_t)k * DIN + 2048 + q]; gvv[i] = g_in[k]; }
      __builtin_amdgcn_sched_barrier(0);
#pragma unroll
      for (int i = 0; i < 16; ++i) GW[F.tid + i * NWAVES * 64] = gvv[i] * wv[i]; }
    __syncthreads();
    const int gw = F.vcu * NWAVES + F.wave, NGW = F.G * NWAVES;
    unsigned char* ws = F.ws;
    for (int it = gw; it < W_EARLY; it += NGW) weight_item(F, it, scr);
#define P0_LOAD(dst, mm) do { const int mm_ = (mm); if (mm_ < M + MM) { const float* xrow_ = mm_ < M ? x_in + (size_t)mm_ * DM : m_in + (size_t)(mm_ - M) * DM; const GAS f32x4* xr_ = (const GAS f32x4*)xrow_ + F.lane; \
        _Pragma("unroll") for (int j_ = 0; j_ < 4; ++j_) dst[j_] = xr_[64 * j_]; } } while (0)
    f32x4 ra[4], rb[4], rc[4];
    P0_LOAD(ra, gw); P0_LOAD(rb, gw + NGW); P0_LOAD(rc, gw + 2 * NGW);
#define P0_ROW(buf, mm) do { const int m = (mm); if (m < M + MM) { const bool is_x = m < M; \
        f32x4 v[4]; float s = 0.f; \
        _Pragma("unroll") for (int j = 0; j < 4; ++j) { v[j] = buf[j]; s += (v[j].x * v[j].x + v[j].y * v[j].y) + (v[j].z * v[j].z + v[j].w * v[j].w); } \
        P0_LOAD(buf, m + 3 * NGW); \
        p0_row(F, GW, ws, m, is_x, v, s); } } while (0)
    for (int m0 = gw; m0 < M + MM; m0 += 3 * NGW) { P0_ROW(ra, m0); P0_ROW(rb, m0 + NGW); P0_ROW(rc, m0 + 2 * NGW); }
#undef P0_ROW
#undef P0_LOAD
}

__device__ __forceinline__ void final_norm(Frame& F) {
    const bool blk = (F.G == 256);
    const int gw = blk ? F.vcu * 128 + F.wave : F.vcu * NWAVES + F.wave, NGW = blk ? NWAVES : F.G * NWAVES, MEND = blk ? F.vcu * 128 + 128 : M;
    const float* ssq = (const float*)(F.ws + WS_SSQ3); const float* g = F.in[29];
    const bf16* h3 = (const bf16*)(F.ws + WS_H3B);
    f32x4 gv[4];
#pragma unroll
    for (int j = 0; j < 4; ++j) gv[j] = *(const f32x4*)(g + 4 * F.lane + 256 * j);
    float rs_l = 0.f;
    { const int mk = gw + F.lane * NGW; if (mk < MEND) rs_l = pg8::row_rstd16(ssq, mk, EPS); }
    u32x2v nx[4];
    if (gw < MEND) {
#pragma unroll
        for (int j = 0; j < 4; ++j) nx[j] = *(const u32x2v*)(h3 + (size_t)gw * DM + 4 * F.lane + 256 * j); }
    int k = 0;
    for (int m = gw; m < MEND; m += NGW, ++k) {
        u32x2v c[4];
#pragma unroll
        for (int j = 0; j < 4; ++j) c[j] = nx[j];
        const int mn = m + NGW;
        if (mn < MEND) {
#pragma unroll
            for (int j = 0; j < 4; ++j) nx[j] = *(const u32x2v*)(h3 + (size_t)mn * DM + 4 * F.lane + 256 * j); }
        const float rs = (k < 64) ? __shfl(rs_l, k) : pg8::row_rstd16(ssq, m, EPS);
        float* o = F.out + (size_t)m * DM + 4 * F.lane;
#pragma unroll
        for (int j = 0; j < 4; ++j) *(f32x4*)(o + 256 * j) = (f32x4){bflo(c[j].x), bfhi(c[j].x), bflo(c[j].y), bfhi(c[j].y)} * rs * gv[j];
    }
}

typedef short v4i16_t __attribute__((ext_vector_type(4)));
typedef short s16x4 __attribute__((ext_vector_type(4)));
__device__ __forceinline__ s16x4 lds_tr16(const LAS unsigned char* p) { return __builtin_bit_cast(s16x4, __builtin_amdgcn_ds_read_tr16_b64_v4i16((LAS v4i16_t*)p)); }
__device__ __forceinline__ bf16x8 cat8(s16x4 lo, s16x4 hi) { return (bf16x8){lo[0], lo[1], lo[2], lo[3], hi[0], hi[1], hi[2], hi[3]}; }

constexpr int ML_ROWB = 272;
constexpr int ML_Q = 0, ML_K = 34816, ML_V = 69632, ML_C = 104448, ML_F = 139264;
template <bool OUTP> __device__ __forceinline__ void mlstm_chunk(Frame& F, int b, int h, int c, f32x4 (&Cacc)[8], float& m_prev, const float ib, const float fb, const float* normw) {
    LAS unsigned char* L = F.lds;
    LAS unsigned char *Qs = L + ML_Q, *Ks = L + ML_K, *Vs = L + ML_V, *Cs = L + ML_C;
    LAS float* fl = (LAS float*)(L + ML_F);
    LAS float *dS = fl, *Mrow = fl + 128, *sint = fl + 256, *eden = fl + 384, *wgt = fl + 512, *nvec = fl + 640, *npart = fl + 768, *scal = fl + 1280, *tmp = fl + 1296;
    LAS float* cwL = fl + 1552;
    const int tid = F.tid, lane0 = F.lane, w = F.wave;
    const bf16* zm = (const bf16*)(F.ws + WS_ZM);
    const float* zg = (const float*)(F.ws + WS_ZG);
    bf16* Y = (bf16*)F.out;
    unsigned craw[35]; float graw[2] = {0.f, 0.f};
#define ML_ISSUE(cn) do { const int m0_ = b * SEQ + (cn) * 128; const int ts0_ = (cn) * 128 + 32 * tq; const char* zb_ = (const char*)(zm + (size_t)m0_ * NZM); \
        if (isk || outp) { craw[0] = (ts0_ >= 3) ? *(const unsigned*)(zb_ - 3 * NZM * 2 + cvoff) : 0u; craw[1] = (ts0_ >= 2) ? *(const unsigned*)(zb_ - 2 * NZM * 2 + cvoff) : 0u; craw[2] = (ts0_ >= 1) ? *(const unsigned*)(zb_ - 1 * NZM * 2 + cvoff) : 0u; \
        _Pragma("unroll") for (int i_ = 0; i_ < 32; ++i_) craw[3 + i_] = *(const unsigned*)(zb_ + (size_t)i_ * NZM * 2 + cvoff); } \
        if (tidv < 128) { const float* zr_ = zg + (size_t)(m0_ + tidv) * 8; graw[0] = zr_[h]; graw[1] = zr_[4 + h]; } } while (0)
        const int m0 = b * SEQ + c * 128; constexpr bool outp = OUTP;
        int lane = lane0, tidv = tid; asm volatile("" : "+v"(lane), "+v"(tidv));
        const int fr = lane & 15, G = lane >> 4;
        const int cp = tidv & 127, tq = tidv >> 7; const bool isk = cp >= 64; const int e2 = 2 * (cp & 63); const float kscale = isk ? 0.08838834764831845f : 1.0f;
        const unsigned cvoff = (unsigned)((32 * (tidv >> 7)) * NZM + (((tidv & 127) >= 64) ? 512 : 0) + 128 * h + 2 * (tidv & 63)) * 2u;
        ML_ISSUE(c);
        v4u vraw[4];
#pragma unroll
        for (int i = 0; i < 4; ++i) vraw[i] = *(const v4u*)((const char*)(zm + (size_t)(m0 + 32 * i) * NZM + 1024 + 128 * h) + (unsigned)((tidv >> 4) * NZM + 8 * (tidv & 15)) * 2u);
        float lf = 0.f, igv = 0.f;
        if (tidv < 128) { igv = graw[0] + ib; const float fv = graw[1] + fb; lf = fminf(fv, 0.f) - log1pf(__expf(-fabsf(fv))); }
        float bc = lf;
#pragma unroll
        for (int o = 1; o < 64; o <<= 1) { const float t = __shfl_up(bc, o); if (lane >= o) bc += t; }
        if (w == 0 && lane == 63) tmp[0] = bc;
        __syncthreads();
        if (w == 1) bc += tmp[0];
        const float dl = igv - bc;
        float pm = dl;
#pragma unroll
        for (int o = 1; o < 64; o <<= 1) { const float t = __shfl_up(pm, o); if (lane >= o) pm = fmaxf(pm, t); }
        if (w == 0 && lane == 63) tmp[1] = pm;
        __syncthreads();
        if (w == 1) pm = fmaxf(pm, tmp[1]);
        if (tidv == 127) { scal[0] = bc; scal[3] = pm; }
        __syncthreads();
        const float g = scal[0], m_loc = g + scal[3], m_new = fmaxf(g + m_prev, m_loc), s_old = __expf(g + m_prev - m_new);
        if (tidv < 128) { const float Ml = fmaxf(m_prev, pm); dS[tidv] = dl; Mrow[tidv] = Ml; sint[tidv] = __expf(m_prev - Ml); eden[tidv] = __expf(-bc - Ml); wgt[tidv] = __expf(g + dl - m_new); }
        {
            const int tl0 = 32 * tq;
            float cw[4][2];
            { const f32x4 c0 = *(const LAS f32x4*)(cwL + cp * 8), c1 = *(const LAS f32x4*)(cwL + cp * 8 + 4); cw[0][0] = c0[0]; cw[0][1] = c0[1]; cw[1][0] = c0[2]; cw[1][1] = c0[3]; cw[2][0] = c1[0]; cw[2][1] = c1[1]; cw[3][0] = c1[2]; cw[3][1] = c1[3]; }
            LAS unsigned char* dst = (isk ? Ks : Qs) + tl0 * ML_ROWB + e2 * 2;
            if (isk || outp)
#pragma unroll
            for (int i = 0; i < 32; ++i) {
                typedef float f2 __attribute__((ext_vector_type(2)));
                const f2 xa = {bflo(craw[i]), bfhi(craw[i])}, xb = {bflo(craw[i + 1]), bfhi(craw[i + 1])}, xc = {bflo(craw[i + 2]), bfhi(craw[i + 2])}, xd = {bflo(craw[i + 3]), bfhi(craw[i + 3])};
                const f2 w0 = {cw[0][0], cw[0][1]}, w1 = {cw[1][0], cw[1][1]}, w2 = {cw[2][0], cw[2][1]}, w3 = {cw[3][0], cw[3][1]};
                const f2 a = w0 * xa + (w1 * xb + (w2 * xc + w3 * xd));
                const f2 t = a * (f2){-LOG2E, -LOG2E}; f2 e; e.x = __builtin_amdgcn_exp2f(t.x); e.y = __builtin_amdgcn_exp2f(t.y);
                const f2 d = e + (f2){1.0f, 1.0f}; f2 r; r.x = __builtin_amdgcn_rcpf(d.x); r.y = __builtin_amdgcn_rcpf(d.y);
                const f2 o2 = (a * (f2){kscale, kscale}) * r;
                *(LAS unsigned*)(dst + i * ML_ROWB) = pk2(o2.x, o2.y);
            }
#pragma unroll
            for (int i = 0; i < 4; ++i) { const int p = tidv + 512 * i, row = p >> 4, ch = p & 15; *(LAS v4u*)(Vs + row * ML_ROWB + ch * 16) = vraw[i]; }
        }
        if (outp)
#pragma unroll
        for (int et = 0; et < 8; ++et)
#pragma unroll
            for (int r = 0; r < 4; ++r) *(LAS unsigned short*)(Cs + (16 * w + 4 * G + r) * ML_ROWB + (16 * et + fr) * 2) = (unsigned short)f2bf(Cacc[et][r]);
        __syncthreads();
        if (outp) {
            int lrow = 16 * w + fr; asm volatile("" : "+v"(lrow));
            bf16x8 qf[4];
#pragma unroll
            for (int ks = 0; ks < 4; ++ks) qf[ks] = *(const LAS bf16x8*)(Qs + lrow * ML_ROWB + (32 * ks + 8 * G) * 2);
            float nq = 0.f;
#pragma unroll
            for (int ks = 0; ks < 4; ++ks)
#pragma unroll
                for (int j = 0; j < 8; ++j) nq += bf2f((unsigned short)qf[ks][j]) * nvec[32 * ks + 8 * G + j];
            nq += __shfl_xor(nq, 16); nq += __shfl_xor(nq, 32);
            const float Ml = Mrow[lrow], si = sint[lrow], ed = eden[lrow];
            f32x4 acc[8];
#pragma unroll
            for (int dt = 0; dt < 8; ++dt) { acc[dt] = (f32x4){0.f, 0.f, 0.f, 0.f};
#pragma unroll
                for (int ks = 0; ks < 4; ++ks) { const bf16x8 a = *(const LAS bf16x8*)(Cs + (16 * dt + fr) * ML_ROWB + (32 * ks + 8 * G) * 2); acc[dt] = __builtin_amdgcn_mfma_f32_16x16x32_bf16(a, qf[ks], acc[dt], 0, 0, 0); }
                acc[dt] = acc[dt] * si; __builtin_amdgcn_sched_barrier(0); }
            float den = 0.f;
#pragma unroll
            for (int kp = 0; kp < 4; ++kp) {
                if (2 * kp <= w) {
                    s16x4 vlo[8], vhi[8];
                    { const LAS unsigned char* vb = Vs + (32 * kp + 4 * G + ((lane >> 2) & 3)) * ML_ROWB + (4 * (lane & 3)) * 2;
#pragma unroll
                      for (int dt = 0; dt < 8; ++dt) { vlo[dt] = lds_tr16(vb + dt * 32); vhi[dt] = lds_tr16(vb + 16 * ML_ROWB + dt * 32); } }
                    __builtin_amdgcn_sched_barrier(0);
                    float pv[8];
#pragma unroll
                    for (int hh = 0; hh < 2; ++hh) { const int st = 2 * kp + hh;
                        f32x4 s4 = (f32x4){0.f, 0.f, 0.f, 0.f};
                        if (st <= w) {
#pragma unroll
                            for (int ks = 0; ks < 4; ++ks) { const bf16x8 a = *(const LAS bf16x8*)(Ks + (16 * st + fr) * ML_ROWB + (32 * ks + 8 * G) * 2); s4 = __builtin_amdgcn_mfma_f32_16x16x32_bf16(a, qf[ks], s4, 0, 0, 0); }
                        }
                        const f32x4 d4 = *(const LAS f32x4*)(dS + 16 * st + 4 * G);
#pragma unroll
                        for (int r = 0; r < 4; ++r) { const int s = 16 * st + 4 * G + r; const float p = (s <= lrow) ? s4[r] * __expf(d4[r] - Ml) : 0.f; den += p; pv[hh * 4 + r] = p; } }
                    bf16x8 pf; { const unsigned a0 = pk2(pv[0], pv[1]), a1 = pk2(pv[2], pv[3]), a2 = pk2(pv[4], pv[5]), a3 = pk2(pv[6], pv[7]); pf = __builtin_bit_cast(bf16x8, (v4u){a0, a1, a2, a3}); }
#pragma unroll
                    for (int dt = 0; dt < 8; ++dt) acc[dt] = __builtin_amdgcn_mfma_f32_16x16x32_bf16(cat8(vlo[dt], vhi[dt]), pf, acc[dt], 0, 0, 0);
                    __builtin_amdgcn_sched_barrier(0);
                }
            }
            den += __shfl_xor(den, 16); den += __shfl_xor(den, 32);
            den += si * nq;
            const float inv = 1.0f / fmaxf(fabsf(den), ed);
            float ss = 0.f;
#pragma unroll
            for (int dt = 0; dt < 8; ++dt) { acc[dt] = acc[dt] * inv; ss += (acc[dt][0] * acc[dt][0] + acc[dt][1] * acc[dt][1]) + (acc[dt][2] * acc[dt][2] + acc[dt][3] * acc[dt][3]); }
            ss += __shfl_xor(ss, 16); ss += __shfl_xor(ss, 32);
            const float rs = 1.0f / sqrtf(ss * (1.0f / 128.0f) + EPS);
            const size_t mrow = (size_t)(m0 + lrow);
#pragma unroll
            for (int dt = 0; dt < 8; ++dt) { const int d0 = 16 * dt + 4 * G;
                const uint2 ov = *(const uint2*)(zm + mrow * NZM + 1536 + 128 * h + d0);
                const f32x4 nw = *(const f32x4*)(normw + 128 * h + d0);
                const float y0 = acc[dt][0] * rs * nw[0] * sigmoidf_(bflo(ov.x)), y1 = acc[dt][1] * rs * nw[1] * sigmoidf_(bfhi(ov.x));
                const float y2 = acc[dt][2] * rs * nw[2] * sigmoidf_(bflo(ov.y)), y3 = acc[dt][3] * rs * nw[3] * sigmoidf_(bfhi(ov.y));
                uint2 o; o.x = pk2(y0, y1); o.y = pk2(y2, y3); *(uint2*)(Y + mrow * DM + 128 * h + d0) = o; }
        }
#pragma unroll
        for (int et = 0; et < 8; ++et) Cacc[et] = Cacc[et] * s_old;
        { s16x4 blo[2][8], bhi[2][8], alo[2], ahi[2];
          const int rq = 4 * G + ((lane >> 2) & 3), cb = 4 * (lane & 3);
#define ML_LD7(buf, kp_) do { const int rb_ = 32 * (kp_) + rq; alo[buf] = lds_tr16(Vs + rb_ * ML_ROWB + (16 * w + cb) * 2); ahi[buf] = lds_tr16(Vs + (rb_ + 16) * ML_ROWB + (16 * w + cb) * 2); \
            _Pragma("unroll") for (int et = 0; et < 8; ++et) { blo[buf][et] = lds_tr16(Ks + rb_ * ML_ROWB + (16 * et + cb) * 2); bhi[buf][et] = lds_tr16(Ks + (rb_ + 16) * ML_ROWB + (16 * et + cb) * 2); } } while (0)
          ML_LD7(0, 0);
#pragma unroll
          for (int kp = 0; kp < 4; ++kp) {
            __builtin_amdgcn_sched_barrier(0);
            if (kp + 1 < 4) ML_LD7((kp + 1) & 1, kp + 1);
            __builtin_amdgcn_sched_barrier(0);
            const f32x4 wl = *(const LAS f32x4*)(wgt + 32 * kp + 4 * G), wh = *(const LAS f32x4*)(wgt + 32 * kp + 16 + 4 * G);
            const s16x4 a_lo = alo[kp & 1], a_hi = ahi[kp & 1];
            bf16x8 af; { const unsigned a0 = pk2(bf2f((unsigned short)a_lo[0]) * wl[0], bf2f((unsigned short)a_lo[1]) * wl[1]), a1 = pk2(bf2f((unsigned short)a_lo[2]) * wl[2], bf2f((unsigned short)a_lo[3]) * wl[3]),
                                          a2 = pk2(bf2f((unsigned short)a_hi[0]) * wh[0], bf2f((unsigned short)a_hi[1]) * wh[1]), a3 = pk2(bf2f((unsigned short)a_hi[2]) * wh[2], bf2f((unsigned short)a_hi[3]) * wh[3]);
                af = __builtin_bit_cast(bf16x8, (v4u){a0, a1, a2, a3}); }
#pragma unroll
            for (int et = 0; et < 8; ++et) Cacc[et] = __builtin_amdgcn_mfma_f32_16x16x32_bf16(af, cat8(blo[kp & 1][et], bhi[kp & 1][et]), Cacc[et], 0, 0, 0);
          }
#undef ML_LD7
        }
        { const int e = tidv & 127, sq = tidv >> 7; float p = 0.f;
#pragma unroll 8
            for (int i = 0; i < 32; ++i) { const int s = 32 * sq + i; p += wgt[s] * bf2f(*(const LAS unsigned short*)(Ks + s * ML_ROWB + e * 2)); }
            npart[sq * 128 + e] = p; }
        __syncthreads();
        if (tidv < 128) nvec[tidv] = s_old * nvec[tidv] + ((npart[tidv] + npart[128 + tidv]) + (npart[256 + tidv] + npart[384 + tidv]));
        m_prev = m_new;
        __syncthreads();
#undef ML_ISSUE
}
__device__ __forceinline__ void mlstm_unit(Frame& F, int b, int h, int c_end, int c_out0) {
    pg8::ch_wait_n<8>((unsigned*)(F.ws + WS_CTL) + CW_CHN + pg8::ch_word(11, 8 * b), pg8::CH_STRIDE, 120u, (unsigned*)(F.ws + WS_CTL) + CW_BAR + XB_TMO, F.colo);
    LAS float* fl = (LAS float*)(F.lds + ML_F);
    LAS float *nvec = fl + 640, *cwL = fl + 1552;
    const float* convw = F.in[4];
    f32x4 Cacc[8];
#pragma unroll
    for (int et = 0; et < 8; ++et) Cacc[et] = (f32x4){0.f, 0.f, 0.f, 0.f};
    float m_prev = 0.f;
    { const int tp = F.tid;
      if (tp < 128) { nvec[tp] = 0.f; const int zc0 = ((tp >= 64) ? 512 : 0) + 128 * h + 2 * (tp & 63);
#pragma unroll
        for (int j = 0; j < 4; ++j) { cwL[tp * 8 + 2 * j] = convw[j * 1024 + zc0]; cwL[tp * 8 + 2 * j + 1] = convw[j * 1024 + zc0 + 1]; } } }
    __syncthreads();
    const int c_mid = c_out0 < c_end ? c_out0 : c_end;
    const float ib = F.in[5][h], fb = F.in[6][h]; const float* normw = F.in[7];
    for (int c = 0; c < c_mid; ++c) mlstm_chunk<false>(F, b, h, c, Cacc, m_prev, ib, fb, normw);
    unsigned* const ycnt = (unsigned*)(F.ws + WS_CTL) + CW_CHN + pg8::ch_word(10, 8 * b);
    for (int c = c_mid; c < c_end; ++c) { mlstm_chunk<true>(F, b, h, c, Cacc, m_prev, ib, fb, normw); if (c & 1) pg8::ch_publish_now(ycnt + pg8::CH_STRIDE * (c >> 1), F.colo); }
}

constexpr int LO_TW = 0, LO_XA = 9216, LO_SG = 18432, LO_ST = 36864, LO_STW = 9216;
__device__ __forceinline__ void lora_unit(Frame& F, int b, int tb) {
    LAS unsigned char* L = F.lds;
    const int tid = F.tid, lane = F.lane, w = F.wave, fr = lane & 15, G = lane >> 4;
    const bf16* zr = (const bf16*)(F.ws + WS_ZR);
    const size_t m0 = (size_t)b * SEQ + 64 * tb;
    {
        unsigned* pc = (unsigned*)(F.ws + WS_CTL) + CW_CHN + pg8::ch_word(11, 8 * b + (tb >> 2)); unsigned* tm = (unsigned*)(F.ws + WS_CTL) + CW_BAR + XB_TMO;
        if ((tb & 3) == 0 && tb > 0) pg8::ch_wait_n<2>(pc - pg8::CH_STRIDE, pg8::CH_STRIDE, 120u, tm, F.colo); else pg8::ch_wait_n<1>(pc, pg8::CH_STRIDE, 120u, tm, F.colo); }
    { const int grp = tid & 31, run = tid >> 5; const int zc = 1536 + 8 * grp;
        float mu8[8]; const float* mu_in = F.in[8];
#pragma unroll
        for (int i = 0; i < 8; ++i) mu8[i] = mu_in[zc + i];
        const bf16* p = zr + (m0 + 4 * run) * NZR + zc;
        v4u raw[5];
        raw[0] = (64 * tb + 4 * run > 0) ? *(const v4u*)(p - NZR) : (v4u){0u, 0u, 0u, 0u};
#pragma unroll
        for (int i = 0; i < 4; ++i) raw[1 + i] = *(const v4u*)(p + (size_t)i * NZR);
        const int kind = grp < 8 ? 1 : (grp < 16 ? 0 : 2); const float asc = kind == 1 ? 2.0f : 1.0f;
        LAS unsigned char* dst = grp < 8 ? L + LO_TW + (4 * run) * 144 + (8 * grp) * 2 : (grp < 16 ? L + LO_XA + (4 * run) * 144 + (8 * (grp - 8)) * 2 : L + LO_SG + (4 * run) * 272 + (8 * (grp - 16)) * 2);
        const int dstride = grp < 16 ? 144 : 272;
#pragma unroll
        for (int i = 0; i < 4; ++i) { const v4u uc = raw[1 + i], up = raw[i]; float v[8];
#pragma unroll
            for (int q = 0; q < 4; ++q) { const float c0 = bflo(uc[q]), c1 = bfhi(uc[q]), p0 = bflo(up[q]), p1 = bfhi(up[q]);
                v[2 * q] = c0 + (p0 - c0) * mu8[2 * q]; v[2 * q + 1] = c1 + (p1 - c1) * mu8[2 * q + 1]; }
            if (kind != 0) {
#pragma unroll
                for (int q = 0; q < 8; ++q) { const float g = sigmoidf_(v[q] * asc); v[q] = kind == 1 ? 2.0f * g - 1.0f : g; } }
            v4u o; o.x = pk2(v[0], v[1]); o.y = pk2(v[2], v[3]); o.z = pk2(v[4], v[5]); o.w = pk2(v[6], v[7]);
            *(LAS v4u*)(dst + i * dstride) = o; }
    }
    __syncthreads();
    const bf16* wup_t = (const bf16*)(F.ws + WS_LORA); const bf16* aup_t = wup_t + 512 * 64; const bf16* gup_t = wup_t + 2 * 512 * 64;
    LAS unsigned char* stg = L + LO_ST + w * LO_STW;
    LAS unsigned char* est = stg; LAS unsigned char* ast = stg + 2304; LAS unsigned char* gst = stg + 4608;
    bf16* Eo = (bf16*)(F.ws + WS_E); bf16* ALo = (bf16*)(F.ws + WS_AL); bf16* GGo = (bf16*)(F.ws + WS_GG);
    const float* w0_in = F.in[9]; const float* a0_in = F.in[11];
    bf16x8 wf[4][8];
#pragma unroll
    for (int c4 = 0; c4 < 4; ++c4) { const int ch = 64 * w + 16 * c4 + fr;
#pragma unroll
        for (int ks = 0; ks < 2; ++ks) { wf[c4][ks] = *(const bf16x8*)(wup_t + (size_t)ch * 64 + 32 * ks + 8 * G); wf[c4][2 + ks] = *(const bf16x8*)(aup_t + (size_t)ch * 64 + 32 * ks + 8 * G); }
#pragma unroll
        for (int ks = 0; ks < 4; ++ks) wf[c4][4 + ks] = *(const bf16x8*)(gup_t + (size_t)ch * 128 + 32 * ks + 8 * G); }
#pragma unroll 1
    for (int tt = 0; tt < 4; ++tt) {
        bf16x8 fw[2], fa[2], fg[4];
#pragma unroll
        for (int ks = 0; ks < 2; ++ks) { fw[ks] = *(const LAS bf16x8*)(L + LO_TW + (16 * tt + fr) * 144 + (32 * ks + 8 * G) * 2); fa[ks] = *(const LAS bf16x8*)(L + LO_XA + (16 * tt + fr) * 144 + (32 * ks + 8 * G) * 2); }
#pragma unroll
        for (int ks = 0; ks < 4; ++ks) fg[ks] = *(const LAS bf16x8*)(L + LO_SG + (16 * tt + fr) * 272 + (32 * ks + 8 * G) * 2);
#pragma unroll
        for (int c4 = 0; c4 < 4; ++c4) {
            f32x4 dw = (f32x4){0.f, 0.f, 0.f, 0.f}, da = dw, dg = dw;
#pragma unroll
            for (int ks = 0; ks < 2; ++ks) { dw = __builtin_amdgcn_mfma_f32_16x16x32_bf16(wf[c4][ks], fw[ks], dw, 0, 0, 0); da = __builtin_amdgcn_mfma_f32_16x16x32_bf16(wf[c4][2 + ks], fa[ks], da, 0, 0, 0); }
#pragma unroll
            for (int ks = 0; ks < 4; ++ks) dg = __builtin_amdgcn_mfma_f32_16x16x32_bf16(wf[c4][4 + ks], fg[ks], dg, 0, 0, 0);
            const f32x4 w0 = *(const f32x4*)(w0_in + 64 * w + 16 * c4 + 4 * G), a0 = *(const f32x4*)(a0_in + 64 * w + 16 * c4 + 4 * G);
            f32x4 ev, av;
#pragma unroll
            for (int r = 0; r < 4; ++r) { ev[r] = 0.6065306597126334f * sigmoidf_(dw[r] + w0[r]); av[r] = sigmoidf_(da[r] + a0[r]); }
            u32x2v oe, oa, og; oe.x = pk2(ev[0], ev[1]); oe.y = pk2(ev[2], ev[3]); *(LAS u32x2v*)(est + fr * 144 + (16 * c4 + 4 * G) * 2) = oe;
            oa.x = pk2(av[0], av[1]); oa.y = pk2(av[2], av[3]); og.x = pk2(dg[0], dg[1]); og.y = pk2(dg[2], dg[3]);
            *(LAS u32x2v*)(ast + fr * 144 + (16 * c4 + 4 * G) * 2) = oa; *(LAS u32x2v*)(gst + fr * 144 + (16 * c4 + 4 * G) * 2) = og; }
        asm volatile("s_waitcnt lgkmcnt(0)" ::: "memory");
        const size_t mr = m0 + 16 * tt;
#pragma unroll
        for (int i = 0; i < 2; ++i) { const int tok = 8 * i + (lane >> 3), pc = lane & 7;
            *(v4u*)(Eo + (mr + tok) * 512 + 64 * w + 8 * pc) = *(const LAS v4u*)(est + tok * 144 + pc * 16); *(v4u*)(ALo + (mr + tok) * 512 + 64 * w + 8 * pc) = *(const LAS v4u*)(ast + tok * 144 + pc * 16); *(v4u*)(GGo + (mr + tok) * 512 + 64 * w + 8 * pc) = *(const LAS v4u*)(gst + tok * 144 + pc * 16); }
        asm volatile("s_waitcnt lgkmcnt(0)" ::: "memory");
    }
    __syncthreads();
    pg8::ch_publish_now((unsigned*)(F.ws + WS_CTL) + CW_CHN + pg8::ch_word(6, 32 * b + tb), F.colo);
}

constexpr int RW_FS = 68;
constexpr int RW_RF = 0, RW_KF = 17408, RW_EF = 34816, RW_AL = 52224;
constexpr int RW_OPS = 144;
constexpr int RW_AT = 0, RW_RT = 9216, RW_BT = 18432, RW_KT = 27648, RW_BH = 36864, RW_KH = 46080, RW_VI = 55296;
constexpr int RW_VF = 69632;
constexpr int RW_TW = 87040, RW_XA = 96256, RW_SG = 105472;
constexpr int RW_GAB = 87040, RW_GAK = 96256, RW_GBR = 105472, RW_GKR = 114688;
constexpr int RW_G = 123904;
constexpr int RW_YT = 132096;
constexpr int RW_DIAG = 149504;
constexpr int RW_DB = 153600;
constexpr int RW_WC = 158720, RW_BON = 158976, RW_ESEG = 159232, RW_PAR = 161280, RW_END = 162560;
static_assert(RW_END <= MISC_OFF, "rwkv LDS map");
__device__ __forceinline__ int rw_pos(int k) { return (k & 32) + 8 * ((k >> 2) & 3) + 4 * ((k >> 4) & 1) + (k & 3); }
__device__ __forceinline__ bf16x8 pack8(const f32x4& lo, const f32x4& hi) { const unsigned a0 = pk2(lo[0], lo[1]), a1 = pk2(lo[2], lo[3]), a2 = pk2(hi[0], hi[1]), a3 = pk2(hi[2], hi[3]); return __builtin_bit_cast(bf16x8, (v4u){a0, a1, a2, a3}); }
__device__ __forceinline__ bf16x8 pack4z(const f32x4& lo) { const unsigned a0 = pk2(lo[0], lo[1]), a1 = pk2(lo[2], lo[3]); return __builtin_bit_cast(bf16x8, (v4u){a0, a1, 0u, 0u}); }
#define RW_MFMA(a, b, c) __builtin_amdgcn_mfma_f32_16x16x32_bf16((a), (b), (c), 0, 0, 0)
#define RW_LDA(base, row, ks) (*(const LAS bf16x8*)(L + (base) + (row) * RW_OPS + (32 * (ks) + 8 * G) * 2))
#define RW_LDT(base, c16, ks) cat8(lds_tr16(L + (base) + (32 * (ks) + 4 * G + ((lane >> 2) & 3)) * RW_OPS + (16 * (c16) + 4 * (lane & 3)) * 2), lds_tr16(L + (base) + (32 * (ks) + 16 + 4 * G + ((lane >> 2) & 3)) * RW_OPS + (16 * (c16) + 4 * (lane & 3)) * 2))
__device__ __forceinline__ void rwkv_unit(Frame& F, int b, int h) {
    LAS unsigned char* L = F.lds;
    LAS float *Rf = (LAS float*)(L + RW_RF), *Kf = (LAS float*)(L + RW_KF), *Ef = (LAS float*)(L + RW_EF), *ALf = (LAS float*)(L + RW_AL), *Vf = (LAS float*)(L + RW_VF);
    LAS float *YT = (LAS float*)(L + RW_YT), *DIAG = (LAS float*)(L + RW_DIAG), *WC = (LAS float*)(L + RW_WC), *BON = (LAS float*)(L + RW_BON), *ESEG = (LAS float*)(L + RW_ESEG);
    LAS unsigned char *TW = L + RW_TW, *XA = L + RW_XA, *SG = L + RW_SG; LAS unsigned short* Gs = (LAS unsigned short*)(L + RW_G);
    const int tid = F.tid, lane0 = F.lane, w = F.wave, fr0 = lane0 & 15, G0 = lane0 >> 4;
    const bf16* zr = (const bf16*)(F.ws + WS_ZR);
    const float* mu = F.in[8];
    const bf16* wup_t = (const bf16*)(F.ws + WS_LORA); const bf16* aup_t = wup_t + 512 * 64; const bf16* gup_t = wup_t + 2 * 512 * 64;
    bf16* Y = (bf16*)F.out;
    const int hc0 = 64 * h;
    f32x4 ST[4];
#pragma unroll
    for (int jt = 0; jt < 4; ++jt) ST[jt] = (f32x4){0.f, 0.f, 0.f, 0.f};
    for (int i = tid; i < 4 * 16 * 20; i += NWAVES * 64) ((LAS unsigned*)(L + RW_DB))[i] = 0u;
    LAS float* PAR = (LAS float*)(L + RW_PAR);
    if (tid < 320) { const int a = tid >> 6, c = tid & 63; const float* src = a == 0 ? F.in[14] : (a == 1 ? F.in[15] : (a == 2 ? F.in[16] : (a == 3 ? F.in[17] : F.in[18]))); PAR[tid] = src[hc0 + c]; }
    const bool ld_on = tid < 384; const int grp = ld_on ? tid % 24 : 0, run4 = ld_on ? tid / 24 : 0;
    const int zc = 512 * (grp >> 3) + hc0 + 8 * (grp & 7);
    float mu8[8];
#pragma unroll
    for (int i = 0; i < 8; ++i) mu8[i] = mu[zc + i];
    LAS unsigned char* const adst = L + (grp < 8 ? RW_RF : (grp < 16 ? RW_KF : RW_VF)) + (4 * run4) * 272 + (8 * (grp & 7)) * 4;
    const bf16* Eg = (const bf16*)(F.ws + WS_E); const bf16* ALg = (const bf16*)(F.ws + WS_AL); const bf16* GGg = (const bf16*)(F.ws + WS_GG);
    v4u raw[5]; v4u eraw, alraw, graw;
    const unsigned rvoff = (unsigned)((4 * run4) * NZR + zc) * 2u;
    const unsigned agoff = (unsigned)((tid >> 3) * 512 + hc0 + 8 * (tid & 7)) * 2u;
#define RW_ISSUE(tbn) do { const size_t mb_ = (size_t)b * SEQ + (tbn) * 64; \
        if (ld_on) { const char* zb_ = (const char*)(zr + mb_ * NZR); \
            raw[0] = ((tbn) * 64 + 4 * run4 > 0) ? *(const v4u*)(zb_ - NZR * 2 + rvoff) : (v4u){0u, 0u, 0u, 0u}; \
            _Pragma("unroll") for (int i_ = 0; i_ < 4; ++i_) raw[1 + i_] = *(const v4u*)(zb_ + (size_t)i_ * NZR * 2 + rvoff); } \
        eraw = *(const v4u*)((const char*)(Eg + mb_ * 512) + agoff); \
        alraw = *(const v4u*)((const char*)(ALg + mb_ * 512) + agoff); graw = *(const v4u*)((const char*)(GGg + mb_ * 512) + agoff); } while (0)
    unsigned* const lctr = (unsigned*)(F.ws + WS_CTL) + CW_CHN + pg8::ch_word(6, 32 * b); unsigned* const ltmo = (unsigned*)(F.ws + WS_CTL) + CW_BAR + XB_TMO;
    unsigned* const ycnt = (unsigned*)(F.ws + WS_CTL) + CW_CHN + pg8::ch_word(10, 8 * b);
    pg8::ch_wait_n<8>((unsigned*)(F.ws + WS_CTL) + CW_CHN + pg8::ch_word(11, 8 * b), pg8::CH_STRIDE, 120u, ltmo, F.colo);
    pg8::ch_wait(lctr, 8u, ltmo);
    if (!F.colo) { __builtin_amdgcn_fence(__ATOMIC_ACQUIRE, "agent"); asm volatile("s_waitcnt vmcnt(0)" ::: "memory"); }
    RW_ISSUE(0);
    __syncthreads();
    for (int tb = 0; tb < 32; ++tb) {
        unsigned lpv = 8u; if (tb + 1 < 32) lpv = __hip_atomic_load(lctr + pg8::CH_STRIDE * (tb + 1), __ATOMIC_RELAXED, __HIP_MEMORY_SCOPE_AGENT);
        const size_t m0 = (size_t)b * SEQ + tb * 64;
        int lane = lane0, fr = fr0, G = G0, ct = tid >> 3, cg = tid & 7;
        asm volatile("" : "+v"(lane), "+v"(fr), "+v"(G), "+v"(ct), "+v"(cg));
        if (ld_on) {
            LAS unsigned char* ap = adst; asm volatile("" : "+v"(ap));
#pragma unroll
            for (int i = 0; i < 4; ++i) { const v4u uc = raw[1 + i], up = raw[i]; float v[8];
#pragma unroll
                for (int q = 0; q < 4; ++q) { const float c0 = bflo(uc[q]), c1 = bfhi(uc[q]), p0 = bflo(up[q]), p1 = bfhi(up[q]);
                    v[2 * q] = c0 + (p0 - c0) * mu8[2 * q]; v[2 * q + 1] = c1 + (p1 - c1) * mu8[2 * q + 1]; }
                *(LAS f32x4*)ap = (f32x4){v[0], v[1], v[2], v[3]}; *(LAS f32x4*)(ap + 16) = (f32x4){v[4], v[5], v[6], v[7]};
                ap += 272; asm volatile("" : "+v"(ap)); }
        }
        { LAS float* ep_ = Ef + ct * RW_FS + 8 * cg; *(LAS f32x4*)ep_ = (f32x4){bflo(eraw.x), bfhi(eraw.x), bflo(eraw.y), bfhi(eraw.y)}; *(LAS f32x4*)(ep_ + 4) = (f32x4){bflo(eraw.z), bfhi(eraw.z), bflo(eraw.w), bfhi(eraw.w)}; }
        const v4u gpk = graw;
        __syncthreads();
        if (tb >= 5 && ((tb - 5) & 3) == 0) {
            if (F.colo) pg8::ch_arrive(ycnt + pg8::CH_STRIDE * ((tb - 5) >> 2), true); else pg8::ch_publish_now(ycnt + pg8::CH_STRIDE * ((tb - 5) >> 2), false); }
        { float c8[8]; float run_ = 0.f;
#pragma unroll
            for (int q = 0; q < 8; ++q) { run_ += Ef[(8 * w + q) * RW_FS + lane]; c8[q] = run_; }
            ESEG[w * 64 + lane] = run_;
            __syncthreads();
            float off = 0.f;
#pragma unroll
            for (int q = 0; q < 7; ++q) off += (q < w) ? ESEG[q * 64 + lane] : 0.f;
#pragma unroll
            for (int q = 0; q < 8; ++q) Ef[(8 * w + q) * RW_FS + lane] = c8[q] + off;
            if (w == 7) WC[lane] = __expf(-(c8[7] + off)); }
        __syncthreads();
        float o_at[8], o_rt[8], o_bt[8], o_kt[8], o_bh[8], o_kh[8], o_v[8];
        { float kr[8], rr[8], ec[8], ep[8], eC[8], al[8]; float ssq = 0.f, bon = 0.f;
#pragma unroll
            for (int q = 0; q < 4; ++q) { al[2 * q] = bflo(alraw[q]); al[2 * q + 1] = bfhi(alraw[q]); }
#pragma unroll
            for (int q = 0; q < 2; ++q) { const f32x4 a = *(const LAS f32x4*)(Kf + ct * RW_FS + 8 * cg + 4 * q), bq = *(const LAS f32x4*)(Rf + ct * RW_FS + 8 * cg + 4 * q),
                    d = *(const LAS f32x4*)(Ef + ct * RW_FS + 8 * cg + 4 * q), e2 = *(const LAS f32x4*)(Ef + 63 * RW_FS + 8 * cg + 4 * q), vv = *(const LAS f32x4*)(Vf + ct * RW_FS + 8 * cg + 4 * q);
                f32x4 p = (f32x4){0.f, 0.f, 0.f, 0.f}; if (ct > 0) p = *(const LAS f32x4*)(Ef + (ct - 1) * RW_FS + 8 * cg + 4 * q);
#pragma unroll
                for (int i = 0; i < 4; ++i) { kr[4 * q + i] = a[i]; rr[4 * q + i] = bq[i]; ec[4 * q + i] = d[i]; eC[4 * q + i] = e2[i]; ep[4 * q + i] = p[i]; o_v[4 * q + i] = vv[i]; } }
            typedef float f2 __attribute__((ext_vector_type(2)));
            f2 pk_[4], pa_[4], pr_[4];
#pragma unroll
            for (int q = 0; q < 2; ++q) { const f32x4 a = *(const LAS f32x4*)(PAR + 8 * cg + 4 * q), b2 = *(const LAS f32x4*)(PAR + 64 + 8 * cg + 4 * q), c2 = *(const LAS f32x4*)(PAR + 128 + 8 * cg + 4 * q);
                pk_[2 * q] = (f2){a[0], a[1]}; pk_[2 * q + 1] = (f2){a[2], a[3]}; pa_[2 * q] = (f2){b2[0], b2[1]}; pa_[2 * q + 1] = (f2){b2[2], b2[3]}; pr_[2 * q] = (f2){c2[0], c2[1]}; pr_[2 * q + 1] = (f2){c2[2], c2[3]}; }
            f2 kk2[4], ss2 = {0.f, 0.f};
#pragma unroll
            for (int p = 0; p < 4; ++p) { const f2 kr2 = {kr[2 * p], kr[2 * p + 1]}; kk2[p] = kr2 * pk_[p]; ss2 = kk2[p] * kk2[p] + ss2; }
            ssq = row8_sum(ss2.x + ss2.y);
            const float inv = 1.0f / fmaxf(sqrtf(ssq), 1e-12f);
            const f2 inv2 = {inv, inv}, one2 = {1.0f, 1.0f}, L2 = {LOG2E, LOG2E}; f2 bon2 = {0.f, 0.f};
#pragma unroll
            for (int p = 0; p < 4; ++p) { const f2 kr2 = {kr[2 * p], kr[2 * p + 1]}, al2 = {al[2 * p], al[2 * p + 1]}, rr2 = {rr[2 * p], rr[2 * p + 1]};
                const f2 kn = kk2[p] * inv2, k2 = kr2 * ((al2 - one2) * pa_[p] + one2), bb = kn * al2;
                const f2 te = (f2){ec[2 * p], ec[2 * p + 1]} * L2, tp = (f2){ep[2 * p], ep[2 * p + 1]} * L2, tr = te - (f2){eC[2 * p], eC[2 * p + 1]} * L2;
                f2 Wt, iWt, Wp, rat;
                Wt.x = __builtin_amdgcn_exp2f(-te.x); Wt.y = __builtin_amdgcn_exp2f(-te.y); iWt.x = __builtin_amdgcn_exp2f(te.x); iWt.y = __builtin_amdgcn_exp2f(te.y);
                Wp.x = __builtin_amdgcn_exp2f(-tp.x); Wp.y = __builtin_amdgcn_exp2f(-tp.y); rat.x = __builtin_amdgcn_exp2f(tr.x); rat.y = __builtin_amdgcn_exp2f(tr.y);
                const f2 oat = -(kn * Wp), ort = rr2 * Wt, obt = bb * iWt, okt = k2 * iWt, obh = bb * rat, okh = k2 * rat;
                o_at[2 * p] = oat.x; o_at[2 * p + 1] = oat.y; o_rt[2 * p] = ort.x; o_rt[2 * p + 1] = ort.y; o_bt[2 * p] = obt.x; o_bt[2 * p + 1] = obt.y;
                o_kt[2 * p] = okt.x; o_kt[2 * p + 1] = okt.y; o_bh[2 * p] = obh.x; o_bh[2 * p + 1] = obh.y; o_kh[2 * p] = okh.x; o_kh[2 * p + 1] = okh.y;
                bon2 = (rr2 * k2) * pr_[p] + bon2; }
            bon = bon2.x + bon2.y;
            bon = row8_sum(bon);
            if (cg == 0) BON[ct] = bon; }
        __syncthreads();
        { const int p0 = 32 * (cg >> 2) + 8 * ((2 * cg) & 3) + 4 * ((cg >> 1) & 1), p1 = 32 * (cg >> 2) + 8 * ((2 * cg + 1) & 3) + 4 * ((cg >> 1) & 1);
#define RW_ST4(base, arr) do { u32x2v lo_, hi_; lo_.x = pk2(arr[0], arr[1]); lo_.y = pk2(arr[2], arr[3]); hi_.x = pk2(arr[4], arr[5]); hi_.y = pk2(arr[6], arr[7]); \
            *(LAS u32x2v*)(L + (base) + ct * RW_OPS + p0 * 2) = lo_; *(LAS u32x2v*)(L + (base) + ct * RW_OPS + p1 * 2) = hi_; } while (0)
            RW_ST4(RW_AT, o_at); RW_ST4(RW_RT, o_rt); RW_ST4(RW_BT, o_bt); RW_ST4(RW_KT, o_kt);
#undef RW_ST4
#define RW_ST4N(base, arr) do { u32x2v lo_, hi_; lo_.x = pk2(arr[0], arr[1]); lo_.y = pk2(arr[2], arr[3]); hi_.x = pk2(arr[4], arr[5]); hi_.y = pk2(arr[6], arr[7]); \
            *(LAS u32x2v*)(L + (base) + ct * RW_OPS + (8 * cg) * 2) = lo_; *(LAS u32x2v*)(L + (base) + ct * RW_OPS + (8 * cg + 4) * 2) = hi_; } while (0)
            RW_ST4N(RW_BH, o_bh); RW_ST4N(RW_KH, o_kh); RW_ST4N(RW_VI, o_v);
#undef RW_ST4N
        }
        __syncthreads();
        if (tb + 1 < 32) {
            if ((unsigned)__builtin_amdgcn_readfirstlane(lpv) < 8u) pg8::ch_wait(lctr + pg8::CH_STRIDE * (tb + 1), 8u, ltmo);
            if (!F.colo) { __builtin_amdgcn_fence(__ATOMIC_ACQUIRE, "agent"); asm volatile("s_waitcnt vmcnt(0)" ::: "memory"); }
            RW_ISSUE(tb + 1); }
        bf16x8 dfa[2][2], dfr[2][2], dfb[2][2], dfk[2][2];
#pragma unroll
        for (int qq = 0; qq < 2; ++qq) { const int q = 2 * w + qq, tq = q >> 2, sq = q & 3;
#pragma unroll
            for (int ks = 0; ks < 2; ++ks) { dfa[qq][ks] = RW_LDA(RW_AT, 16 * tq + fr, ks); dfr[qq][ks] = RW_LDA(RW_RT, 16 * tq + fr, ks); dfb[qq][ks] = RW_LDA(RW_BT, 16 * sq + fr, ks); dfk[qq][ks] = RW_LDA(RW_KT, 16 * sq + fr, ks); } }
        __builtin_amdgcn_sched_barrier(0);
#pragma unroll
        for (int qq = 0; qq < 2; ++qq) { const int q = 2 * w + qq, tq = q >> 2, sq = q & 3;
            f32x4 gab = (f32x4){0.f, 0.f, 0.f, 0.f}, gak = gab, gbr = gab, gkr = gab;
            if (sq <= tq) {
#pragma unroll
                for (int ks = 0; ks < 2; ++ks) { gab = RW_MFMA(dfb[qq][ks], dfa[qq][ks], gab); gak = RW_MFMA(dfk[qq][ks], dfa[qq][ks], gak); gbr = RW_MFMA(dfb[qq][ks], dfr[qq][ks], gbr); gkr = RW_MFMA(dfk[qq][ks], dfr[qq][ks], gkr); } }
            const int t = 16 * tq + fr, s0 = 16 * sq + 4 * G, ps = rw_pos(s0);
            if (sq == tq) {
#pragma unroll
                for (int r = 0; r < 4; ++r) { const bool lt = (4 * G + r) < fr, le = (4 * G + r) <= fr; gab[r] = lt ? gab[r] : 0.f; gak[r] = lt ? gak[r] : 0.f; gbr[r] = le ? gbr[r] : 0.f; gkr[r] = le ? gkr[r] : 0.f; }
                *(LAS f32x4*)(DIAG + tq * 256 + fr * 16 + 4 * G) = gab;
                gab = (f32x4){0.f, 0.f, 0.f, 0.f}; }
            u32x2v o;
            o.x = pk2(gab[0], gab[1]); o.y = pk2(gab[2], gab[3]); *(LAS u32x2v*)(L + RW_GAB + t * RW_OPS + ps * 2) = o;
            o.x = pk2(gak[0], gak[1]); o.y = pk2(gak[2], gak[3]); *(LAS u32x2v*)(L + RW_GAK + t * RW_OPS + ps * 2) = o;
            o.x = pk2(gbr[0], gbr[1]); o.y = pk2(gbr[2], gbr[3]); *(LAS u32x2v*)(L + RW_GBR + t * RW_OPS + ps * 2) = o;
            o.x = pk2(gkr[0], gkr[1]); o.y = pk2(gkr[2], gkr[3]); *(LAS u32x2v*)(L + RW_GKR + t * RW_OPS + ps * 2) = o; }
        __syncthreads();
        if (w == 7) { const int blk = lane >> 4; int c = lane & 15; asm volatile("" : "+v"(c)); float z[16];
            f32x4 Lr[16][4];
#define RW_ELOAD(t0_, t1_) _Pragma("unroll") for (int t = (t0_); t < (t1_); ++t) _Pragma("unroll") for (int q = 0; q < 4; ++q) if (4 * q < t) Lr[t][q] = *(const LAS f32x4*)(DIAG + blk * 256 + t * 16 + 4 * q);
#define RW_ESTEP(t0_, t1_) _Pragma("unroll") for (int t = (t0_); t < (t1_); ++t) { float p4[4] = {(t == c) ? 1.0f : 0.0f, 0.f, 0.f, 0.f}; \
                _Pragma("unroll") for (int q = 0; q < 4; ++q) if (4 * q < t) { _Pragma("unroll") for (int e = 0; e < 4; ++e) if (4 * q + e < t) p4[q] += Lr[t][q][e] * z[4 * q + e]; } \
                z[t] = (p4[0] + p4[1]) + (p4[2] + p4[3]); }
            RW_ELOAD(1, 11)
            asm volatile("s_waitcnt lgkmcnt(0)" ::: "memory"); __builtin_amdgcn_sched_barrier(0);
            RW_ESTEP(0, 7)
            __builtin_amdgcn_sched_barrier(0);
            RW_ELOAD(11, 16)
            __builtin_amdgcn_sched_barrier(0);
            RW_ESTEP(7, 11)
            asm volatile("s_waitcnt lgkmcnt(0)" ::: "memory"); __builtin_amdgcn_sched_barrier(0);
            RW_ESTEP(11, 16)
#undef RW_ELOAD
#undef RW_ESTEP
            const int slot = 8 * (c >> 2) + (c & 3);
#pragma unroll
            for (int t = 0; t < 16; ++t) *(LAS unsigned short*)(L + RW_DB + blk * 1280 + t * 80 + slot * 2) = (unsigned short)f2bf(z[t]); }
        const f32x4 z4 = (f32x4){0.f, 0.f, 0.f, 0.f};
        bf16x8 sb[2], vf[2], ub[2];
        f32x4 XT[4];
        if (w < 4) {
            bf16x8 fa[4][2], fk[4][2];
            vf[0] = RW_LDT(RW_VI, w, 0); vf[1] = RW_LDT(RW_VI, w, 1);
#pragma unroll
            for (int t4 = 0; t4 < 4; ++t4) { fa[t4][0] = RW_LDA(RW_AT, 16 * t4 + fr, 0); fa[t4][1] = RW_LDA(RW_AT, 16 * t4 + fr, 1); fk[t4][0] = RW_LDA(RW_GAK, 16 * t4 + fr, 0); if (t4 >= 2) fk[t4][1] = RW_LDA(RW_GAK, 16 * t4 + fr, 1); }
            __builtin_amdgcn_sched_barrier(0);
            sb[0] = pack8(ST[0], ST[1]); sb[1] = pack8(ST[2], ST[3]);
#pragma unroll
            for (int t4 = 0; t4 < 4; ++t4) { f32x4 acc = z4;
                acc = RW_MFMA(fa[t4][0], sb[0], acc); acc = RW_MFMA(fa[t4][1], sb[1], acc);
                acc = RW_MFMA(fk[t4][0], vf[0], acc); if (t4 >= 2) acc = RW_MFMA(fk[t4][1], vf[1], acc);
                XT[t4] = acc; }
        }
        __syncthreads();
        if (w < 4) {
#define RW_DBF(blk) (*(const LAS bf16x8*)(L + RW_DB + (blk) * 1280 + fr * 80 + (8 * G) * 2))
            bf16x8 fd[4], fg[4];
#pragma unroll
            for (int q = 0; q < 4; ++q) fd[q] = RW_DBF(q);
            fg[0] = RW_LDA(RW_GAB, 16 + fr, 0); fg[1] = RW_LDA(RW_GAB, 32 + fr, 0); fg[2] = RW_LDA(RW_GAB, 48 + fr, 0); fg[3] = RW_LDA(RW_GAB, 48 + fr, 1);
            __builtin_amdgcn_sched_barrier(0);
            const f32x4 U0 = RW_MFMA(fd[0], pack4z(XT[0]), z4);
            ub[0] = pack4z(U0);
            const f32x4 Z1 = RW_MFMA(fg[0], ub[0], XT[1]);
            const f32x4 U1 = RW_MFMA(fd[1], pack4z(Z1), z4);
            ub[0] = pack8(U0, U1);
            const f32x4 Z2 = RW_MFMA(fg[1], ub[0], XT[2]);
            const f32x4 U2 = RW_MFMA(fd[2], pack4z(Z2), z4);
            ub[1] = pack4z(U2);
            f32x4 Z3 = RW_MFMA(fg[2], ub[0], XT[3]); Z3 = RW_MFMA(fg[3], ub[1], Z3);
            const f32x4 U3 = RW_MFMA(fd[3], pack4z(Z3), z4);
            ub[1] = pack8(U2, U3);
#undef RW_DBF
            __builtin_amdgcn_sched_barrier(0);
            bf16x8 fy[4][2], fbr[4][2], fkr[4][2];
#pragma unroll
            for (int t4 = 0; t4 < 4; ++t4) { fy[t4][0] = RW_LDA(RW_RT, 16 * t4 + fr, 0); fy[t4][1] = RW_LDA(RW_RT, 16 * t4 + fr, 1); fbr[t4][0] = RW_LDA(RW_GBR, 16 * t4 + fr, 0); fkr[t4][0] = RW_LDA(RW_GKR, 16 * t4 + fr, 0);
                if (t4 >= 2) { fbr[t4][1] = RW_LDA(RW_GBR, 16 * t4 + fr, 1); fkr[t4][1] = RW_LDA(RW_GKR, 16 * t4 + fr, 1); } }
            __builtin_amdgcn_sched_barrier(0);
#pragma unroll
            for (int t4 = 0; t4 < 4; ++t4) { f32x4 acc = z4;
                acc = RW_MFMA(fy[t4][0], sb[0], acc); acc = RW_MFMA(fy[t4][1], sb[1], acc);
                acc = RW_MFMA(fbr[t4][0], ub[0], acc); acc = RW_MFMA(fkr[t4][0], vf[0], acc);
                if (t4 >= 2) { acc = RW_MFMA(fbr[t4][1], ub[1], acc); acc = RW_MFMA(fkr[t4][1], vf[1], acc); }
#pragma unroll
                for (int r = 0; r < 4; ++r) YT[(16 * t4 + 4 * G + r) * RW_FS + 16 * w + fr] = acc[r]; }
            __builtin_amdgcn_sched_barrier(0);
            bf16x8 fbh[4][2], fkh[4][2];
#pragma unroll
            for (int jt = 0; jt < 4; ++jt) { fbh[jt][0] = RW_LDT(RW_BH, jt, 0); fbh[jt][1] = RW_LDT(RW_BH, jt, 1); fkh[jt][0] = RW_LDT(RW_KH, jt, 0); fkh[jt][1] = RW_LDT(RW_KH, jt, 1); }
            __builtin_amdgcn_sched_barrier(0);
#pragma unroll
            for (int jt = 0; jt < 4; ++jt) { const f32x4 wc4 = *(const LAS f32x4*)(WC + 16 * jt + 4 * G); f32x4 acc = ST[jt] * wc4;
                acc = RW_MFMA(fbh[jt][0], ub[0], acc); acc = RW_MFMA(fbh[jt][1], ub[1], acc);
                acc = RW_MFMA(fkh[jt][0], vf[0], acc); acc = RW_MFMA(fkh[jt][1], vf[1], acc);
                ST[jt] = acc; }
        }
        __syncthreads();
        { typedef float f2 __attribute__((ext_vector_type(2)));
            f2 y2[4]; f2 s2 = {0.f, 0.f};
#pragma unroll
            for (int q = 0; q < 2; ++q) { const f32x4 a = *(const LAS f32x4*)(YT + ct * RW_FS + 8 * cg + 4 * q); y2[2 * q] = (f2){a[0], a[1]}; y2[2 * q + 1] = (f2){a[2], a[3]}; s2 = s2 + y2[2 * q] + y2[2 * q + 1]; }
            const float mean = row8_sum(s2.x + s2.y) * (1.0f / 64.0f); const f2 mean2 = {mean, mean}; f2 q2 = {0.f, 0.f};
#pragma unroll
            for (int p = 0; p < 4; ++p) { y2[p] = y2[p] - mean2; q2 = y2[p] * y2[p] + q2; }
            const float rstd = 1.0f / sqrtf(row8_sum(q2.x + q2.y) * (1.0f / 64.0f) + RWKV_LN_EPS); const float bon = BON[ct]; const f2 rstd2 = {rstd, rstd}, bon2 = {bon, bon};
            const v4u vpk = *(const LAS v4u*)(L + RW_VI + ct * RW_OPS + (8 * cg) * 2);
            f2 lw[4], lb[4];
#pragma unroll
            for (int q = 0; q < 2; ++q) { const f32x4 a = *(const LAS f32x4*)(PAR + 192 + 8 * cg + 4 * q), b2 = *(const LAS f32x4*)(PAR + 256 + 8 * cg + 4 * q); lw[2 * q] = (f2){a[0], a[1]}; lw[2 * q + 1] = (f2){a[2], a[3]}; lb[2 * q] = (f2){b2[0], b2[1]}; lb[2 * q + 1] = (f2){b2[2], b2[3]}; }
            v4u ov;
#pragma unroll
            for (int p = 0; p < 4; ++p) { const f2 vv = {bflo(vpk[p]), bfhi(vpk[p])}, gg = {bflo(gpk[p]), bfhi(gpk[p])};
                const f2 yn = (y2[p] * rstd2) * lw[p] + (bon2 * vv + lb[p]); const f2 o2 = yn * gg; ov[p] = pk2(o2.x, o2.y); }
            *(v4u*)(Y + (m0 + ct) * DM + 512 + hc0 + 8 * cg) = ov; }
        __syncthreads();
    }
    pg8::ch_publish_now(ycnt + pg8::CH_STRIDE * 7, F.colo);
#undef RW_ISSUE
}
#undef RW_MFMA
#undef RW_LDA
#undef RW_LDT

typedef float f32x16 __attribute__((ext_vector_type(16)));
constexpr int AT_ROWB = 528;
__device__ __forceinline__ void attn_load_tile(Frame& F, const bf16* src  ) {
    const unsigned voff = (unsigned)(F.tid >> 5) * 4096u + (unsigned)(F.tid & 31) * 16u;
    LAS unsigned char* dst = F.lds + (F.tid >> 5) * AT_ROWB + (F.tid & 31) * 16;
#pragma unroll
    for (int hh = 0; hh < 2; ++hh) { v4u r[8];
#pragma unroll
        for (int i = 0; i < 8; ++i) r[i] = *(const v4u*)((const char*)src + (size_t)(8 * hh + i) * 65536 + voff);
#pragma unroll
        for (int i = 0; i < 8; ++i) *(LAS v4u*)(dst + (8 * hh + i) * 16 * AT_ROWB) = r[i]; }
}
__device__ __forceinline__ void attn_unit(Frame& F, int b, int hd, int qt) {
    const int lane = F.lane, w = F.wave, r32 = lane & 31, hi = lane >> 5;
    const bf16* kv = (const bf16*)(F.ws + WS_KV) + (size_t)b * MEMT * 2048 + 256 * hd;
    bf16* QO = (bf16*)((unsigned char*)F.out + OUT_QO);
    const size_t qrow = (size_t)b * SEQ + 256 * qt + 32 * w + r32;
    attn_load_tile(F, kv);
    bf16x8 qf[16];
#pragma unroll
    for (int ks = 0; ks < 16; ++ks) qf[ks] = *(const bf16x8*)((const char*)(QO + ((size_t)b * SEQ + 256 * qt + 32 * w) * DM + 256 * hd + 16 * ks) + (unsigned)(r32 * 2048 + hi * 16));
    __syncthreads();
    float mxh[2], smh[2];
    bf16x8 pf[16];
#pragma unroll
    for (int half = 0; half < 2; ++half) {
        f32x16 s[4];
#pragma unroll
        for (int k4 = 0; k4 < 4; ++k4)
#pragma unroll
            for (int r = 0; r < 16; ++r) s[k4][r] = 0.f;
        bf16x8 fa[2][4];
#define AT_LDB(buf, hb) _Pragma("unroll") for (int j_ = 0; j_ < 4; ++j_) fa[buf][j_] = *(const LAS bf16x8*)(F.lds + (32 * (4 * half + ((hb) >> 2)) + r32) * AT_ROWB + (16 * (4 * ((hb) & 3) + j_) + 8 * hi) * 2);
        AT_LDB(0, 0)
#pragma unroll
        for (int hb = 0; hb < 16; ++hb) {
            __builtin_amdgcn_sched_barrier(0);
            if (hb + 1 < 16) { AT_LDB((hb + 1) & 1, hb + 1) }
            __builtin_amdgcn_sched_barrier(0);
#pragma unroll
            for (int j = 0; j < 4; ++j) s[hb >> 2] = __builtin_amdgcn_mfma_f32_32x32x16_bf16(fa[hb & 1][j], qf[4 * (hb & 3) + j], s[hb >> 2], 0, 0, 0);
        }
#undef AT_LDB
        float mx = -INFINITY;
#pragma unroll
        for (int k4 = 0; k4 < 4; ++k4)
#pragma unroll
            for (int r = 0; r < 16; ++r) mx = fmaxf(mx, s[k4][r]);
        mx = fmaxf(mx, __shfl_xor(mx, 32));
        float sum = 0.f;
#pragma unroll
        for (int k4 = 0; k4 < 4; ++k4) {
#pragma unroll
            for (int r = 0; r < 16; ++r) { s[k4][r] = __builtin_amdgcn_exp2f(s[k4][r] - mx); sum += s[k4][r]; }
#pragma unroll
            for (int ss = 0; ss < 2; ++ss) { const unsigned a0 = pk2(s[k4][8 * ss + 0], s[k4][8 * ss + 1]), a1 = pk2(s[k4][8 * ss + 2], s[k4][8 * ss + 3]), a2 = pk2(s[k4][8 * ss + 4], s[k4][8 * ss + 5]), a3 = pk2(s[k4][8 * ss + 6], s[k4][8 * ss + 7]);
                pf[8 * half + 2 * k4 + ss] = __builtin_bit_cast(bf16x8, (v4u){a0, a1, a2, a3}); }
        }
        sum += __shfl_xor(sum, 32);
        mxh[half] = mx; smh[half] = sum;
    }
    __syncthreads();
    attn_load_tile(F, kv + 1024);
    const float mxa = fmaxf(mxh[0], mxh[1]);
    float f0 = __builtin_amdgcn_exp2f(mxh[0] - mxa), f1 = __builtin_amdgcn_exp2f(mxh[1] - mxa);
    const float inv = 1.0f / (f0 * smh[0] + f1 * smh[1]);
    f0 *= inv; f1 *= inv;
    __syncthreads();
    const int G4 = lane >> 4;
    const LAS unsigned char* vb = F.lds + (4 * (G4 >> 1) + ((lane >> 2) & 3)) * AT_ROWB + (16 * (G4 & 1) + 4 * (lane & 3)) * 2;
#pragma unroll 1
    for (int dt = 0; dt < 8; ++dt) {
        f32x16 oa, ob;
#pragma unroll
        for (int r = 0; r < 16; ++r) { oa[r] = 0.f; ob[r] = 0.f; }
#pragma unroll
        for (int kk = 0; kk < 8; ++kk) { const s16x4 lo = lds_tr16(vb + (16 * kk) * AT_ROWB + dt * 64), hi4 = lds_tr16(vb + (16 * kk + 8) * AT_ROWB + dt * 64);
            oa = __builtin_amdgcn_mfma_f32_32x32x16_bf16(cat8(lo, hi4), pf[kk], oa, 0, 0, 0);
            const s16x4 lo2 = lds_tr16(vb + (16 * kk + 128) * AT_ROWB + dt * 64), hi42 = lds_tr16(vb + (16 * kk + 136) * AT_ROWB + dt * 64);
            ob = __builtin_amdgcn_mfma_f32_32x32x16_bf16(cat8(lo2, hi42), pf[kk + 8], ob, 0, 0, 0); }
#pragma unroll
        for (int rg = 0; rg < 4; ++rg) { uint2 ov; ov.x = pk2(oa[4 * rg + 0] * f0 + ob[4 * rg + 0] * f1, oa[4 * rg + 1] * f0 + ob[4 * rg + 1] * f1); ov.y = pk2(oa[4 * rg + 2] * f0 + ob[4 * rg + 2] * f1, oa[4 * rg + 3] * f0 + ob[4 * rg + 3] * f1);
            *(uint2*)(QO + qrow * DM + 256 * hd + 32 * dt + 8 * rg + 4 * hi) = ov; }
    }
    __syncthreads();
}

#ifndef MK_N_LAUNCHES
#define MK_N_LAUNCHES 1
#endif
constexpr int N_PHASES = 10;
struct Args { const float* in[30]; float* out; unsigned char* ws; int ph_lo, ph_hi; };
__global__ void __launch_bounds__(NWAVES * 64, 2) mega_fwd(Args args) {
    extern __shared__ __attribute__((aligned(16))) unsigned char lds[];
    Frame F;
    F.lds = (LAS unsigned char*)lds;
    F.tid = threadIdx.x; F.lane = F.tid & 63; F.wave = __builtin_amdgcn_readfirstlane(F.tid >> 6);
    F.G = gridDim.x; { const int bx = blockIdx.x; F.vcu = (F.G % 8 == 0) ? (bx % 8) * (F.G / 8) + bx / 8 : bx; }
    F.in.p = (const float* const __attribute__((address_space(4)))*)__builtin_amdgcn_kernarg_segment_ptr();
    F.out = args.out; F.ws = args.ws;
    unsigned char* ws = args.ws;
    volatile LAS unsigned* MISC = (volatile LAS unsigned*)(F.lds + MISC_OFF);
    if (F.tid < 64) MISC[F.tid] = 0u;
    __syncthreads();
    const int lo = args.ph_lo, hi = args.ph_hi;
    const bool multi = (hi - lo) > 1;
    XcdBarrier bar; bar.bar = (unsigned*)(ws + WS_CTL) + CW_BAR; bar.x = 0; bar.st = nullptr;
    if (multi) { bar = xcd_barrier_post((unsigned*)(ws + WS_CTL) + CW_BAR, MISC + 8);
        if (F.tid == 0) (void)__hip_atomic_fetch_or((unsigned*)(ws + WS_CTL) + CW_GRP + 64 * (blockIdx.x & 7), 1u << bar.x, __ATOMIC_RELAXED, __HIP_MEMORY_SCOPE_AGENT); }
    bool colo = false;
#ifndef PHASE_MASK
#define PHASE_MASK 0x3ff
#endif
#define IN(k) (((PHASE_MASK >> (k)) & 1) && lo <= (k) && (k) < hi)
#ifndef REP2_MASK
#define REP2_MASK 0
#endif
#define REPS(k) (((REP2_MASK >> (k)) & 1) ? 2 : 1)
#define SEAM(k) do { if (IN(k) && IN((k) + 1)) xcd_barrier(bar); } while (0)
#define LSEAM(k) do { if (IN(k) && IN((k) + 1)) { if (colo) xcd_barrier_local(bar); else xcd_barrier(bar); } } while (0)
    typedef pg8::bf16_t b16;
    if (IN(0)) { for (int rp = 0; rp < REPS(0); ++rp) { p0_prologue(F); __syncthreads(); } }
    SEAM(0);
    if (multi) {
        if (F.tid == 0) { unsigned ok = (F.G == 256) ? 1u : 0u;
#pragma unroll
            for (int j = 0; j < 8; ++j) { const unsigned m = xb_ld((unsigned*)(ws + WS_CTL) + CW_GRP + 64 * j); ok &= (m != 0u && (m & (m - 1u)) == 0u) ? 1u : 0u; }
            MISC[10] = ok; }
        __syncthreads();
        colo = __builtin_amdgcn_readfirstlane(MISC[10]) != 0u;
    }
    F.colo = colo;
    unsigned* chn = (unsigned*)(ws + WS_CTL) + CW_CHN; unsigned* tmo = (unsigned*)(ws + WS_CTL) + CW_BAR + XB_TMO;
    if (IN(1)) for (int rp = 0; rp < REPS(1); ++rp) {
        pg8::Gemm g{(const b16*)(ws + WS_XN), (const b16*)(ws + WS_WIN), M + MM, NZ + 2048, DM};
        pg8::Order2C S; S.o.init(F.G, (int)blockIdx.x);
        S.hooks_init(chn, tmo, colo, F.wave); S.wait_k0 = -1; S.need0 = 0u; S.pub_k0 = 11; S.wait_k1 = -1; S.need1 = 0u; S.pub_k1 = -1;
        pg8::EpiZ E{(b16*)(ws + WS_ZM), (b16*)(ws + WS_ZR), (b16*)(ws + WS_KV)};
        pg8::gemm_phase<pg8::EpiZ, pg8::Order2C, true, true>(F.lds, g, S, E);
    }
    if (IN(2)) {
#ifndef REP_LO
#define REP_LO 1
#endif
        const int gq = (int)(blockIdx.x & 7), jq = (int)(blockIdx.x >> 3), vq = jq - 16;
        const int pu = (F.G != 256) ? F.vcu : (jq < 16 ? 16 * gq + jq : 128 + 64 * (vq & 1) + 8 * gq + 4 * (vq >> 3) + ((vq >> 1) & 3));
        if (F.G != 256) late_weights(F, F.vcu, F.G); else if (pu >= 128) late_weights(F, pu - 128, 128);
        wsplit_arrive(bar, (unsigned*)(ws + WS_CTL) + CW_WSP);
        { const int nl = (F.G != 256) ? (512 - F.vcu + F.G - 1) / F.G : (jq < 16 ? 1 : 3);
          for (int s3 = 0; s3 < nl; ++s3) { int lb, ltb;
            if (F.G != 256) { const int u = F.vcu + F.G * s3; lb = u >> 5; ltb = u & 31; }
            else if (jq < 16) { lb = 2 * gq + (jq >> 3); ltb = jq & 7; }
            else { const int n = 16 * s3 + vq; lb = 2 * gq + (n & 1); ltb = 8 + (n >> 1); }
            lora_unit(F, lb, ltb); } }
#ifndef ML_SPLIT
#define ML_SPLIT 10
#endif
#ifndef REP_RW
#define REP_RW 1
#endif
#ifndef REP_ML
#define REP_ML 1
#endif
        for (int rep = 0; rep < REP_RW; ++rep) for (int u = pu; u < 128; u += F.G) rwkv_unit(F, u >> 3, u & 7);
        for (int rep = 0; rep < REP_ML; ++rep) for (int u = pu; u < 256; u += F.G) if (u >= 128) { const int v = (u - 128) & 63; mlstm_unit(F, v >> 2, v & 3, u < 192 ? ML_SPLIT : 16, u < 192 ? 0 : ML_SPLIT); }
    }
    if (IN(2)) { __syncthreads(); if (F.tid == 0) (void)__hip_atomic_fetch_add((unsigned*)(ws + WS_CTL) + CW_CHN + pg8::ch_word(5, 8), 1u, __ATOMIC_RELAXED, __HIP_MEMORY_SCOPE_AGENT); }
    if (IN(3)) {
        wsplit_wait(bar, (unsigned*)(ws + WS_CTL) + CW_WSP);
        pg8::Gemm g{(const b16*)F.out, (const b16*)(ws + WS_WMIX), M, DM, DM};
        typedef pg8::StreamOrder<pg8::OrderQ, pg8::OrderQ> Ord; typedef pg8::EpiPair<pg8::EpiRes, pg8::EpiQ> Epi;
        Ord S; S.o0.init(F.G, F.vcu); S.o1.init(F.G, F.vcu); S.count0(); S.A1 = (const b16*)(ws + WS_H1B); S.B1 = (const b16*)(ws + WS_WQ);
        S.hooks_init(chn, tmo, colo, F.wave); S.wait_k0 = 10; S.need0 = 96u; S.pub_k0 = 0; S.wait_k1 = 0; S.need1 = 32u; S.pub_k1 = -1;
        Epi E{pg8::EpiRes{(const b16*)(ws + WS_XN), (b16*)(ws + WS_H1B), (float*)(ws + WS_SSQ1), (const float*)(ws + WS_RMS)},
              pg8::EpiQ{(b16*)((unsigned char*)F.out + OUT_QO), (const float*)(ws + WS_SSQ1), EPS, LOG2E * 0.0625f, F.lds}};
        pg8::gemm_phase<Epi, Ord, true, true>(F.lds, g, S, E);
        if (F.tid == 0) (void)__hip_atomic_fetch_add(chn + pg8::ch_word(5, (int)(blockIdx.x & 7)), 1u, __ATOMIC_RELAXED, __HIP_MEMORY_SCOPE_AGENT);
    }
    if (IN(5)) {
        pg8::OrderQ S; S.init(F.G, F.vcu); pg8::Unit u;
        for (int i = 0; S.next(i, u); ++i) { pg8::ch_wait_n<1>(chn + pg8::ch_word(11, 128 + (u.pm >> 3)), pg8::CH_STRIDE, 64u, tmo, colo);
            attn_unit(F, u.pm >> 3, u.pn, u.pm & 7); pg8::ch_publish_now(chn + pg8::ch_word(1, u.pm), colo); }
        if (F.wave == 0) asm volatile("buffer_inv sc1" ::: "memory");
    }
    if (IN(6)) {
        if (F.wave == 0) pg8::ch_wait(chn + pg8::ch_word(5, 8), (unsigned)F.G, tmo);
        __syncthreads();
        pg8::Gemm g{(const b16*)((unsigned char*)F.out + OUT_QO), (const b16*)(ws + WS_WO), M, DM, DM};
        typedef pg8::StreamOrder<pg8::StaticOrder, pg8::StaticOrder> Ord; typedef pg8::EpiPair<pg8::EpiRes, pg8::EpiGlu> Epi;
        Ord S; S.o0.init(M, DM, F.G, (int)blockIdx.x); S.o1.init(M, 2 * DFF, F.G, (int)blockIdx.x); S.count0(); S.A1 = (const b16*)(ws + WS_H2B); S.B1 = (const b16*)(ws + WS_WGU);
        S.hooks_init(chn, tmo, colo, F.wave); S.wait_k0 = 1; S.need0 = 32u; S.pub_k0 = 2; S.wait_k1 = 2; S.need1 = 32u; S.pub_k1 = 3;
        Epi E{pg8::EpiRes{(const b16*)(ws + WS_H1B), (b16*)(ws + WS_H2B), (float*)(ws + WS_SSQ2), nullptr},
              pg8::EpiGlu{(b16*)(ws + WS_ACT), (const float*)(ws + WS_SSQ2), EPS, F.lds}};
        pg8::gemm_phase<Epi, Ord, true, true>(F.lds, g, S, E);
    }
    if (IN(8)) {
        if (F.G != 256) xcd_barrier(bar);
        pg8::Gemm g{(const b16*)(ws + WS_ACT), (const b16*)(ws + WS_WD), M, DM, DFF};
        pg8::ChainOrder S; S.so.init(M, DM, F.G, (int)blockIdx.x);
        S.hooks_init(chn, tmo, colo, F.wave); S.wait_k0 = 3; S.need0 = 176u; S.pub_k0 = -1; S.wait_k1 = -1; S.need1 = 0u; S.pub_k1 = -1;
        pg8::EpiResNorm E{(const b16*)(ws + WS_H2B), F.out, (float*)(ws + WS_SSQ3), F.in[29], EPS, chn, tmo, colo, F.G == 256};
        pg8::gemm_phase<pg8::EpiResNorm, pg8::ChainOrder, true, true>(F.lds, g, S, E);
        if (xb_ld(tmo) != 0u) F.out[(size_t)F.vcu * 128 * DM + F.tid] = __builtin_nanf("");
    }
#undef IN
#undef SEAM
#undef LSEAM
}

extern "C" void kernel_launch(void* const* d_in, const int* in_sizes, int n_in, void* d_out, int out_size, void* d_ws, size_t ws_size, hipStream_t stream) {
    static int grid = 0;
    if (grid == 0) {
        if (n_in != 30 || in_sizes[0] != M * DM || out_size != M * DM || ws_size < WS_END) { fprintf(stderr, "kernel_launch: unexpected problem: n_in %d in0 %d out %d ws %zu (need %zu); nothing launched\n", n_in, n_in > 0 ? in_sizes[0] : -1, out_size, ws_size, (size_t)WS_END); grid = -1; return; }
        int dev = 0, cus = 0, per_cu = 0;
        if (hipGetDevice(&dev) != hipSuccess || hipDeviceGetAttribute(&cus, hipDeviceAttributeMultiprocessorCount, dev) != hipSuccess) { grid = -1; return; }
        if (hipFuncSetAttribute((const void*)mega_fwd, hipFuncAttributeMaxDynamicSharedMemorySize, LDS_BYTES) != hipSuccess) { fprintf(stderr, "kernel_launch: hipFuncSetAttribute(%d B LDS) failed\n", LDS_BYTES); grid = -1; return; }
        if (hipOccupancyMaxActiveBlocksPerMultiprocessor(&per_cu, (const void*)mega_fwd, NWAVES * 64, LDS_BYTES) != hipSuccess || per_cu < 1) { fprintf(stderr, "kernel_launch: occupancy query says %d blocks per CU\n", per_cu); }
        (void)hipGetLastError();
        grid = cus;
    }
    if (grid < 0) return;
    (void)hipMemsetAsync((char*)d_ws + WS_CTL, 0, CTL_ZERO_BYTES, stream);
    Args a{};
    for (int i = 0; i < 30; ++i) a.in[i] = (const float*)d_in[i];
    a.out = (float*)d_out; a.ws = (unsigned char*)d_ws;
#if MK_N_LAUNCHES == 1
    static_assert(MK_N_LAUNCHES == 1 && (ML_SPLIT & 1) == 0, "one launch (counter hand-offs); the mLSTM split must not cut a 256-token row panel");
    a.ph_lo = 0; a.ph_hi = N_PHASES;
    hipLaunchKernelGGL(mega_fwd, dim3(grid), dim3(NWAVES * 64), LDS_BYTES, stream, a);
#else
    for (int p = 0; p < N_PHASES; ++p) { a.ph_lo = p; a.ph_hi = p + 1; hipLaunchKernelGGL(mega_fwd, dim3(grid), dim3(NWAVES * 64), LDS_BYTES, stream, a); }
#endif
}
```
